# Optimizing an MI355X kernel written in HIP

```python
import jax, jax.numpy as jnp
from jax import lax
import numpy as np

D_MODEL = 1024
BATCH = 4
SEQ = 4096
DEPTH = 4

CTX_LEN = 256
GRID_W = 64
ROPE_THETA = 10000.0
EPS = 1e-6
BLOCK = 128
HEAD_DIM = 64
D_MIX = D_MODEL
MLA_HEADS = 4
MLA_NOPE = 64
MLA_ROPE = 32
MLA_V = 64
MLA_Q_RANK = 256
MLA_KV_RANK = 128
GQA_HEADS = 4
GQA_KV_HEADS = 2
SWA_HEADS = 4
SWA_KV_HEADS = 2
WINDOW = 128
SSD_HEADS = 4
SSD_HEAD_DIM = 64
SSD_GROUPS = 2
SSD_STATE = 128
SSD_CONV = 5
SSD_CHUNK = 128
SSD_INNER = SSD_HEADS * SSD_HEAD_DIM
SSD_CONV_DIM = SSD_INNER + 2 * SSD_GROUPS * SSD_STATE
A_WIDTHS = (MLA_Q_RANK, MLA_KV_RANK, MLA_ROPE, MLA_HEADS * MLA_V)
B_WIDTHS = (GQA_HEADS * HEAD_DIM, GQA_KV_HEADS * HEAD_DIM, GQA_KV_HEADS * HEAD_DIM, GQA_HEADS * HEAD_DIM)
C_WIDTHS = (SWA_HEADS * HEAD_DIM, SWA_KV_HEADS * HEAD_DIM, SWA_KV_HEADS * HEAD_DIM, SWA_HEADS * HEAD_DIM)
D_WIDTHS = (SSD_INNER, SSD_CONV_DIM, 2 * SSD_HEADS)
IN_WIDTHS = A_WIDTHS + B_WIDTHS + C_WIDTHS + D_WIDTHS
IN_COLS = sum(IN_WIDTHS)

kernel_name = 'hybrid_head_group_flow_block'


def rmsnorm(x, w):
    xf = x.astype(jnp.float32)
    y = xf * lax.rsqrt(jnp.mean(xf * xf, axis=-1, keepdims=True) + EPS)
    return (y * w.astype(jnp.float32)).astype(x.dtype)


def split_cols(p, widths):
    return jnp.split(p, [int(i) for i in np.cumsum(widths)[:-1]], axis=-1)


def axial_rope(n_tokens, rot_dim):
    rows = n_tokens // GRID_W
    row = jnp.repeat(jnp.arange(rows, dtype=jnp.float32), GRID_W)
    col = jnp.tile(jnp.arange(GRID_W, dtype=jnp.float32), rows)
    n_freq = rot_dim // 4
    inv_freq = ROPE_THETA ** (-jnp.arange(n_freq, dtype=jnp.float32) / n_freq)
    ang = jnp.concatenate([row[:, None] * inv_freq, col[:, None] * inv_freq], axis=-1)
    return jnp.cos(ang), jnp.sin(ang)


def apply_rope(x, cos, sin):
    half = x.shape[-1] // 2
    x1, x2 = x[..., :half], x[..., half:]
    c, s = cos[:, None, :], sin[:, None, :]
    return jnp.concatenate([x1 * c - x2 * s, x1 * s + x2 * c], axis=-1).astype(x.dtype)


def blocked_attention(q, k, v, scale):
    bsz, n = q.shape[:2]
    nblk = n // BLOCK
    qb = q.reshape(bsz, nblk, BLOCK, *q.shape[2:]).swapaxes(0, 1)

    def one_block(q_blk):
        s = jnp.einsum('bqhgd,bkhd->bhgqk', q_blk, k).astype(jnp.float32) * scale
        p = jax.nn.softmax(s, axis=-1).astype(v.dtype)
        return jnp.einsum('bhgqk,bkhd->bqhgd', p, v)

    out = lax.map(one_block, qb)
    return out.swapaxes(0, 1).reshape(bsz, n, -1)


def dense_sink_attention(q, k, v, sink, scale):
    bsz, n, kvh, g, _ = q.shape
    s = jnp.einsum('bqhgd,bkhd->bhgqk', q, k).astype(jnp.float32) * scale
    sink_col = jnp.broadcast_to(sink.astype(jnp.float32).reshape(kvh, g)[None, :, :, None, None], s.shape[:-1] + (1,))
    p = jax.nn.softmax(jnp.concatenate([s, sink_col], axis=-1), axis=-1)[..., :-1].astype(v.dtype)
    return jnp.einsum('bhgqk,bkhd->bqhgd', p, v).reshape(bsz, n, -1)


def window_sink_attention(q, k, v, k_ctx, v_ctx, sink, scale):
    bsz, n, kvh, g, d = q.shape
    nblk = n // BLOCK
    pad = ((0, 0), (BLOCK, BLOCK), (0, 0), (0, 0))
    kp = jnp.pad(k, pad).reshape(bsz, nblk + 2, BLOCK, kvh, d)
    vp = jnp.pad(v, pad).reshape(bsz, nblk + 2, BLOCK, kvh, d)
    k_band = jnp.concatenate([kp[:, :-2], kp[:, 1:-1], kp[:, 2:]], axis=2)
    v_band = jnp.concatenate([vp[:, :-2], vp[:, 1:-1], vp[:, 2:]], axis=2)
    qb = q.reshape(bsz, nblk, BLOCK, kvh, g, d)
    s_loc = jnp.einsum('bnqhgd,bnkhd->bnhgqk', qb, k_band).astype(jnp.float32) * scale
    s_ctx = jnp.einsum('bnqhgd,bkhd->bnhgqk', qb, k_ctx).astype(jnp.float32) * scale
    blk = jnp.arange(nblk)[:, None, None] * BLOCK
    q_pos = blk + jnp.arange(BLOCK)[None, :, None]
    k_pos = blk - BLOCK + jnp.arange(3 * BLOCK)[None, None, :]
    valid = (jnp.abs(k_pos - q_pos) <= WINDOW) & (k_pos >= 0) & (k_pos < n)
    s_loc = jnp.where(valid[None, :, None, None], s_loc, -jnp.inf)
    sink_col = jnp.broadcast_to(sink.astype(jnp.float32).reshape(kvh, g)[None, None, :, :, None, None], s_ctx.shape[:-1] + (1,))
    p = jax.nn.softmax(jnp.concatenate([s_ctx, s_loc, sink_col], axis=-1), axis=-1).astype(v.dtype)
    m = k_ctx.shape[1]
    out = (jnp.einsum('bnhgqk,bkhd->bnqhgd', p[..., :m], v_ctx)
           + jnp.einsum('bnhgqk,bnkhd->bnqhgd', p[..., m:m + 3 * BLOCK], v_band))
    return out.reshape(bsz, n, kvh * g * d)


def centred_dwconv(u, w, b):
    k = w.shape[0]
    out = lax.conv_general_dilated(u, w[:, None, :].astype(u.dtype), window_strides=(1,),
                                   padding=[(k // 2, k // 2)], dimension_numbers=('NWC', 'WIO', 'NWC'),
                                   feature_group_count=u.shape[-1])
    return out + b


def ssd_scan(x, dt, bm, cm, a, init, with_output):
    bsz, n, nh, hp = x.shape
    nc = n // SSD_CHUNK
    rep = nh // bm.shape[2]
    bh = jnp.repeat(bm, rep, axis=2).reshape(bsz, nc, SSD_CHUNK, nh, -1)
    xdt = (x * dt[..., None]).reshape(bsz, nc, SSD_CHUNK, nh, hp)
    a_cum = jnp.cumsum((dt * a).reshape(bsz, nc, SSD_CHUNK, nh), axis=2)
    a_tot = a_cum[:, :, -1]
    states = jnp.einsum('bckhn,bckhp->bchpn', bh * jnp.exp(a_tot[:, :, None] - a_cum)[..., None], xdt)

    def step(s, inp):
        st, at = inp
        return s * jnp.exp(at)[:, :, None, None] + st, s

    final, prev = lax.scan(step, init, (jnp.moveaxis(states, 1, 0), jnp.moveaxis(a_tot, 1, 0)))
    if not with_output:
        return None, final
    prev = jnp.moveaxis(prev, 0, 1)
    ch = jnp.repeat(cm, rep, axis=2).reshape(bsz, nc, SSD_CHUNK, nh, -1)
    seg = a_cum[:, :, :, None, :] - a_cum[:, :, None, :, :]
    lower = jnp.tril(jnp.ones((SSD_CHUNK, SSD_CHUNK), dtype=bool))
    decay = jnp.exp(jnp.where(lower[None, None, :, :, None], seg, -jnp.inf))
    scores = jnp.einsum('bcqhn,bckhn->bcqkh', ch, bh) * decay
    y = (jnp.einsum('bcqkh,bckhp->bcqhp', scores, xdt)
         + jnp.einsum('bcqhn,bchpn->bcqhp', ch, prev) * jnp.exp(a_cum)[..., None])
    return y.reshape(bsz, n, nh, hp), final


def mla_keys(ckv, k_rope, kv_norm_w, w_kv_up, rope):
    bsz, n = ckv.shape[:2]
    kv = (rmsnorm(ckv, kv_norm_w) @ w_kv_up).reshape(bsz, n, MLA_HEADS, MLA_NOPE + MLA_V)
    kr = k_rope[:, :, None, :]
    if rope is not None:
        kr = apply_rope(kr, *rope)
    k = jnp.concatenate([kv[..., :MLA_NOPE], jnp.broadcast_to(kr, (bsz, n, MLA_HEADS, MLA_ROPE))], axis=-1)
    return k, kv[..., MLA_NOPE:]


def mla_queries(cq, q_norm_w, w_q_up, rope):
    bsz, n = cq.shape[:2]
    q = (rmsnorm(cq, q_norm_w) @ w_q_up).reshape(bsz, n, MLA_HEADS, MLA_NOPE + MLA_ROPE)
    if rope is not None:
        q = jnp.concatenate([q[..., :MLA_NOPE], apply_rope(q[..., MLA_NOPE:], *rope)], axis=-1)
    return q[:, :, :, None, :]


def mla_branch(lat, ctx, q_norm_w, kv_norm_w, w_q_up, w_kv_up, rope, need_ctx_out):
    cq, ckv, kr, gate = lat
    cq_c, ckv_c, kr_c, gate_c = ctx
    scale = (MLA_NOPE + MLA_ROPE) ** -0.5
    k_l, v_l = mla_keys(ckv, kr, kv_norm_w, w_kv_up, rope)
    k_c, v_c = mla_keys(ckv_c, kr_c, kv_norm_w, w_kv_up, None)
    q_l = mla_queries(cq, q_norm_w, w_q_up, rope)
    out_l = blocked_attention(q_l, jnp.concatenate([k_c, k_l], 1), jnp.concatenate([v_c, v_l], 1), scale) * jax.nn.silu(gate)
    out_c = None
    if need_ctx_out:
        q_c = mla_queries(cq_c, q_norm_w, w_q_up, None)
        out_c = blocked_attention(q_c, k_c, v_c, scale) * jax.nn.silu(gate_c)
    return out_l, out_c


def global_gqa_branch(lat, ctx, q_norm_w, k_norm_w, rope, need_ctx_out):
    q, k, v, gate = lat
    q_c, k_c, v_c, gate_c = ctx
    bsz, n = q.shape[:2]
    m = k_c.shape[1]
    g = GQA_HEADS // GQA_KV_HEADS
    scale = HEAD_DIM ** -0.5
    q = apply_rope(rmsnorm(q.reshape(bsz, n, GQA_HEADS, HEAD_DIM), q_norm_w), *rope).reshape(bsz, n, GQA_KV_HEADS, g, HEAD_DIM)
    k = apply_rope(rmsnorm(k.reshape(bsz, n, GQA_KV_HEADS, HEAD_DIM), k_norm_w), *rope)
    v = v.reshape(bsz, n, GQA_KV_HEADS, HEAD_DIM)
    k_c = rmsnorm(k_c.reshape(bsz, m, GQA_KV_HEADS, HEAD_DIM), k_norm_w)
    v_c = v_c.reshape(bsz, m, GQA_KV_HEADS, HEAD_DIM)
    out_l = blocked_attention(q, jnp.concatenate([k_c, k], 1), jnp.concatenate([v_c, v], 1), scale) * jax.nn.silu(gate)
    out_c = None
    if need_ctx_out:
        q_c = rmsnorm(q_c.reshape(bsz, m, GQA_HEADS, HEAD_DIM), q_norm_w).reshape(bsz, m, GQA_KV_HEADS, g, HEAD_DIM)
        out_c = blocked_attention(q_c, k_c, v_c, scale) * jax.nn.silu(gate_c)
    return out_l, out_c


def window_gqa_branch(lat, ctx, sink, rope, need_ctx_out):
    q, k, v, gate = lat
    q_c, k_c, v_c, gate_c = ctx
    bsz, n = q.shape[:2]
    m = k_c.shape[1]
    g = SWA_HEADS // SWA_KV_HEADS
    scale = HEAD_DIM ** -0.5
    q = apply_rope(q.reshape(bsz, n, SWA_HEADS, HEAD_DIM), *rope).reshape(bsz, n, SWA_KV_HEADS, g, HEAD_DIM)
    k = apply_rope(k.reshape(bsz, n, SWA_KV_HEADS, HEAD_DIM), *rope)
    v = v.reshape(bsz, n, SWA_KV_HEADS, HEAD_DIM)
    k_c = k_c.reshape(bsz, m, SWA_KV_HEADS, HEAD_DIM)
    v_c = v_c.reshape(bsz, m, SWA_KV_HEADS, HEAD_DIM)
    out_l = window_sink_attention(q, k, v, k_c, v_c, sink, scale) * jax.nn.silu(gate)
    out_c = None
    if need_ctx_out:
        q_c = q_c.reshape(bsz, m, SWA_KV_HEADS, g, HEAD_DIM)
        out_c = dense_sink_attention(q_c, k_c, v_c, sink, scale) * jax.nn.silu(gate_c)
    return out_l, out_c


def ssd_prep(xbc, conv_w, conv_b):
    u = jax.nn.silu(centred_dwconv(xbc, conv_w, conv_b))
    xs, bm, cm = jnp.split(u, [SSD_INNER, SSD_INNER + SSD_GROUPS * SSD_STATE], axis=-1)
    bsz, n = xs.shape[:2]
    return (xs.reshape(bsz, n, SSD_HEADS, SSD_HEAD_DIM), bm.reshape(bsz, n, SSD_GROUPS, SSD_STATE),
            cm.reshape(bsz, n, SSD_GROUPS, SSD_STATE))


def ssd_branch(lat, ctx, conv_w, conv_b, a_log, dt_bias, d_skip, norm_w, need_ctx_out):
    z_l, xbc_l, dt_l = lat
    z_c, xbc_c, dt_c = ctx
    x_l, b_l, c_l = ssd_prep(xbc_l, conv_w, conv_b)
    x_c, b_c, c_c = ssd_prep(xbc_c, conv_w, conv_b)
    bsz = x_l.shape[0]
    skip = d_skip.astype(jnp.float32)[None, None, :, None]
    y_l = skip * x_l
    y_c = skip * x_c if need_ctx_out else None
    for direction in range(2):
        a = -jnp.exp(a_log[direction].astype(jnp.float32))
        sl = slice(direction * SSD_HEADS, (direction + 1) * SSD_HEADS)
        bias = dt_bias[direction].astype(jnp.float32)
        seq_l = [x_l, jax.nn.softplus(dt_l[..., sl].astype(jnp.float32) + bias), b_l, c_l]
        seq_c = [x_c, jax.nn.softplus(dt_c[..., sl].astype(jnp.float32) + bias), b_c, c_c]
        if direction == 1:
            seq_l = [jnp.flip(t, axis=1) for t in seq_l]
            seq_c = [jnp.flip(t, axis=1) for t in seq_c]
        init = jnp.zeros((bsz, SSD_HEADS, SSD_HEAD_DIM, SSD_STATE), jnp.float32)
        yc_dir, s_ctx = ssd_scan(*seq_c, a, init, need_ctx_out)
        yl_dir, _ = ssd_scan(*seq_l, a, s_ctx, True)
        if direction == 1:
            yl_dir = jnp.flip(yl_dir, axis=1)
            yc_dir = jnp.flip(yc_dir, axis=1) if need_ctx_out else None
        y_l = y_l + yl_dir
        if need_ctx_out:
            y_c = y_c + yc_dir
    n = x_l.shape[1]
    out_l = rmsnorm(y_l.reshape(bsz, n, SSD_INNER) * jax.nn.silu(z_l), norm_w).astype(z_l.dtype)
    out_c = None
    if need_ctx_out:
        m = x_c.shape[1]
        out_c = rmsnorm(y_c.reshape(bsz, m, SSD_INNER) * jax.nn.silu(z_c), norm_w).astype(z_c.dtype)
    return out_l, out_c


def hybrid_layer(x, xc, c, c_ctx, norm_w, w_mod, b_mod, w_in, mla_q_norm, mla_kv_norm, mla_w_q_up, mla_w_kv_up,
                 gqa_q_norm, gqa_k_norm, swa_sink, ssd_conv_w, ssd_conv_b, ssd_a_log, ssd_dt_bias, ssd_d,
                 ssd_norm_w, w_out, rope_mla, rope_head, need_ctx_out):
    shift, scale, gate = jnp.split(jax.nn.silu(c) @ w_mod + b_mod, 3, axis=-1)
    shift_c, scale_c, gate_c = jnp.split(jax.nn.silu(c_ctx) @ w_mod + b_mod, 3, axis=-1)
    h = rmsnorm(x, norm_w) * (1 + scale[:, None]) + shift[:, None]
    hc = rmsnorm(xc, norm_w) * (1 + scale_c) + shift_c
    pl = split_cols(h @ w_in, IN_WIDTHS)
    pc = split_cols(hc @ w_in, IN_WIDTHS)
    ya_l, ya_c = mla_branch(pl[0:4], pc[0:4], mla_q_norm, mla_kv_norm, mla_w_q_up, mla_w_kv_up, rope_mla, need_ctx_out)
    yb_l, yb_c = global_gqa_branch(pl[4:8], pc[4:8], gqa_q_norm, gqa_k_norm, rope_head, need_ctx_out)
    yc_l, yc_c = window_gqa_branch(pl[8:12], pc[8:12], swa_sink, rope_head, need_ctx_out)
    yd_l, yd_c = ssd_branch(pl[12:15], pc[12:15], ssd_conv_w, ssd_conv_b, ssd_a_log, ssd_dt_bias, ssd_d,
                            ssd_norm_w, need_ctx_out)
    x = x + gate[:, None] * (jnp.concatenate([ya_l, yb_l, yc_l, yd_l], axis=-1) @ w_out)
    if need_ctx_out:
        xc = xc + gate_c * (jnp.concatenate([ya_c, yb_c, yc_c, yd_c], axis=-1) @ w_out)
    return x, xc


def setup_inputs(seed: int = 0) -> dict:
    key = jax.random.key(seed)
    ks = jax.random.split(key, 24)
    f32 = jnp.float32

    def nrm(k, shape, s):
        return jax.random.normal(k, shape, f32) * s

    dt_init = jnp.exp(jax.random.uniform(ks[18], (DEPTH, 2, SSD_HEADS), f32, jnp.log(1e-3), jnp.log(1e-1)))
    return {
        'x': nrm(ks[0], (BATCH, SEQ, D_MODEL), 1.0),
        'c': nrm(ks[1], (BATCH, D_MODEL), 1.0),
        'ctx': nrm(ks[2], (BATCH, CTX_LEN, D_MODEL), 1.0),
        'c_ctx': nrm(ks[3], (D_MODEL,), 1.0),
        'norm_w': 1.0 + nrm(ks[4], (DEPTH, D_MODEL), 0.02),
        'w_mod': nrm(ks[5], (DEPTH, D_MODEL, 3 * D_MODEL), 0.5 * D_MODEL ** -0.5),
        'b_mod': nrm(ks[6], (DEPTH, 3 * D_MODEL), 0.01),
        'w_in': nrm(ks[7], (DEPTH, D_MODEL, IN_COLS), D_MODEL ** -0.5),
        'mla_q_norm': 1.0 + nrm(ks[8], (DEPTH, MLA_Q_RANK), 0.02),
        'mla_kv_norm': 1.0 + nrm(ks[9], (DEPTH, MLA_KV_RANK), 0.02),
        'mla_w_q_up': nrm(ks[10], (DEPTH, MLA_Q_RANK, MLA_HEADS * (MLA_NOPE + MLA_ROPE)), MLA_Q_RANK ** -0.5),
        'mla_w_kv_up': nrm(ks[11], (DEPTH, MLA_KV_RANK, MLA_HEADS * (MLA_NOPE + MLA_V)), MLA_KV_RANK ** -0.5),
        'gqa_q_norm': 1.0 + nrm(ks[12], (DEPTH, HEAD_DIM), 0.02),
        'gqa_k_norm': 1.0 + nrm(ks[13], (DEPTH, HEAD_DIM), 0.02),
        'swa_sink': nrm(ks[14], (DEPTH, SWA_HEADS), 0.5),
        'ssd_conv_w': nrm(ks[15], (DEPTH, SSD_CONV, SSD_CONV_DIM), SSD_CONV ** -0.5),
        'ssd_conv_b': nrm(ks[16], (DEPTH, SSD_CONV_DIM), 0.01),
        'ssd_a_log': jnp.log(jax.random.uniform(ks[17], (DEPTH, 2, SSD_HEADS), f32, 1.0, 16.0)),
        'ssd_dt_bias': dt_init + jnp.log(-jnp.expm1(-dt_init)),
        'ssd_d': 1.0 + nrm(ks[19], (DEPTH, SSD_HEADS), 0.02),
        'ssd_norm_w': 1.0 + nrm(ks[20], (DEPTH, SSD_INNER), 0.02),
        'w_out': nrm(ks[21], (DEPTH, D_MIX, D_MODEL), D_MIX ** -0.5),
        'final_norm_w': 1.0 + nrm(ks[22], (D_MODEL,), 0.02),
    }


def reference(x, c, ctx, c_ctx, norm_w, w_mod, b_mod, w_in, mla_q_norm, mla_kv_norm, mla_w_q_up, mla_w_kv_up,
              gqa_q_norm, gqa_k_norm, swa_sink, ssd_conv_w, ssd_conv_b, ssd_a_log, ssd_dt_bias, ssd_d,
              ssd_norm_w, w_out, final_norm_w):
    n = x.shape[1]
    rope_head = axial_rope(n, HEAD_DIM)
    rope_mla = axial_rope(n, MLA_ROPE)
    xc = ctx
    for i in range(DEPTH):
        x, xc = hybrid_layer(x, xc, c, c_ctx, norm_w[i], w_mod[i], b_mod[i], w_in[i], mla_q_norm[i], mla_kv_norm[i],
                             mla_w_q_up[i], mla_w_kv_up[i], gqa_q_norm[i], gqa_k_norm[i], swa_sink[i],
                             ssd_conv_w[i], ssd_conv_b[i], ssd_a_log[i], ssd_dt_bias[i], ssd_d[i], ssd_norm_w[i],
                             w_out[i], rope_mla, rope_head, i < DEPTH - 1)
    return rmsnorm(x, final_norm_w)
```

```cpp
#include <hip/hip_runtime.h>
#include <stdint.h>
#include <math.h>

typedef unsigned short bf16_t;
__device__ __forceinline__ float bf2f(bf16_t v) { return __uint_as_float(((unsigned)v) << 16); }
__device__ __forceinline__ bf16_t f2bf(float f) { unsigned u = __float_as_uint(f); return (bf16_t)((u + 0x7fffu + ((u >> 16) & 1u)) >> 16); }
__device__ __forceinline__ float silu_f(float v) { return v / (1.f + __expf(-v)); }

constexpr int DM = 1024, NB = 4, SEQ = 4096, CTX = 256, SPB = CTX + SEQ  , MROWS = NB * SPB  ;
constexpr int DEPTH = 4, GRIDW = 64;
constexpr int IN_COLS = 3240;
constexpr int NTMP = 1280, NKEEP = 2048;
constexpr float EPS = 1e-6f;
constexpr float LOG2E = 1.4426950408889634f;
constexpr int T_CQ = 0, T_CKV = 256, T_KR = 384, T_DT = 416, T_XBC = 512;
constexpr int K_GA = 0, K_BQ = 256, K_BK = 512, K_BV = 640, K_BG = 768, K_CQ = 1024, K_CK = 1280, K_CV = 1408, K_CG = 1536, K_Z = 1792;

constexpr size_t MiB = 1u << 20;
constexpr size_t WS_CTL = 0;
constexpr size_t WS_MOD = 1 * MiB;
constexpr size_t WS_ROPE64 = 2 * MiB;
constexpr size_t WS_ROPE32 = 3 * MiB;
constexpr size_t WS_DT = 4 * MiB;
constexpr size_t WS_XC = 5 * MiB;
constexpr size_t WS_H = 9 * MiB;
constexpr size_t WS_TMP = 43 * MiB;
constexpr size_t WS_KEEP = 86 * MiB;
constexpr size_t WS_QA = 154 * MiB;
constexpr size_t WS_KA = 167 * MiB;
constexpr size_t WS_VA = 180 * MiB;
constexpr size_t WS_U = 189 * MiB;
constexpr size_t WS_END = 215 * MiB;

struct P {
    const float *x, *c, *ctx, *c_ctx, *norm_w, *w_mod, *b_mod, *w_in, *mla_q_norm, *mla_kv_norm, *w_q_up, *w_kv_up, *gqa_q_norm, *gqa_k_norm,
        *swa_sink, *conv_w, *conv_b, *a_log, *dt_bias, *ssd_d, *ssd_norm_w, *w_out, *final_norm_w;
    float* out; unsigned char* ws;
};


__global__ void __launch_bounds__(256) mod_kernel(P p) {
    __shared__ float sc[5][DM];
    const int l = blockIdx.y, j = blockIdx.x * 256 + threadIdx.x;
    for (int i = threadIdx.x; i < 5 * DM; i += 256) { const int r = i / DM, k = i % DM; const float v = r < 4 ? p.c[r * DM + k] : p.c_ctx[k]; sc[r][k] = silu_f(v); }
    __syncthreads();
    const float* w = p.w_mod + (size_t)l * DM * 3072 + j;
    float acc[5]; const float b = p.b_mod[l * 3072 + j];
#pragma unroll
    for (int r = 0; r < 5; ++r) acc[r] = b;
    for (int k = 0; k < DM; ++k) { const float wv = w[(size_t)k * 3072];
#pragma unroll
        for (int r = 0; r < 5; ++r) acc[r] += sc[r][k] * wv; }
    float* mod = (float*)(p.ws + WS_MOD) + (size_t)l * 5 * 3072;
#pragma unroll
    for (int r = 0; r < 5; ++r) mod[r * 3072 + j] = acc[r];
}

__device__ __forceinline__ void sincos_acc(float ang, float& c, float& s) {
    const double x = (double)ang; const double jd = rint(x * 0.63661977236758134308); const int j = (int)jd;
    const float y = (float)(x - jd * 1.57079632679489661923); const float z = y * y;
    const float sn = y + y * z * (-1.6666654611e-1f + z * (8.3321608736e-3f + z * (-1.9515295891e-4f)));
    const float cs = 1.f - 0.5f * z + z * z * (4.166664568298827e-2f + z * (-1.388731625493765e-3f + z * 2.443315711809948e-5f));
    switch (j & 3) { case 0: c = cs; s = sn; break; case 1: c = -sn; s = cs; break; case 2: c = -cs; s = -sn; break; default: c = sn; s = -cs; break; }
}
__global__ void rope_kernel(P p) {
    const int idx = blockIdx.x * 256 + threadIdx.x;
    if (idx >= SEQ * 48) return;
    const int t = idx / 48, i = idx % 48; const float row = (float)(t / GRIDW), col = (float)(t % GRIDW);
    if (i < 32) { const int f = i & 15; const float invf = powf(10000.f, -(float)f / 16.f); const float ang = (i < 16 ? row : col) * invf; float c, s; sincos_acc(ang, c, s);
        float* o = (float*)(p.ws + WS_ROPE64) + ((size_t)t * 32 + i) * 2; o[0] = c; o[1] = s; }
    else { const int ii = i - 32, f = ii & 7; const float invf = powf(10000.f, -(float)f / 8.f); const float ang = (ii < 8 ? row : col) * invf; float c, s; sincos_acc(ang, c, s);
        float* o = (float*)(p.ws + WS_ROPE32) + ((size_t)t * 16 + ii) * 2; o[0] = c; o[1] = s; }
}

__device__ __forceinline__ const float* xrow_in(const P& p, int layer, int r) {
    const int b = r / SPB, s = r % SPB;
    if (s < CTX) return (layer == 0 ? p.ctx : (const float*)(p.ws + WS_XC)) + ((size_t)b * CTX + s) * DM;
    return (layer == 0 ? p.x : (const float*)p.out) + ((size_t)b * SEQ + (s - CTX)) * DM;
}
__device__ __forceinline__ float* xrow_out(const P& p, int r) {
    const int b = r / SPB, s = r % SPB;
    if (s < CTX) return (float*)(p.ws + WS_XC) + ((size_t)b * CTX + s) * DM;
    return p.out + ((size_t)b * SEQ + (s - CTX)) * DM;
}
__device__ __forceinline__ float wave_sum(float v) {
#pragma unroll
    for (int o = 1; o < 64; o <<= 1) v += __shfl_xor(v, o);
    return v;
}

__global__ void __launch_bounds__(256) norm_kernel(P p, int layer) {
    const int r = blockIdx.x * 4 + (threadIdx.x >> 6), lane = threadIdx.x & 63;
    const float* xr = xrow_in(p, layer, r); const int b = r / SPB, s = r % SPB; const int mr = s < CTX ? 4 : b;
    const float* mod = (const float*)(p.ws + WS_MOD) + ((size_t)layer * 5 + mr) * 3072; const float* nw = p.norm_w + layer * DM;
    float v[16]; float ss = 0.f;
#pragma unroll
    for (int j = 0; j < 4; ++j) { const float4 t = *(const float4*)(xr + j * 256 + lane * 4); v[4 * j] = t.x; v[4 * j + 1] = t.y; v[4 * j + 2] = t.z; v[4 * j + 3] = t.w; ss += t.x * t.x + t.y * t.y + t.z * t.z + t.w * t.w; }
    const float rstd = rsqrtf(wave_sum(ss) * (1.f / DM) + EPS);
    bf16_t* h = (bf16_t*)(p.ws + WS_H) + (size_t)r * DM;
#pragma unroll
    for (int j = 0; j < 4; ++j)
#pragma unroll
        for (int e = 0; e < 4; ++e) { const int col = j * 256 + lane * 4 + e; h[col] = f2bf(v[4 * j + e] * rstd * nw[col] * (1.f + mod[1024 + col]) + mod[col]); }
}

__device__ __forceinline__ int in_col_map(int n) {
    if (n < 416) return n; if (n < 424) return 3232 + (n - 416); if (n < 512) return -1; if (n < 1280) return 2464 + (n - 512); return 416 + (n - 1280);
}
template <int MODE> __global__ void __launch_bounds__(256) gemm_naive(P p, int layer) {
    __shared__ float As[16][65], Ws[16][65];
    const int tid = threadIdx.x, tx = tid & 15, ty = tid >> 4; const int m0 = blockIdx.y * 64, n0 = blockIdx.x * 64;
    const bf16_t* A = (const bf16_t*)(p.ws + WS_H); const int ldw = MODE == 0 ? IN_COLS : DM;
    const float* W = MODE == 0 ? p.w_in + (size_t)layer * DM * IN_COLS : p.w_out + (size_t)layer * DM * DM;
    float acc[4][4] = {};
    const int lr = tid >> 2, lk = (tid & 3) * 4;
    const int wk = tid >> 4, wn = (tid & 15) * 4;
    int wc[4];
#pragma unroll
    for (int e = 0; e < 4; ++e) wc[e] = MODE == 0 ? in_col_map(n0 + wn + e) : n0 + wn + e;
    for (int k0 = 0; k0 < DM; k0 += 16) {
        const uint2 av = *(const uint2*)(A + (size_t)(m0 + lr) * DM + k0 + lk);
        As[lk][lr] = __uint_as_float(av.x << 16); As[lk + 1][lr] = __uint_as_float(av.x & 0xffff0000u); As[lk + 2][lr] = __uint_as_float(av.y << 16); As[lk + 3][lr] = __uint_as_float(av.y & 0xffff0000u);
#pragma unroll
        for (int e = 0; e < 4; ++e) Ws[wk][wn + e] = wc[e] >= 0 ? W[(size_t)(k0 + wk) * ldw + wc[e]] : 0.f;
        __syncthreads();
#pragma unroll
        for (int k = 0; k < 16; ++k) { float a[4], w[4];
#pragma unroll
            for (int i = 0; i < 4; ++i) { a[i] = As[k][ty * 4 + i]; w[i] = Ws[k][tx * 4 + i]; }
#pragma unroll
            for (int i = 0; i < 4; ++i)
#pragma unroll
                for (int j = 0; j < 4; ++j) acc[i][j] += a[i] * w[j]; }
        __syncthreads();
    }
#pragma unroll
    for (int i = 0; i < 4; ++i) { const int r = m0 + ty * 4 + i;
        if (MODE == 0) {
#pragma unroll
            for (int j = 0; j < 4; ++j) { const int n = n0 + tx * 4 + j;
                if (n < NTMP) ((bf16_t*)(p.ws + WS_TMP))[(size_t)r * NTMP + n] = f2bf(acc[i][j]); else ((bf16_t*)(p.ws + WS_KEEP))[(size_t)r * NKEEP + (n - NTMP)] = f2bf(acc[i][j]); }
        } else {
            const int b = r / SPB, s = r % SPB; const int mr = s < CTX ? 4 : b; const float* gate = (const float*)(p.ws + WS_MOD) + ((size_t)layer * 5 + mr) * 3072 + 2048;
            const float* xi = xrow_in(p, layer, r); float* xo = xrow_out(p, r);
#pragma unroll
            for (int j = 0; j < 4; ++j) { const int n = n0 + tx * 4 + j; xo[n] = xi[n] + gate[n] * acc[i][j]; }
        }
    }
}

__global__ void __launch_bounds__(256) prep_mla_kernel(P p, int layer) {
    __shared__ float sq[8][256], skv[8][128], oq[8][384], okv[8][512], skr[8][32];
    const int tid = threadIdx.x, r0 = blockIdx.x * 8; const bf16_t* tmp = (const bf16_t*)(p.ws + WS_TMP);
    const float* qn = p.mla_q_norm + layer * 256; const float* kvn = p.mla_kv_norm + layer * 128;
    { const int rr = tid >> 5, l32 = tid & 31; const bf16_t* row = tmp + (size_t)(r0 + rr) * NTMP;
        float v[8], ss = 0.f;
#pragma unroll
        for (int j = 0; j < 8; ++j) { v[j] = bf2f(row[T_CQ + l32 + 32 * j]); ss += v[j] * v[j]; }
#pragma unroll
        for (int o = 1; o < 32; o <<= 1) ss += __shfl_xor(ss, o);
        const float rs = rsqrtf(ss * (1.f / 256.f) + EPS);
#pragma unroll
        for (int j = 0; j < 8; ++j) sq[rr][l32 + 32 * j] = v[j] * rs * qn[l32 + 32 * j];
        float w[4], s2 = 0.f;
#pragma unroll
        for (int j = 0; j < 4; ++j) { w[j] = bf2f(row[T_CKV + l32 + 32 * j]); s2 += w[j] * w[j]; }
#pragma unroll
        for (int o = 1; o < 32; o <<= 1) s2 += __shfl_xor(s2, o);
        const float rs2 = rsqrtf(s2 * (1.f / 128.f) + EPS);
#pragma unroll
        for (int j = 0; j < 4; ++j) skv[rr][l32 + 32 * j] = w[j] * rs2 * kvn[l32 + 32 * j];
        skr[rr][l32] = bf2f(row[T_KR + l32]);
    }
    __syncthreads();
    const float* wq = p.w_q_up + (size_t)layer * 256 * 384; const float* wkv = p.w_kv_up + (size_t)layer * 128 * 512;
    for (int col = tid; col < 384; col += 256) { float acc[8] = {};
        for (int k = 0; k < 256; ++k) { const float w = wq[k * 384 + col];
#pragma unroll
            for (int r = 0; r < 8; ++r) acc[r] += sq[r][k] * w; }
#pragma unroll
        for (int r = 0; r < 8; ++r) oq[r][col] = acc[r]; }
    for (int col = tid; col < 512; col += 256) { float acc[8] = {};
        for (int k = 0; k < 128; ++k) { const float w = wkv[k * 512 + col];
#pragma unroll
            for (int r = 0; r < 8; ++r) acc[r] += skv[r][k] * w; }
#pragma unroll
        for (int r = 0; r < 8; ++r) okv[r][col] = acc[r]; }
    __syncthreads();
    bf16_t* QA = (bf16_t*)(p.ws + WS_QA); bf16_t* KA = (bf16_t*)(p.ws + WS_KA); bf16_t* VA = (bf16_t*)(p.ws + WS_VA);
    const float qscale = LOG2E / sqrtf(96.f);
    for (int i = tid; i < 8 * 384; i += 256) { const int rr = i / 384, col = i % 384, h = col / 96, d = col % 96; const int r = r0 + rr, s = r % SPB;
        float v = oq[rr][col];
        if (d >= 64 && s >= CTX) { const int t = s - CTX, e = d - 64, ii = e & 15; const float* cs = (const float*)(p.ws + WS_ROPE32) + ((size_t)t * 16 + ii) * 2;
            const float x1 = oq[rr][h * 96 + 64 + ii], x2 = oq[rr][h * 96 + 80 + ii]; v = e < 16 ? x1 * cs[0] - x2 * cs[1] : x1 * cs[1] + x2 * cs[0]; }
        QA[(size_t)r * 384 + col] = f2bf(v * qscale);
        float kv;
        if (d < 64) kv = okv[rr][h * 128 + d];
        else { const int e = d - 64, ii = e & 15; const float x1 = skr[rr][ii], x2 = skr[rr][16 + ii];
            if (s >= CTX) { const int t = s - CTX; const float* cs = (const float*)(p.ws + WS_ROPE32) + ((size_t)t * 16 + ii) * 2; kv = e < 16 ? x1 * cs[0] - x2 * cs[1] : x1 * cs[1] + x2 * cs[0]; }
            else kv = skr[rr][e]; }
        KA[(size_t)r * 384 + col] = f2bf(kv);
    }
    for (int i = tid; i < 8 * 256; i += 256) { const int rr = i / 256, col = i % 256, h = col / 64, d = col % 64; VA[(size_t)(r0 + rr) * 256 + col] = f2bf(okv[rr][h * 128 + 64 + d]); }
}

__global__ void __launch_bounds__(256) prep_bc_kernel(P p, int layer) {
    const int r = blockIdx.x * 4 + (threadIdx.x >> 6), lane = threadIdx.x & 63, half = lane >> 5, i = lane & 31;
    const int s = r % SPB; const bool lat = s >= CTX; const int t = s - CTX;
    bf16_t* row = (bf16_t*)(p.ws + WS_KEEP) + (size_t)r * NKEEP;
    float cs0 = 1.f, sn0 = 0.f; if (lat) { const float* cs = (const float*)(p.ws + WS_ROPE64) + ((size_t)t * 32 + i) * 2; cs0 = cs[0]; sn0 = cs[1]; }
    const float qscale = 0.125f * LOG2E;
#pragma unroll
    for (int it = 0; it < 6; ++it) { const int hv = it * 2 + half; int off; bool isq, nrm; const float* nw = nullptr;
        if (hv < 4) { off = K_BQ + hv * 64; isq = true; nrm = true; nw = p.gqa_q_norm + layer * 64; }
        else if (hv < 6) { off = K_BK + (hv - 4) * 64; isq = false; nrm = true; nw = p.gqa_k_norm + layer * 64; }
        else if (hv < 10) { off = K_CQ + (hv - 6) * 64; isq = true; nrm = false; }
        else { off = K_CK + (hv - 10) * 64; isq = false; nrm = false; }
        float x1 = bf2f(row[off + i]), x2 = bf2f(row[off + 32 + i]);
        if (nrm) { float ss = x1 * x1 + x2 * x2;
#pragma unroll
            for (int o = 1; o < 32; o <<= 1) ss += __shfl_xor(ss, o);
            const float rs = rsqrtf(ss * (1.f / 64.f) + EPS); x1 = x1 * rs * nw[i]; x2 = x2 * rs * nw[32 + i]; }
        float y1 = x1 * cs0 - x2 * sn0, y2 = x1 * sn0 + x2 * cs0;
        if (isq) { y1 *= qscale; y2 *= qscale; }
        row[off + i] = f2bf(y1); row[off + 32 + i] = f2bf(y2);
    }
}

__global__ void __launch_bounds__(256) prep_d_kernel(P p, int layer) {
    const int r = blockIdx.x, tid = threadIdx.x; const int s = r % SPB; const bool lat = s >= CTX; const int pos = lat ? s - CTX : s, len = lat ? SEQ : CTX;
    const bf16_t* tmp = (const bf16_t*)(p.ws + WS_TMP); bf16_t* U = (bf16_t*)(p.ws + WS_U) + (size_t)r * 768;
    const float* cw = p.conv_w + (size_t)layer * 5 * 768; const float* cb = p.conv_b + layer * 768;
    for (int c = tid; c < 768; c += 256) { float a = cb[c];
#pragma unroll
        for (int j = 0; j < 5; ++j) { const int pp = pos + j - 2; if (pp >= 0 && pp < len) a += cw[j * 768 + c] * bf2f(tmp[(size_t)(r + j - 2) * NTMP + T_XBC + c]); }
        U[c] = f2bf(silu_f(a)); }
    if (tid < 8) { const float v = bf2f(tmp[(size_t)r * NTMP + T_DT + tid]) + p.dt_bias[layer * 8 + tid]; const float sp = v > 20.f ? v : log1pf(__expf(v)); ((float*)(p.ws + WS_DT))[(size_t)r * 8 + tid] = sp; }
}

template <int GROUP> __global__ void __launch_bounds__(256) attn_naive(P p, int layer, int qkind) {
    constexpr int DQ = GROUP == 0 ? 96 : 64, DV = 64;
    __shared__ __attribute__((aligned(16))) float Ks[64][DQ], Vs[64][DV];
    const int tid = threadIdx.x, qb = blockIdx.x, h = blockIdx.y, b = blockIdx.z; const int kvh = GROUP == 0 ? h : h >> 1;
    const int srow = qkind == 0 ? CTX + qb * 256 + tid : tid;
    const size_t r = (size_t)b * SPB + srow;
    const bf16_t *Qp, *Kp, *Vp, *Gp; int ldq, ldk, ldv;
    if (GROUP == 0) { Qp = (const bf16_t*)(p.ws + WS_QA) + h * 96; ldq = 384; Kp = (const bf16_t*)(p.ws + WS_KA) + h * 96; ldk = 384; Vp = (const bf16_t*)(p.ws + WS_VA) + h * 64; ldv = 256; Gp = (const bf16_t*)(p.ws + WS_KEEP) + K_GA + h * 64; }
    else if (GROUP == 1) { const bf16_t* kp = (const bf16_t*)(p.ws + WS_KEEP); Qp = kp + K_BQ + h * 64; Kp = kp + K_BK + kvh * 64; Vp = kp + K_BV + kvh * 64; Gp = kp + K_BG + h * 64; ldq = ldk = ldv = NKEEP; }
    else { const bf16_t* kp = (const bf16_t*)(p.ws + WS_KEEP); Qp = kp + K_CQ + h * 64; Kp = kp + K_CK + kvh * 64; Vp = kp + K_CV + kvh * 64; Gp = kp + K_CG + h * 64; ldq = ldk = ldv = NKEEP; }
    float q[DQ];
#pragma unroll
    for (int d = 0; d < DQ; ++d) q[d] = bf2f(Qp[r * ldq + d]);
    float o[DV];
#pragma unroll
    for (int d = 0; d < DV; ++d) o[d] = 0.f;
    float m = -INFINITY, l = 0.f;
    int k_lo = 0, k_hi = CTX;
    int w_lo = 0, w_hi = 0;
    if (qkind == 0) { if (GROUP == 2) { const int t0 = qb * 256; w_lo = CTX + max(t0 - 128, 0); w_hi = CTX + min(t0 + 255 + 128, SEQ - 1) + 1; } else { w_lo = CTX; w_hi = SPB; } }
    const int tq = srow - CTX;
    for (int pass = 0; pass < 2; ++pass) {
        const int lo = pass == 0 ? k_lo : w_lo, hi = pass == 0 ? k_hi : w_hi;
        for (int kt = lo; kt < hi; kt += 64) {
            __syncthreads();
            for (int i = tid; i < 64 * DQ; i += 256) { const int kk = i / DQ, d = i % DQ; Ks[kk][d] = (kt + kk < hi) ? bf2f(Kp[((size_t)b * SPB + kt + kk) * ldk + d]) : 0.f; }
            for (int i = tid; i < 64 * DV; i += 256) { const int kk = i / DV, d = i % DV; Vs[kk][d] = (kt + kk < hi) ? bf2f(Vp[((size_t)b * SPB + kt + kk) * ldv + d]) : 0.f; }
            __syncthreads();
#pragma unroll 1
            for (int j = 0; j < 64; ++j) { float a = 0.f;
#pragma unroll
                for (int d = 0; d < DQ; ++d) a += q[d] * Ks[j][d];
                const int kpos = kt + j; bool valid = kpos < hi;
                if (GROUP == 2 && pass == 1) { const int tk = kpos - CTX; valid = valid && (tk - tq <= 128) && (tq - tk <= 128); }
                const float sv = valid ? a : -INFINITY; const float mx = fmaxf(m, sv);
                const float f = exp2f(m - mx), pj = exp2f(sv - mx); m = mx; l = l * f + pj;
#pragma unroll
                for (int d = 0; d < DV; ++d) o[d] = o[d] * f + pj * Vs[j][d]; }
        }
    }
    if (GROUP == 2) { const float sk = p.swa_sink[layer * 4 + h] * LOG2E; const float mx = fmaxf(m, sk); const float f = exp2f(m - mx); l = l * f + exp2f(sk - mx);
#pragma unroll
        for (int d = 0; d < DV; ++d) o[d] *= f; }
    const float il = 1.f / l;
    bf16_t* mix = (bf16_t*)(p.ws + WS_H) + r * DM + GROUP * 256 + h * 64;
#pragma unroll
    for (int d = 0; d < DV; ++d) { const float g = bf2f(Gp[r * NKEEP + d]); mix[d] = f2bf(o[d] * il * silu_f(g)); }
}

__global__ void __launch_bounds__(64) ssd_scan_naive(P p, int layer) {
    const int lane = threadIdx.x, pl = lane & 15, nq = lane >> 4; const int pq = blockIdx.x & 3, h = (blockIdx.x >> 2) & 3, dir = (blockIdx.x >> 4) & 1, b = blockIdx.x >> 5;
    const int pcol = h * 64 + pq * 16 + pl, g = h >> 1;
    const bf16_t* U = (const bf16_t*)(p.ws + WS_U); const float* DT = (const float*)(p.ws + WS_DT); float* Y = (float*)(p.ws + WS_TMP) + (size_t)dir * MROWS * 256;
    const float a = -__expf(p.a_log[layer * 8 + dir * 4 + h]);
    float st[32];
#pragma unroll
    for (int n = 0; n < 32; ++n) st[n] = 0.f;
    for (int step = 0; step < SPB; ++step) {
        int s;
        if (step < CTX) s = dir == 0 ? step : CTX - 1 - step; else { const int tt = step - CTX; s = CTX + (dir == 0 ? tt : SEQ - 1 - tt); }
        const size_t r = (size_t)b * SPB + s; const bf16_t* u = U + r * 768;
        const float dt = DT[r * 8 + dir * 4 + h]; const float dA = __expf(dt * a); const float xdt = bf2f(u[pcol]) * dt;
        float y = 0.f;
        const uint4* bp = (const uint4*)(u + 256 + g * 128 + nq * 32); const uint4* cp = (const uint4*)(u + 512 + g * 128 + nq * 32);
#pragma unroll
        for (int v4 = 0; v4 < 4; ++v4) { const uint4 bv = bp[v4], cv = cp[v4]; const unsigned bw[4] = {bv.x, bv.y, bv.z, bv.w}, cw[4] = {cv.x, cv.y, cv.z, cv.w};
#pragma unroll
            for (int e = 0; e < 4; ++e) { const int n = v4 * 8 + e * 2;
                st[n] = st[n] * dA + xdt * __uint_as_float(bw[e] << 16); y += st[n] * __uint_as_float(cw[e] << 16);
                st[n + 1] = st[n + 1] * dA + xdt * __uint_as_float(bw[e] & 0xffff0000u); y += st[n + 1] * __uint_as_float(cw[e] & 0xffff0000u); } }
        y += __shfl_xor(y, 16); y += __shfl_xor(y, 32);
        if (nq == 0) Y[r * 256 + pcol] = y;
    }
}
__global__ void __launch_bounds__(256) ssd_final_kernel(P p, int layer) {
    const int r = blockIdx.x * 4 + (threadIdx.x >> 6), lane = threadIdx.x & 63;
    const bf16_t* U = (const bf16_t*)(p.ws + WS_U) + (size_t)r * 768; const bf16_t* keep = (const bf16_t*)(p.ws + WS_KEEP) + (size_t)r * NKEEP;
    const float* Y0 = (const float*)(p.ws + WS_TMP) + (size_t)r * 256; const float* Y1 = Y0 + (size_t)MROWS * 256;
    float v[4], ss = 0.f;
#pragma unroll
    for (int e = 0; e < 4; ++e) { const int c = lane * 4 + e, h = c >> 6; const float y = p.ssd_d[layer * 4 + h] * bf2f(U[c]) + Y0[c] + Y1[c]; v[e] = y * silu_f(bf2f(keep[K_Z + c])); ss += v[e] * v[e]; }
    const float rs = rsqrtf(wave_sum(ss) * (1.f / 256.f) + EPS);
    bf16_t* mix = (bf16_t*)(p.ws + WS_H) + (size_t)r * DM + 768;
#pragma unroll
    for (int e = 0; e < 4; ++e) { const int c = lane * 4 + e; mix[c] = f2bf(v[e] * rs * p.ssd_norm_w[layer * 256 + c]); }
}

__global__ void __launch_bounds__(256) final_norm_kernel(P p) {
    const int r = blockIdx.x * 4 + (threadIdx.x >> 6), lane = threadIdx.x & 63; float* xr = p.out + (size_t)r * DM;
    float4 v[4]; float ss = 0.f;
#pragma unroll
    for (int j = 0; j < 4; ++j) { v[j] = *(const float4*)(xr + j * 256 + lane * 4); ss += v[j].x * v[j].x + v[j].y * v[j].y + v[j].z * v[j].z + v[j].w * v[j].w; }
    const float rstd = rsqrtf(wave_sum(ss) * (1.f / DM) + EPS);
#pragma unroll
    for (int j = 0; j < 4; ++j) { const float4 w = *(const float4*)(p.final_norm_w + j * 256 + lane * 4); float4 o; o.x = v[j].x * rstd * w.x; o.y = v[j].y * rstd * w.y; o.z = v[j].z * rstd * w.z; o.w = v[j].w * rstd * w.w; *(float4*)(xr + j * 256 + lane * 4) = o; }
}

extern "C" void kernel_launch(void* const* d_in, const int* in_sizes, int n_in, void* d_out, int out_size, void* d_ws, size_t ws_size, hipStream_t stream) {
    if (n_in != 23 || ws_size < WS_END) return;
    P p{};
    const float** f = (const float**)&p;
    for (int i = 0; i < 23; ++i) f[i] = (const float*)d_in[i];
    p.out = (float*)d_out; p.ws = (unsigned char*)d_ws;
    mod_kernel<<<dim3(3072 / 256, DEPTH), 256, 0, stream>>>(p);
    rope_kernel<<<SEQ * 48 / 256, 256, 0, stream>>>(p);
    for (int l = 0; l < DEPTH; ++l) {
        norm_kernel<<<MROWS / 4, 256, 0, stream>>>(p, l);
        gemm_naive<0><<<dim3(3328 / 64, MROWS / 64), 256, 0, stream>>>(p, l);
        prep_mla_kernel<<<MROWS / 8, 256, 0, stream>>>(p, l);
        prep_bc_kernel<<<MROWS / 4, 256, 0, stream>>>(p, l);
        prep_d_kernel<<<MROWS, 256, 0, stream>>>(p, l);
        attn_naive<0><<<dim3(16, 4, NB), 256, 0, stream>>>(p, l, 0);
        attn_naive<1><<<dim3(16, 4, NB), 256, 0, stream>>>(p, l, 0);
        attn_naive<2><<<dim3(16, 4, NB), 256, 0, stream>>>(p, l, 0);
        attn_naive<0><<<dim3(1, 4, NB), 256, 0, stream>>>(p, l, 1);
        attn_naive<1><<<dim3(1, 4, NB), 256, 0, stream>>>(p, l, 1);
        attn_naive<2><<<dim3(1, 4, NB), 256, 0, stream>>>(p, l, 1);
        ssd_scan_naive<<<NB * 2 * 4 * 4, 64, 0, stream>>>(p, l);
        ssd_final_kernel<<<MROWS / 4, 256, 0, stream>>>(p, l);
        gemm_naive<1><<<dim3(DM / 64, MROWS / 64), 256, 0, stream>>>(p, l);
    }
    final_norm_kernel<<<NB * SEQ / 4, 256, 0, stream>>>(p);
}
```

```cpp
#include <hip/hip_runtime.h>
#include <hip/hip_cooperative_groups.h>
#include <hip/hip_bf16.h>
#include <stdint.h>
#include <stdio.h>
namespace cg = cooperative_groups;
#include <math.h>

#define SB() __builtin_amdgcn_sched_barrier(0)
__device__ __forceinline__ int tid512_fresh() { int t = (int)threadIdx.x; asm volatile("" : "+v"(t)); return t; }
__device__ __forceinline__ int tid_fresh() { int t = (int)(threadIdx.x & 255u); asm volatile("" : "+v"(t)); return t; }
#define TIDX tidl
#define HAND_A 1
#define HAND_B 1
typedef unsigned short bf16_t;
__device__ __forceinline__ float bf2f(bf16_t v) { return __uint_as_float(((unsigned)v) << 16); }
__device__ __forceinline__ bf16_t f2bf(float f) { unsigned u = __float_as_uint(f); return (bf16_t)((u + 0x7fffu + ((u >> 16) & 1u)) >> 16); }
typedef float pk_f32x2_t __attribute__((ext_vector_type(2))); typedef __bf16 pk_bf16x2_t __attribute__((ext_vector_type(2)));
__device__ __forceinline__ unsigned pk2bf(float lo, float hi) { const pk_f32x2_t v = {lo, hi}; const pk_bf16x2_t b = __builtin_convertvector(v, pk_bf16x2_t); return __builtin_bit_cast(unsigned, b); }
__device__ __forceinline__ float silu_f(float v) { return v * __builtin_amdgcn_rcpf(1.f + __expf(-v)); }

constexpr int DM = 1024, NB = 4, SEQ = 4096, CTX = 256, SPB = CTX + SEQ  , MROWS = NB * SPB  ;
constexpr int DEPTH = 4, GRIDW = 64;
constexpr int IN_COLS = 3240;
constexpr int NTMP = 1280, NKEEP = 2048;
constexpr float EPS = 1e-6f;
constexpr float LOG2E = 1.4426950408889634f;
constexpr int T_CQ = 0, T_CKV = 256, T_KR = 384, T_DT = 416, T_XBC = 512;
constexpr int K_GA = 0, K_BQ = 256, K_BK = 512, K_BV = 640, K_BG = 768, K_CQ = 1024, K_CK = 1280, K_CV = 1408, K_CG = 1536, K_Z = 1792;

constexpr size_t MiB = 1u << 20;
constexpr size_t WS_CTL = 0;
constexpr size_t WS_MOD = 1 * MiB;
constexpr size_t WS_ATOT = 1 * MiB + 256 * 1024;
constexpr size_t WS_ACUM = 256 * 1024;
constexpr size_t WS_ROPE64 = 2 * MiB;
constexpr size_t WS_ROPE32 = 3 * MiB;
constexpr size_t WS_DT = 4 * MiB;
constexpr size_t WS_XC = 5 * MiB;
constexpr size_t WS_H = 9 * MiB;
constexpr size_t WS_TMP = 43 * MiB;
constexpr size_t WS_STATES = WS_TMP;
constexpr size_t WS_Y = WS_TMP + (size_t)NB * 34 * 2 * 4 * 64 * 128 * 4;
constexpr size_t WS_KEEP = 86 * MiB;
constexpr size_t WS_QA = 154 * MiB;
constexpr size_t WS_KA = 167 * MiB;
constexpr size_t WS_VA = 180 * MiB;
constexpr size_t WS_U = 189 * MiB;
constexpr size_t WS_WIN = 215 * MiB;
constexpr size_t WS_WOUT = 241 * MiB;
constexpr size_t WS_WQ = 249 * MiB;
constexpr size_t WS_WKV = 250 * MiB;
constexpr size_t WS_END = 251 * MiB;

struct P {
    const float *x, *c, *ctx, *c_ctx, *norm_w, *w_mod, *b_mod, *w_in, *mla_q_norm, *mla_kv_norm, *w_q_up, *w_kv_up, *gqa_q_norm, *gqa_k_norm,
        *swa_sink, *conv_w, *conv_b, *a_log, *dt_bias, *ssd_d, *ssd_norm_w, *w_out, *final_norm_w;
    float* out; unsigned char* ws;
    int never, pad;
};


__device__ __forceinline__ void mod_unit(const P& p, int u, char* lds) {
    const int tid = tid512_fresh(), col = tid & 31, kg = tid >> 5; const int l = u / 96, j = (u % 96) * 32 + col;
    float* red = (float*)lds;
    float* sc = (float*)(lds + 16384);
    const float* w = p.w_mod + (size_t)l * DM * 3072 + (size_t)kg * 64 * 3072 + j;
    float wv[64];
#pragma unroll
    for (int k = 0; k < 64; ++k) wv[k] = w[(size_t)k * 3072];
    SB();
#pragma unroll
    for (int i = 0; i < 2; ++i) { const int kk = tid + 512 * i;
#pragma unroll
        for (int r = 0; r < 4; ++r) sc[kk * 5 + r] = silu_f(p.c[r * DM + kk]);
        sc[kk * 5 + 4] = silu_f(p.c_ctx[kk]); }
    __syncthreads();
    float acc[5] = {0.f, 0.f, 0.f, 0.f, 0.f};
#pragma unroll
    for (int k = 0; k < 64; ++k) { const float* s5 = sc + (kg * 64 + k) * 5;
#pragma unroll
        for (int r = 0; r < 5; ++r) acc[r] += s5[r] * wv[k]; }
#pragma unroll
    for (int r = 0; r < 5; ++r) red[(kg * 5 + r) * 32 + col] = acc[r];
    __syncthreads();
    if (tid < 160) { const int r = tid >> 5, c = tid & 31; float s = p.b_mod[l * 3072 + (u % 96) * 32 + c];
#pragma unroll
        for (int g = 0; g < 16; ++g) s += red[(g * 5 + r) * 32 + c];
        ((float*)(p.ws + WS_MOD))[((size_t)l * 5 + r) * 3072 + (u % 96) * 32 + c] = s; }
    __syncthreads();
}

__device__ __forceinline__ void sincos_acc(float ang, float& c, float& s) {
    const double x = (double)ang; const double jd = rint(x * 0.63661977236758134308); const int j = (int)jd;
    const float y = (float)(x - jd * 1.57079632679489661923); const float z = y * y;
    const float sn = y + y * z * (-1.6666654611e-1f + z * (8.3321608736e-3f + z * (-1.9515295891e-4f)));
    const float cs = 1.f - 0.5f * z + z * z * (4.166664568298827e-2f + z * (-1.388731625493765e-3f + z * 2.443315711809948e-5f));
    switch (j & 3) { case 0: c = cs; s = sn; break; case 1: c = -sn; s = cs; break; case 2: c = -cs; s = -sn; break; default: c = sn; s = -cs; break; }
}
__device__ __forceinline__ void rope_body(const P& p, int vb) {
    const int tidl = tid_fresh();
    const int idx = vb * 256 + TIDX;
    if (idx >= SEQ * 48) return;
    const int t = idx / 48, i = idx % 48; const float row = (float)(t / GRIDW), col = (float)(t % GRIDW);
    if (i < 32) { const int f = i & 15; const float invf = powf(10000.f, -(float)f / 16.f); const float ang = (i < 16 ? row : col) * invf; float c, s; sincos_acc(ang, c, s);
        float* o = (float*)(p.ws + WS_ROPE64) + ((size_t)t * 32 + i) * 2; o[0] = c; o[1] = s; }
    else { const int ii = i - 32, f = ii & 7; const float invf = powf(10000.f, -(float)f / 8.f); const float ang = (ii < 8 ? row : col) * invf; float c, s; sincos_acc(ang, c, s);
        float* o = (float*)(p.ws + WS_ROPE32) + ((size_t)t * 16 + ii) * 2; o[0] = c; o[1] = s; }
}

__device__ __forceinline__ const float* xrow_in(const P& p, int layer, int r) {
    const int b = r / SPB, s = r % SPB;
    if (s < CTX) return (layer == 0 ? p.ctx : (const float*)(p.ws + WS_XC)) + ((size_t)b * CTX + s) * DM;
    return (layer == 0 ? p.x : (const float*)p.out) + ((size_t)b * SEQ + (s - CTX)) * DM;
}
__device__ __forceinline__ float* xrow_out(const P& p, int r) {
    const int b = r / SPB, s = r % SPB;
    if (s < CTX) return (float*)(p.ws + WS_XC) + ((size_t)b * CTX + s) * DM;
    return p.out + ((size_t)b * SEQ + (s - CTX)) * DM;
}
__device__ __forceinline__ float wave_sum(float v) {
#pragma unroll
    for (int o = 1; o < 64; o <<= 1) v += __shfl_xor(v, o);
    return v;
}

__device__ __forceinline__ void norm_body(const P& p, int layer, int vb) {
    const int tidl = tid_fresh();
    const int r = vb * 4 + (TIDX >> 6), lane = TIDX & 63;
    const float* xr = xrow_in(p, layer, r); const int b = r / SPB, s = r % SPB; const int mr = s < CTX ? 4 : b;
    const float* mod = (const float*)(p.ws + WS_MOD) + ((size_t)layer * 5 + mr) * 3072; const float* nw = p.norm_w + layer * DM;
    float v[16]; float ss = 0.f;
#pragma unroll
    for (int j = 0; j < 4; ++j) { const float4 t = *(const float4*)(xr + j * 256 + lane * 4); v[4 * j] = t.x; v[4 * j + 1] = t.y; v[4 * j + 2] = t.z; v[4 * j + 3] = t.w; ss += t.x * t.x + t.y * t.y + t.z * t.z + t.w * t.w; }
    const float rstd = rsqrtf(wave_sum(ss) * (1.f / DM) + EPS);
    bf16_t* h = (bf16_t*)(p.ws + WS_H) + (size_t)r * DM;
#pragma unroll
    for (int j = 0; j < 4; ++j)
#pragma unroll
        for (int e = 0; e < 4; ++e) { const int col = j * 256 + lane * 4 + e; h[col] = f2bf(v[4 * j + e] * rstd * nw[col] * (1.f + mod[1024 + col]) + mod[col]); }
}

__device__ __forceinline__ void norm_row2(const P& p, int layer, int R0, int R1, int lane) {
    const bool two = R1 >= 0; const int Rb = two ? R1 : R0;
    const float* xa = xrow_in(p, layer, R0); const float* xb = xrow_in(p, layer, Rb);
    float4 va[4], vb[4];
#pragma unroll
    for (int j = 0; j < 4; ++j) { va[j] = *(const float4*)(xa + j * 256 + lane * 4); vb[j] = *(const float4*)(xb + j * 256 + lane * 4); }
    SB();
    float sa = 0.f, sb = 0.f;
#pragma unroll
    for (int j = 0; j < 4; ++j) { sa += va[j].x * va[j].x + va[j].y * va[j].y + va[j].z * va[j].z + va[j].w * va[j].w; sb += vb[j].x * vb[j].x + vb[j].y * vb[j].y + vb[j].z * vb[j].z + vb[j].w * vb[j].w; }
#pragma unroll
    for (int o = 1; o < 64; o <<= 1) { sa += __shfl_xor(sa, o); sb += __shfl_xor(sb, o); }
    const float ra = rsqrtf(sa * (1.f / DM) + EPS), rb = rsqrtf(sb * (1.f / DM) + EPS); const float* nw = p.norm_w + layer * DM;
#pragma unroll
    for (int q = 0; q < 2; ++q) { if (q == 1 && !two) break; const int R = q == 0 ? R0 : R1; const float rstd = q == 0 ? ra : rb; const int b = R / SPB, s = R % SPB; const int mr = s < CTX ? 4 : b;
        const float* mod = (const float*)(p.ws + WS_MOD) + ((size_t)layer * 5 + mr) * 3072; bf16_t* h = (bf16_t*)(p.ws + WS_H) + (size_t)R * DM;
#pragma unroll
        for (int j = 0; j < 4; ++j) { const float4 v = q == 0 ? va[j] : vb[j]; const int col = j * 256 + lane * 4; const float4 w = *(const float4*)(nw + col), sc = *(const float4*)(mod + 1024 + col), sh = *(const float4*)(mod + col);
            uint2 o; o.x = pk2bf(v.x * rstd * w.x * (1.f + sc.x) + sh.x, v.y * rstd * w.y * (1.f + sc.y) + sh.y);
            o.y = pk2bf(v.z * rstd * w.z * (1.f + sc.z) + sh.z, v.w * rstd * w.w * (1.f + sc.w) + sh.w);
            *(uint2*)(h + col) = o; } }
}
__device__ __forceinline__ void norm_row(const P& p, int layer, int R, int lane) {
    const float* xr = xrow_in(p, layer, R); const int b = R / SPB, s = R % SPB; const int mr = s < CTX ? 4 : b;
    const float* mod = (const float*)(p.ws + WS_MOD) + ((size_t)layer * 5 + mr) * 3072; const float* nw = p.norm_w + layer * DM;
    float4 v[4]; float ss = 0.f;
#pragma unroll
    for (int j = 0; j < 4; ++j) { v[j] = *(const float4*)(xr + j * 256 + lane * 4); ss += v[j].x * v[j].x + v[j].y * v[j].y + v[j].z * v[j].z + v[j].w * v[j].w; }
    const float rstd = rsqrtf(wave_sum(ss) * (1.f / DM) + EPS);
    bf16_t* h = (bf16_t*)(p.ws + WS_H) + (size_t)R * DM;
#pragma unroll
    for (int j = 0; j < 4; ++j) { const int col = j * 256 + lane * 4; const float4 w = *(const float4*)(nw + col), sc = *(const float4*)(mod + 1024 + col), sh = *(const float4*)(mod + col);
        uint2 o; o.x = pk2bf(v[j].x * rstd * w.x * (1.f + sc.x) + sh.x, v[j].y * rstd * w.y * (1.f + sc.y) + sh.y);
        o.y = pk2bf(v[j].z * rstd * w.z * (1.f + sc.z) + sh.z, v[j].w * rstd * w.w * (1.f + sc.w) + sh.w);
        *(uint2*)(h + col) = o; }
}
__device__ __forceinline__ int in_col_map(int n) {
    if (n < 416) return n; if (n < 424) return 3232 + (n - 416); if (n < 512) return -1; if (n < 1280) return 2464 + (n - 512); return 416 + (n - 1280);
}
template <int MODE> __device__ __forceinline__ void gemm_body(const P& p, int layer, int vb, char* smem) {
    const int tidl = tid_fresh();
    float (*As)[65] = (float (*)[65])smem; float (*Ws)[65] = (float (*)[65])(smem + 16 * 65 * 4);
    constexpr int NBX = MODE == 0 ? 3328 / 64 : DM / 64;
    const int tid = TIDX, tx = tid & 15, ty = tid >> 4; const int m0 = (vb / NBX) * 64, n0 = (vb % NBX) * 64;
    const bf16_t* A = (const bf16_t*)(p.ws + WS_H); const int ldw = MODE == 0 ? IN_COLS : DM;
    const float* W = MODE == 0 ? p.w_in + (size_t)layer * DM * IN_COLS : p.w_out + (size_t)layer * DM * DM;
    float acc[4][4] = {};
    const int lr = tid >> 2, lk = (tid & 3) * 4;
    const int wk = tid >> 4, wn = (tid & 15) * 4;
    int wc[4];
#pragma unroll
    for (int e = 0; e < 4; ++e) wc[e] = MODE == 0 ? in_col_map(n0 + wn + e) : n0 + wn + e;
    for (int k0 = 0; k0 < DM; k0 += 16) {
        const uint2 av = *(const uint2*)(A + (size_t)(m0 + lr) * DM + k0 + lk);
        As[lk][lr] = __uint_as_float(av.x << 16); As[lk + 1][lr] = __uint_as_float(av.x & 0xffff0000u); As[lk + 2][lr] = __uint_as_float(av.y << 16); As[lk + 3][lr] = __uint_as_float(av.y & 0xffff0000u);
#pragma unroll
        for (int e = 0; e < 4; ++e) Ws[wk][wn + e] = wc[e] >= 0 ? W[(size_t)(k0 + wk) * ldw + wc[e]] : 0.f;
        __syncthreads();
#pragma unroll
        for (int k = 0; k < 16; ++k) { float a[4], w[4];
#pragma unroll
            for (int i = 0; i < 4; ++i) { a[i] = As[k][ty * 4 + i]; w[i] = Ws[k][tx * 4 + i]; }
#pragma unroll
            for (int i = 0; i < 4; ++i)
#pragma unroll
                for (int j = 0; j < 4; ++j) acc[i][j] += a[i] * w[j]; }
        __syncthreads();
    }
#pragma unroll
    for (int i = 0; i < 4; ++i) { const int r = m0 + ty * 4 + i;
        if (MODE == 0) {
#pragma unroll
            for (int j = 0; j < 4; ++j) { const int n = n0 + tx * 4 + j;
                if (n < NTMP) ((bf16_t*)(p.ws + WS_TMP))[(size_t)r * NTMP + n] = f2bf(acc[i][j]); else ((bf16_t*)(p.ws + WS_KEEP))[(size_t)r * NKEEP + (n - NTMP)] = f2bf(acc[i][j]); }
        } else {
            const int b = r / SPB, s = r % SPB; const int mr = s < CTX ? 4 : b; const float* gate = (const float*)(p.ws + WS_MOD) + ((size_t)layer * 5 + mr) * 3072 + 2048;
            const float* xi = xrow_in(p, layer, r); float* xo = xrow_out(p, r);
#pragma unroll
            for (int j = 0; j < 4; ++j) { const int n = n0 + tx * 4 + j; xo[n] = xi[n] + gate[n] * acc[i][j]; }
        }
    }
}

__device__ __forceinline__ void prep_mla_body(const P& p, int layer, int vb, char* smem) {
    const int tidl = tid_fresh();
    float (*sq)[256] = (float (*)[256])smem; float (*skv)[128] = (float (*)[128])(smem + 8192); float (*oq)[384] = (float (*)[384])(smem + 12288);
    float (*okv)[512] = (float (*)[512])(smem + 24576); float (*skr)[32] = (float (*)[32])(smem + 40960);
    const int tid = TIDX, r0 = vb * 8; const bf16_t* tmp = (const bf16_t*)(p.ws + WS_TMP);
    const float* qn = p.mla_q_norm + layer * 256; const float* kvn = p.mla_kv_norm + layer * 128;
    { const int rr = tid >> 5, l32 = tid & 31; const bf16_t* row = tmp + (size_t)(r0 + rr) * NTMP;
        float v[8], ss = 0.f;
#pragma unroll
        for (int j = 0; j < 8; ++j) { v[j] = bf2f(row[T_CQ + l32 + 32 * j]); ss += v[j] * v[j]; }
#pragma unroll
        for (int o = 1; o < 32; o <<= 1) ss += __shfl_xor(ss, o);
        const float rs = rsqrtf(ss * (1.f / 256.f) + EPS);
#pragma unroll
        for (int j = 0; j < 8; ++j) sq[rr][l32 + 32 * j] = v[j] * rs * qn[l32 + 32 * j];
        float w[4], s2 = 0.f;
#pragma unroll
        for (int j = 0; j < 4; ++j) { w[j] = bf2f(row[T_CKV + l32 + 32 * j]); s2 += w[j] * w[j]; }
#pragma unroll
        for (int o = 1; o < 32; o <<= 1) s2 += __shfl_xor(s2, o);
        const float rs2 = rsqrtf(s2 * (1.f / 128.f) + EPS);
#pragma unroll
        for (int j = 0; j < 4; ++j) skv[rr][l32 + 32 * j] = w[j] * rs2 * kvn[l32 + 32 * j];
        skr[rr][l32] = bf2f(row[T_KR + l32]);
    }
    __syncthreads();
    const float* wq = p.w_q_up + (size_t)layer * 256 * 384; const float* wkv = p.w_kv_up + (size_t)layer * 128 * 512;
    for (int col = tid; col < 384; col += 256) { float acc[8] = {};
        for (int k = 0; k < 256; ++k) { const float w = wq[k * 384 + col];
#pragma unroll
            for (int r = 0; r < 8; ++r) acc[r] += sq[r][k] * w; }
#pragma unroll
        for (int r = 0; r < 8; ++r) oq[r][col] = acc[r]; }
    for (int col = tid; col < 512; col += 256) { float acc[8] = {};
        for (int k = 0; k < 128; ++k) { const float w = wkv[k * 512 + col];
#pragma unroll
            for (int r = 0; r < 8; ++r) acc[r] += skv[r][k] * w; }
#pragma unroll
        for (int r = 0; r < 8; ++r) okv[r][col] = acc[r]; }
    __syncthreads();
    bf16_t* QA = (bf16_t*)(p.ws + WS_QA); bf16_t* KA = (bf16_t*)(p.ws + WS_KA); bf16_t* VA = (bf16_t*)(p.ws + WS_VA);
    const float qscale = LOG2E / sqrtf(96.f);
    for (int i = tid; i < 8 * 384; i += 256) { const int rr = i / 384, col = i % 384, h = col / 96, d = col % 96; const int r = r0 + rr, s = r % SPB;
        float v = oq[rr][col];
        if (d >= 64 && s >= CTX) { const int t = s - CTX, e = d - 64, ii = e & 15; const float* cs = (const float*)(p.ws + WS_ROPE32) + ((size_t)t * 16 + ii) * 2;
            const float x1 = oq[rr][h * 96 + 64 + ii], x2 = oq[rr][h * 96 + 80 + ii]; v = e < 16 ? x1 * cs[0] - x2 * cs[1] : x1 * cs[1] + x2 * cs[0]; }
        QA[(size_t)r * 384 + col] = f2bf(v * qscale);
        float kv;
        if (d < 64) kv = okv[rr][h * 128 + d];
        else { const int e = d - 64, ii = e & 15; const float x1 = skr[rr][ii], x2 = skr[rr][16 + ii];
            if (s >= CTX) { const int t = s - CTX; const float* cs = (const float*)(p.ws + WS_ROPE32) + ((size_t)t * 16 + ii) * 2; kv = e < 16 ? x1 * cs[0] - x2 * cs[1] : x1 * cs[1] + x2 * cs[0]; }
            else kv = skr[rr][e]; }
        KA[(size_t)r * 384 + col] = f2bf(kv);
    }
    for (int i = tid; i < 8 * 256; i += 256) { const int rr = i / 256, col = i % 256, h = col / 64, d = col % 64; VA[(size_t)(r0 + rr) * 256 + col] = f2bf(okv[rr][h * 128 + 64 + d]); }
}

__device__ __forceinline__ void prep_bc_body(const P& p, int layer, int vb) {
    const int tidl = tid_fresh();
    const int r = vb * 4 + (TIDX >> 6), lane = TIDX & 63, half = lane >> 5, i = lane & 31;
    const int s = r % SPB; const bool lat = s >= CTX; const int t = s - CTX;
    bf16_t* row = (bf16_t*)(p.ws + WS_KEEP) + (size_t)r * NKEEP;
    float cs0 = 1.f, sn0 = 0.f; if (lat) { const float* cs = (const float*)(p.ws + WS_ROPE64) + ((size_t)t * 32 + i) * 2; cs0 = cs[0]; sn0 = cs[1]; }
    const float qscale = 0.125f * LOG2E;
#pragma unroll
    for (int it = 0; it < 6; ++it) { const int hv = it * 2 + half; int off; bool isq, nrm; const float* nw = nullptr;
        if (hv < 4) { off = K_BQ + hv * 64; isq = true; nrm = true; nw = p.gqa_q_norm + layer * 64; }
        else if (hv < 6) { off = K_BK + (hv - 4) * 64; isq = false; nrm = true; nw = p.gqa_k_norm + layer * 64; }
        else if (hv < 10) { off = K_CQ + (hv - 6) * 64; isq = true; nrm = false; }
        else { off = K_CK + (hv - 10) * 64; isq = false; nrm = false; }
        float x1 = bf2f(row[off + i]), x2 = bf2f(row[off + 32 + i]);
        if (nrm) { float ss = x1 * x1 + x2 * x2;
#pragma unroll
            for (int o = 1; o < 32; o <<= 1) ss += __shfl_xor(ss, o);
            const float rs = rsqrtf(ss * (1.f / 64.f) + EPS); x1 = x1 * rs * nw[i]; x2 = x2 * rs * nw[32 + i]; }
        float y1 = x1 * cs0 - x2 * sn0, y2 = x1 * sn0 + x2 * cs0;
        if (isq) { y1 *= qscale; y2 *= qscale; }
        row[off + i] = f2bf(y1); row[off + 32 + i] = f2bf(y2);
    }
}

__device__ __forceinline__ void prep_d_body(const P& p, int layer, int vb) {
    const int tidl = tid_fresh();
    const int r = vb, tid = TIDX; const int s = r % SPB; const bool lat = s >= CTX; const int pos = lat ? s - CTX : s, len = lat ? SEQ : CTX;
    const bf16_t* tmp = (const bf16_t*)(p.ws + WS_TMP); bf16_t* U = (bf16_t*)(p.ws + WS_U) + (size_t)r * 768;
    const float* cw = p.conv_w + (size_t)layer * 5 * 768; const float* cb = p.conv_b + layer * 768;
    for (int c = tid; c < 768; c += 256) { float a = cb[c];
#pragma unroll
        for (int j = 0; j < 5; ++j) { const int pp = pos + j - 2; if (pp >= 0 && pp < len) a += cw[j * 768 + c] * bf2f(tmp[(size_t)(r + j - 2) * NTMP + T_XBC + c]); }
        U[c] = f2bf(silu_f(a)); }
    if (tid < 8) { const float v = bf2f(tmp[(size_t)r * NTMP + T_DT + tid]) + p.dt_bias[layer * 8 + tid]; const float sp = v > 20.f ? v : log1pf(__expf(v)); ((float*)(p.ws + WS_DT))[(size_t)r * 8 + tid] = sp; }
}

template <int GROUP> __device__ __forceinline__ void attn_body(const P& p, int layer, int qkind, int vb, char* smem) {
    const int tidl = tid_fresh();
    constexpr int DQ = GROUP == 0 ? 96 : 64, DV = 64;
    float (*Ks)[DQ] = (float (*)[DQ])smem; float (*Vs)[DV] = (float (*)[DV])(smem + 64 * DQ * 4);
    const int nqb = qkind == 0 ? 16 : 1;
    const int tid = TIDX, qb = vb % nqb, h = (vb / nqb) & 3, b = vb / (nqb * 4); const int kvh = GROUP == 0 ? h : h >> 1;
    const int srow = qkind == 0 ? CTX + qb * 256 + tid : tid;
    const size_t r = (size_t)b * SPB + srow;
    const bf16_t *Qp, *Kp, *Vp, *Gp; int ldq, ldk, ldv;
    if (GROUP == 0) { Qp = (const bf16_t*)(p.ws + WS_QA) + h * 96; ldq = 384; Kp = (const bf16_t*)(p.ws + WS_KA) + h * 96; ldk = 384; Vp = (const bf16_t*)(p.ws + WS_VA) + h * 64; ldv = 256; Gp = (const bf16_t*)(p.ws + WS_KEEP) + K_GA + h * 64; }
    else if (GROUP == 1) { const bf16_t* kp = (const bf16_t*)(p.ws + WS_KEEP); Qp = kp + K_BQ + h * 64; Kp = kp + K_BK + kvh * 64; Vp = kp + K_BV + kvh * 64; Gp = kp + K_BG + h * 64; ldq = ldk = ldv = NKEEP; }
    else { const bf16_t* kp = (const bf16_t*)(p.ws + WS_KEEP); Qp = kp + K_CQ + h * 64; Kp = kp + K_CK + kvh * 64; Vp = kp + K_CV + kvh * 64; Gp = kp + K_CG + h * 64; ldq = ldk = ldv = NKEEP; }
    unsigned qpk[DQ / 2];
#pragma unroll
    for (int d = 0; d < DQ / 2; ++d) qpk[d] = *(const unsigned*)(Qp + r * ldq + 2 * d);
    float o[DV];
#pragma unroll
    for (int d = 0; d < DV; ++d) o[d] = 0.f;
    float m = -INFINITY, l = 0.f;
    int k_lo = 0, k_hi = CTX;
    int w_lo = 0, w_hi = 0;
    if (qkind == 0) { if (GROUP == 2) { const int t0 = qb * 256; w_lo = CTX + t0 - 128; w_hi = w_lo + 512;   } else { w_lo = CTX; w_hi = SPB; } }
    const int tq = srow - CTX;
    for (int pass = 0; pass < 2; ++pass) {
        const int lo = pass == 0 ? k_lo : w_lo, hi = pass == 0 ? k_hi : w_hi;
        for (int kt = lo; kt < hi; kt += 64) {
            const bool in_range = kt >= (pass == 0 ? 0 : CTX) && kt < SPB;
            __syncthreads();
            if (in_range) {
                for (int i = tid; i < 64 * DQ; i += 256) { const int kk = i / DQ, d = i % DQ; Ks[kk][d] = bf2f(Kp[((size_t)b * SPB + kt + kk) * ldk + d]); }
                for (int i = tid; i < 64 * DV; i += 256) { const int kk = i / DV, d = i % DV; Vs[kk][d] = bf2f(Vp[((size_t)b * SPB + kt + kk) * ldv + d]); }
            }
            __syncthreads();
            if (in_range) {
#pragma unroll 1
            for (int j = 0; j < 64; ++j) { float a = 0.f;
#pragma unroll
                for (int d = 0; d < DQ / 2; ++d) a += __uint_as_float(qpk[d] << 16) * Ks[j][2 * d] + __uint_as_float(qpk[d] & 0xffff0000u) * Ks[j][2 * d + 1];
                bool valid = true;
                if (GROUP == 2 && pass == 1) { const int tk = kt + j - CTX; valid = (tk - tq <= 128) && (tq - tk <= 128); }
                const float sv = valid ? a : -INFINITY; const float mx = fmaxf(m, sv);
                const float f = exp2f(m - mx), pj = exp2f(sv - mx); m = mx; l = l * f + pj;
#pragma unroll
                for (int d = 0; d < DV; ++d) o[d] = o[d] * f + pj * Vs[j][d]; }
            }
        }
    }
    if (GROUP == 2) { const float sk = p.swa_sink[layer * 4 + h] * LOG2E; const float mx = fmaxf(m, sk); const float f = exp2f(m - mx); l = l * f + exp2f(sk - mx);
#pragma unroll
        for (int d = 0; d < DV; ++d) o[d] *= f; }
    const float il = 1.f / l;
    bf16_t* mix = (bf16_t*)(p.ws + WS_H) + r * DM + GROUP * 256 + h * 64;
#pragma unroll
    for (int d = 0; d < DV; ++d) { const float g = bf2f(Gp[r * NKEEP + d]); mix[d] = f2bf(o[d] * il * silu_f(g)); }
}

__device__ __forceinline__ int ssd_order(int d, int i) { return d == 0 ? i : (i < 2 ? 1 - i : 35 - i); }
__device__ __forceinline__ void ssd_local_body(const P& p, int layer, int w) {
    const int lane = tid512_fresh() & 63, pl = lane & 15, nq = lane >> 4; const int pq = w & 3, h = (w >> 2) & 3, bc = w >> 4, ch = bc % 34, b = bc / 34;
    const int pcol = h * 64 + pq * 16 + pl, g = h >> 1;
    const bf16_t* U = (const bf16_t*)(p.ws + WS_U); const float* DT = (const float*)(p.ws + WS_DT); bf16_t* Y = (bf16_t*)(p.ws + WS_Y);
    float* ACUM = (float*)(p.ws + WS_ACUM); float* ATOT = (float*)(p.ws + WS_ATOT); float* ST = (float*)(p.ws + WS_STATES);
    for (int dir = 0; dir < 2; ++dir) {
        const float a = -__expf(p.a_log[layer * 8 + dir * 4 + h]);
        float st[32];
#pragma unroll
        for (int n = 0; n < 32; ++n) st[n] = 0.f;
        float acc = 0.f;
        for (int step = 0; step < 128; ++step) {
            const int kpos = dir == 0 ? step : 127 - step; const size_t r = (size_t)b * SPB + ch * 128 + kpos; const bf16_t* u = U + r * 768;
            const float dt = DT[r * 8 + dir * 4 + h]; const float da = dt * a; const float dA = __expf(da); const float xdt = bf2f(u[pcol]) * dt; acc += da;
            if (pq == 0 && lane == 0) ACUM[r * 8 + dir * 4 + h] = acc;
            float y = 0.f;
            const uint4* bp = (const uint4*)(u + 256 + g * 128 + nq * 32); const uint4* cp = (const uint4*)(u + 512 + g * 128 + nq * 32);
#pragma unroll
            for (int v4 = 0; v4 < 4; ++v4) { const uint4 bv = bp[v4], cv = cp[v4]; const unsigned bw[4] = {bv.x, bv.y, bv.z, bv.w}, cw[4] = {cv.x, cv.y, cv.z, cv.w};
#pragma unroll
                for (int e = 0; e < 4; ++e) { const int n = v4 * 8 + e * 2;
                    st[n] = st[n] * dA + xdt * __uint_as_float(bw[e] << 16); y += st[n] * __uint_as_float(cw[e] << 16);
                    st[n + 1] = st[n + 1] * dA + xdt * __uint_as_float(bw[e] & 0xffff0000u); y += st[n + 1] * __uint_as_float(cw[e] & 0xffff0000u); } }
            y += __shfl_xor(y, 16); y += __shfl_xor(y, 32);
            if (nq == 0) { if (dir == 0) Y[r * 256 + pcol] = f2bf(y); else Y[r * 256 + pcol] = f2bf(bf2f(Y[r * 256 + pcol]) + y); }
        }
        if (pq == 0 && lane == 0) ATOT[(b * 34 + ch) * 8 + dir * 4 + h] = acc;
        float* sp = ST + ((((size_t)(b * 34 + ch) * 2 + dir) * 4 + h) * 64 + pq * 16 + pl) * 128 + nq * 32;
#pragma unroll
        for (int n = 0; n < 32; n += 4) *(float4*)(sp + n) = make_float4(st[n], st[n + 1], st[n + 2], st[n + 3]);
    }
}
__device__ __forceinline__ void ssd_chunk_scan_body(const P& p, int idx) {
    const int e = idx & 4095, h = (idx >> 12) & 3, d = (idx >> 14) & 1, b = idx >> 15;
    unsigned* ST = (unsigned*)(p.ws + WS_STATES); const float* ATOT = (const float*)(p.ws + WS_ATOT);
    unsigned loc[34]; float dec[34];
#pragma unroll
    for (int i = 0; i < 34; ++i) { const int ch = ssd_order(d, i); loc[i] = ST[(((size_t)(b * 34 + ch) * 2 + d) * 4 + h) * 4096 + e]; dec[i] = ATOT[(b * 34 + ch) * 8 + d * 4 + h]; }
    SB();
    float s0 = 0.f, s1 = 0.f;
#pragma unroll
    for (int i = 0; i < 34; ++i) { const int ch = ssd_order(d, i); ST[(((size_t)(b * 34 + ch) * 2 + d) * 4 + h) * 4096 + e] = pk2bf(s0, s1);
        const float ex = __expf(dec[i]); s0 = s0 * ex + __uint_as_float(loc[i] << 16); s1 = s1 * ex + __uint_as_float(loc[i] & 0xffff0000u); }
}
__device__ __forceinline__ void ssd_final_body(const P& p, int layer, int vb) {
    const int tidl = tid_fresh();
    const int r = vb * 4 + (TIDX >> 6), lane = TIDX & 63; const int b = r / SPB, ch = (r % SPB) >> 7;
    const bf16_t* U = (const bf16_t*)(p.ws + WS_U) + (size_t)r * 768; const bf16_t* keep = (const bf16_t*)(p.ws + WS_KEEP) + (size_t)r * NKEEP;
    const bf16_t* Y = (const bf16_t*)(p.ws + WS_Y) + (size_t)r * 256; const float* ACUM = (const float*)(p.ws + WS_ACUM) + (size_t)r * 8; const float* ST = (const float*)(p.ws + WS_STATES);
    const int c0 = lane * 4, h = c0 >> 6, g = h >> 1;
    float yo[4] = {0.f, 0.f, 0.f, 0.f};
    for (int d = 0; d < 2; ++d) { const float dec = __expf(ACUM[d * 4 + h]); const float* pv = ST + ((((size_t)(b * 34 + ch) * 2 + d) * 4 + h) * 64 + (c0 & 63)) * 128;
        float s4[4] = {0.f, 0.f, 0.f, 0.f};
        for (int n = 0; n < 128; n += 4) { const uint2 cv = *(const uint2*)(U + 512 + g * 128 + n); const float cf[4] = {__uint_as_float(cv.x << 16), __uint_as_float(cv.x & 0xffff0000u), __uint_as_float(cv.y << 16), __uint_as_float(cv.y & 0xffff0000u)};
#pragma unroll
            for (int e = 0; e < 4; ++e) { const float4 pr = *(const float4*)(pv + e * 128 + n); s4[e] += cf[0] * pr.x + cf[1] * pr.y + cf[2] * pr.z + cf[3] * pr.w; } }
#pragma unroll
        for (int e = 0; e < 4; ++e) yo[e] += dec * s4[e]; }
    float v[4], ss = 0.f;
#pragma unroll
    for (int e = 0; e < 4; ++e) { const int c = c0 + e; const float y = p.ssd_d[layer * 4 + h] * bf2f(U[c]) + bf2f(Y[c]) + yo[e]; v[e] = y * silu_f(bf2f(keep[K_Z + c])); ss += v[e] * v[e]; }
    const float rs = rsqrtf(wave_sum(ss) * (1.f / 256.f) + EPS);
    bf16_t* mix = (bf16_t*)(p.ws + WS_H) + (size_t)r * DM + 768;
#pragma unroll
    for (int e = 0; e < 4; ++e) { const int c = c0 + e; mix[c] = f2bf(v[e] * rs * p.ssd_norm_w[layer * 256 + c]); }
}

__device__ __forceinline__ void final_norm_body(const P& p, int vb) {
    const int tidl = tid_fresh();
    const int r = vb * 4 + (TIDX >> 6), lane = TIDX & 63; float* xr = p.out + (size_t)r * DM;
    float4 v[4]; float ss = 0.f;
#pragma unroll
    for (int j = 0; j < 4; ++j) { v[j] = *(const float4*)(xr + j * 256 + lane * 4); ss += v[j].x * v[j].x + v[j].y * v[j].y + v[j].z * v[j].z + v[j].w * v[j].w; }
    const float rstd = rsqrtf(wave_sum(ss) * (1.f / DM) + EPS);
#pragma unroll
    for (int j = 0; j < 4; ++j) { const float4 w = *(const float4*)(p.final_norm_w + j * 256 + lane * 4); float4 o; o.x = v[j].x * rstd * w.x; o.y = v[j].y * rstd * w.y; o.z = v[j].z * rstd * w.z; o.w = v[j].w * rstd * w.w; *(float4*)(xr + j * 256 + lane * 4) = o; }
}


namespace pg8 {
#define PG8_LAS __attribute__((address_space(3)))
typedef unsigned short bf16_t;
typedef short bf16x8 __attribute__((ext_vector_type(8)));
typedef float f32x4 __attribute__((ext_vector_type(4)));
typedef unsigned u32x4 __attribute__((ext_vector_type(4)));
constexpr int BM = 256, BK = 64, HALF = 128, HTB = HALF * BK * 2  , STAGE_BYTES = 8 * HTB, NXCD = 8, WGM = 8;

__host__ __device__ __forceinline__ int lds_byte(int r, int c) { const int st = (r >> 4) * 2 + (c >> 5), rr = r & 15, cc = c & 31, ob = rr * 64 + cc * 2; return st * 1024 + (ob ^ (((ob >> 9) & 1) << 5)); }
__host__ __device__ __forceinline__ void stage_rc(int b, int& R, int& C) { const int st = b / 1024, sb = b % 1024, swz = sb ^ (((sb >> 9) & 1) << 5); R = (st >> 1) * 16 + swz / 64; C = (st & 1) * 32 + (swz % 64) / 2; }
__host__ __device__ __forceinline__ int perm32(int rho) { const int n = rho >> 4, i = rho & 15; return 8 * (i >> 2) + 4 * n + (i & 3); }

struct Unit { int pm, pn; };
struct Gemm { const bf16_t* A; const bf16_t* Bt; int M, N, K; };

struct StaticOrder {
    int nM, nN, nwg, G, c;
    __host__ __device__ void init(int M, int N, int G_, int c_) { nM = M / BM; nN = N / BM; nwg = nM * nN; G = G_; c = c_; }
    __host__ __device__ bool next(int i, Unit& u) const {
        const long L = (long)i * G + c; if (L >= nwg) return false;
        int wgid = (int)L; { const int q = nwg / NXCD, r = nwg % NXCD, xcd = wgid % NXCD, off = wgid / NXCD; wgid = (xcd < r ? xcd * (q + 1) : r * (q + 1) + (xcd - r) * q) + off; }
        const int nig = WGM * nN, gid = wgid / nig, fm = gid * WGM, gsz = (nM - fm) < WGM ? (nM - fm) : WGM;
        u.pm = fm + ((wgid % nig) % gsz); u.pn = (wgid % nig) / gsz; return true;
    }
    __device__ __forceinline__ void a_ready(const Unit&) const {}
    __device__ __forceinline__ void done(const Unit&) const {}
};

__device__ __forceinline__ unsigned cvt_pk_bf16(float lo, float hi) { unsigned r; asm volatile("v_cvt_pk_bf16_f32 %0, %1, %2" : "=v"(r) : "v"(lo), "v"(hi)); return r; }
template <class Epi, class Sched, bool ALIGN_EPI = false, bool SP2 = false>
__device__ __forceinline__ void gemm_phase(PG8_LAS unsigned char* lds, const Gemm g, const Sched& S, const Epi& E) {
    const int tid = tid512_fresh(), wid = __builtin_amdgcn_readfirstlane(tid >> 6), lane = tid & 63, wr = wid >> 2, wc = wid & 3, fr = lane & 15, fq = lane >> 4;
    const int K = g.K, nt = K / BK;
    unsigned voffA[2], voffB[2];
#pragma unroll
    for (int i = 0; i < 2; ++i) { int R, C; stage_rc(tid * 16 + i * 8192, R, C); const int Rb = Epi::PERM ? ((R & ~31) + perm32(R & 31)) : R;
        voffA[i] = (unsigned)(R * K + C) * 2u; voffB[i] = (unsigned)(Rb * K + C) * 2u; }
    const size_t kstep = (size_t)(BK * 2);
    const size_t hstep = (size_t)HALF * K * 2;
    const size_t tstep = 2 * hstep;
    const unsigned ldsw = (unsigned)wid * 1024u;
    const int aoff = lds_byte(wr * 64 + fr, fq * 8), boff = lds_byte(wc * 32 + fr, fq * 8);
#define PG8_SA(b, h) (((b) * 2 + (h)) * HTB)
#define PG8_SB(b, h) ((4 + (b) * 2 + (h)) * HTB)
#define PG8_STAGE(bufoff, gbase, voff) do { _Pragma("unroll") for (int _i = 0; _i < 2; ++_i) \
        __builtin_amdgcn_global_load_lds((const unsigned*)((const char*)(gbase) + (voff)[_i]), (PG8_LAS unsigned*)(lds + (bufoff) + ldsw + _i * 8192), 16, 0, 0); } while (0)
#define PG8_LDA(dst, b, h) do { _Pragma("unroll") for (int m = 0; m < 4; ++m) _Pragma("unroll") for (int k = 0; k < 2; ++k) dst[m][k] = *(const PG8_LAS bf16x8*)(lds + PG8_SA(b, h) + aoff + m * 2048 + k * 1024); } while (0)
#define PG8_LDB(dst, b, h) do { _Pragma("unroll") for (int n = 0; n < 2; ++n) _Pragma("unroll") for (int k = 0; k < 2; ++k) dst[n][k] = *(const PG8_LAS bf16x8*)(lds + PG8_SB(b, h) + boff + n * 2048 + k * 1024); } while (0)
#define PG8_MMA(ai, bj, At, Bt) do { __builtin_amdgcn_s_setprio(1); _Pragma("unroll") for (int m = 0; m < 4; ++m) _Pragma("unroll") for (int n = 0; n < 2; ++n) _Pragma("unroll") for (int k = 0; k < 2; ++k) \
        acc[ai][bj][m][n] = __builtin_amdgcn_mfma_f32_16x16x32_bf16(Bt[n][k], At[m][k], acc[ai][bj][m][n], 0, 0, 0); __builtin_amdgcn_s_setprio(0); } while (0)
#define PG8_WAIT_V(n) asm volatile("s_waitcnt vmcnt(" #n ")" ::: "memory")
#define PG8_WAIT_L(n) asm volatile("s_waitcnt lgkmcnt(" #n ")" ::: "memory")
#define PG8_BAR __builtin_amdgcn_s_barrier()
#define PG8_SCHED __builtin_amdgcn_sched_barrier(0)
    Unit cur, nxt; int ui = 0;
    if (!S.next(0, cur)) return;
    f32x4 acc[2][2][4][2];
#pragma unroll
    for (int a = 0; a < 2; ++a)
#pragma unroll
        for (int b = 0; b < 2; ++b)
#pragma unroll
            for (int m = 0; m < 4; ++m)
#pragma unroll
                for (int n = 0; n < 2; ++n) acc[a][b][m][n] = (f32x4){0.f, 0.f, 0.f, 0.f};
    bf16x8 At[4][2], B0[2][2], B1[2][2];
    const char* cA = (const char*)g.A + (size_t)cur.pm * tstep; const char* cB = (const char*)g.Bt + (size_t)cur.pn * tstep;
    S.a_ready(cur);
    if constexpr (SP2) {
        PG8_STAGE(PG8_SB(0, 0), cB, voffB); PG8_STAGE(PG8_SB(0, 1), cB + hstep, voffB); PG8_STAGE(PG8_SA(0, 0), cA, voffA); PG8_STAGE(PG8_SA(0, 1), cA + hstep, voffA);
        if (wr == 1) PG8_BAR;
        PG8_WAIT_V(2); PG8_BAR;
        PG8_STAGE(PG8_SB(1, 0), cB + kstep, voffB); PG8_STAGE(PG8_SA(1, 0), cA + kstep, voffA); PG8_STAGE(PG8_SB(1, 1), cB + hstep + kstep, voffB);
        PG8_WAIT_V(6); PG8_BAR;
    } else {
        PG8_STAGE(PG8_SB(0, 0), cB, voffB); PG8_STAGE(PG8_SA(0, 0), cA, voffA); PG8_STAGE(PG8_SB(0, 1), cB + hstep, voffB); PG8_STAGE(PG8_SA(0, 1), cA + hstep, voffA);
        if (wr == 1) PG8_BAR;
        PG8_WAIT_V(4); PG8_BAR;
        PG8_STAGE(PG8_SB(1, 0), cB + kstep, voffB); PG8_STAGE(PG8_SA(1, 0), cA + kstep, voffA); PG8_STAGE(PG8_SB(1, 1), cB + hstep + kstep, voffB);
        PG8_WAIT_V(6); PG8_BAR;
    }
    for (;;) {
        const bool has_next = S.next(ui + 1, nxt);
        const char* nA = has_next ? (const char*)g.A + (size_t)nxt.pm * tstep : cA; const char* nB = has_next ? (const char*)g.Bt + (size_t)nxt.pn * tstep : cB;
        for (int t = 0; t < nt; t += 2) {
            const bool last = (t == nt - 2);
            const char* a1 = cA + (size_t)(t + 1) * kstep;
            const char* a2 = last ? nA : cA + (size_t)(t + 2) * kstep; const char* b2 = last ? nB : cB + (size_t)(t + 2) * kstep;
            const char* a3 = a2 + kstep; const char* b3 = b2 + kstep;
            if (last && has_next) S.a_ready(nxt);
            if constexpr (SP2) {
            PG8_LDB(B0, 0, 0); PG8_LDB(B1, 0, 1); PG8_SCHED; PG8_LDA(At, 0, 0); PG8_STAGE(PG8_SA(1, 1), a1 + hstep, voffA);
            PG8_WAIT_V(8); PG8_WAIT_L(0); PG8_BAR; PG8_MMA(0, 0, At, B0); PG8_MMA(0, 1, At, B1); PG8_BAR; PG8_SCHED;
            PG8_LDA(At, 0, 1); PG8_STAGE(PG8_SB(0, 0), b2, voffB); PG8_STAGE(PG8_SB(0, 1), b2 + hstep, voffB); PG8_STAGE(PG8_SA(0, 0), a2, voffA);
            PG8_WAIT_V(8); PG8_WAIT_L(0); PG8_BAR; PG8_MMA(1, 0, At, B0); PG8_MMA(1, 1, At, B1); PG8_BAR; PG8_SCHED;
            PG8_LDB(B0, 1, 0); PG8_LDB(B1, 1, 1); PG8_SCHED; PG8_LDA(At, 1, 0); PG8_STAGE(PG8_SA(0, 1), a2 + hstep, voffA);
            PG8_WAIT_V(8); PG8_WAIT_L(0); PG8_BAR; PG8_MMA(0, 0, At, B0); PG8_MMA(0, 1, At, B1); PG8_BAR; PG8_SCHED;
            PG8_LDA(At, 1, 1); PG8_STAGE(PG8_SB(1, 0), b3, voffB); PG8_STAGE(PG8_SB(1, 1), b3 + hstep, voffB); PG8_STAGE(PG8_SA(1, 0), a3, voffA);
            PG8_WAIT_V(8); PG8_WAIT_L(0); PG8_BAR; PG8_MMA(1, 0, At, B0); PG8_MMA(1, 1, At, B1); PG8_BAR; PG8_SCHED;
            } else {
            PG8_LDB(B0, 0, 0); PG8_SCHED; PG8_LDA(At, 0, 0); PG8_STAGE(PG8_SA(1, 1), a1 + hstep, voffA);
            PG8_WAIT_L(8); PG8_BAR; PG8_WAIT_L(0); PG8_MMA(0, 0, At, B0); PG8_BAR; PG8_SCHED;
            PG8_LDB(B1, 0, 1); PG8_STAGE(PG8_SB(0, 0), b2, voffB);
            PG8_BAR; PG8_WAIT_L(0); PG8_MMA(0, 1, At, B1); PG8_BAR;
            PG8_LDA(At, 0, 1); PG8_STAGE(PG8_SA(0, 0), a2, voffA);
            PG8_BAR; PG8_WAIT_L(0); PG8_MMA(1, 0, At, B0); PG8_BAR; PG8_SCHED;
            PG8_STAGE(PG8_SB(0, 1), b2 + hstep, voffB);
            PG8_WAIT_V(6); PG8_BAR; PG8_MMA(1, 1, At, B1); PG8_BAR;
            PG8_LDB(B0, 1, 0); PG8_SCHED; PG8_LDA(At, 1, 0); PG8_STAGE(PG8_SA(0, 1), a2 + hstep, voffA);
            PG8_WAIT_L(8); PG8_BAR; PG8_WAIT_L(0); PG8_MMA(0, 0, At, B0); PG8_BAR; PG8_SCHED;
            PG8_LDB(B1, 1, 1); PG8_STAGE(PG8_SB(1, 0), b3, voffB);
            PG8_BAR; PG8_WAIT_L(0); PG8_MMA(0, 1, At, B1); PG8_BAR;
            PG8_LDA(At, 1, 1); PG8_STAGE(PG8_SA(1, 0), a3, voffA);
            PG8_BAR; PG8_WAIT_L(0); PG8_MMA(1, 0, At, B0); PG8_BAR; PG8_SCHED;
            PG8_STAGE(PG8_SB(1, 1), b3 + hstep, voffB);
            PG8_WAIT_V(6); PG8_BAR; PG8_MMA(1, 1, At, B1); PG8_BAR;
            }
        }
        if constexpr (ALIGN_EPI) { if (wr == 0) PG8_BAR; }
        if constexpr (!Epi::AFTER_DRAIN) { E(acc, cur, wr, wc, fr, fq); S.done(cur); }
        if (!has_next) break;
#pragma unroll
        for (int a = 0; a < 2; ++a)
#pragma unroll
            for (int b = 0; b < 2; ++b)
#pragma unroll
                for (int m = 0; m < 4; ++m)
#pragma unroll
                    for (int n = 0; n < 2; ++n) acc[a][b][m][n] = (f32x4){0.f, 0.f, 0.f, 0.f};
        cur = nxt; cA = nA; cB = nB; ++ui;
        if constexpr (ALIGN_EPI) { if (wr == 1) PG8_BAR; }
    }
    PG8_WAIT_V(0);
    if constexpr (!ALIGN_EPI) { if (wr == 0) PG8_BAR; }
    PG8_BAR;
    if constexpr (Epi::AFTER_DRAIN) { E.fused(acc, cur, wr, wc, fr, fq, lds, wid, lane); S.done(cur); }
#undef PG8_SA
#undef PG8_SB
#undef PG8_STAGE
#undef PG8_LDA
#undef PG8_LDB
#undef PG8_MMA
#undef PG8_WAIT_V
#undef PG8_WAIT_L
#undef PG8_BAR
#undef PG8_SCHED
}
}

struct EpiIn {
    static constexpr bool PERM = true, AFTER_DRAIN = false;
    bf16_t* tmp; bf16_t* keep;
    __device__ __forceinline__ void operator()(const pg8::f32x4 (&acc)[2][2][4][2], const pg8::Unit& u, int wr, int wc, int fr, int fq) const {
        const int row0 = u.pm * 256 + wr * 64 + fr, colt = u.pn * 256; bf16_t* base; int ldc;
        if (colt < NTMP) { base = tmp + colt; ldc = NTMP; } else { base = keep + (colt - NTMP); ldc = NKEEP; }
        const int col0 = wc * 32 + 8 * fq;
#pragma unroll
        for (int ai = 0; ai < 2; ++ai)
#pragma unroll
            for (int m = 0; m < 4; ++m) { bf16_t* rowp = base + (size_t)(row0 + ai * 128 + m * 16) * ldc + col0;
#pragma unroll
                for (int bj = 0; bj < 2; ++bj) { const pg8::f32x4 v0 = acc[ai][bj][m][0], v1 = acc[ai][bj][m][1]; pg8::u32x4 w;
                    w.x = pk2bf(v0[0], v0[1]); w.y = pk2bf(v0[2], v0[3]); w.z = pk2bf(v1[0], v1[1]); w.w = pk2bf(v1[2], v1[3]);
                    *(pg8::u32x4*)(rowp + bj * 128) = w; } }
    }
};
struct LatentOrder {
    int G, c;
    __device__ __forceinline__ bool next(int i, pg8::Unit& u) const { const int L = i * G + c; if (L >= 256) return false; const int pl = L >> 2; u.pm = (pl >> 4) * 17 + 1 + (pl & 15); u.pn = L & 3; return true; }
    __device__ __forceinline__ void a_ready(const pg8::Unit&) const {}
    __device__ __forceinline__ void done(const pg8::Unit&) const {}
};
struct CtxOrder {
    int G, c;
    __device__ __forceinline__ bool next(int i, pg8::Unit& u) const { const int L = i * G + c; if (L >= 16) return false; u.pm = (L >> 2) * 17; u.pn = L & 3; return true; }
    __device__ __forceinline__ void a_ready(const pg8::Unit&) const {}
    __device__ __forceinline__ void done(const pg8::Unit&) const {}
};
struct InOrder {
    int G, c, pass;
    static __device__ __forceinline__ int mustcol(int k) { return k < 5 ? k : k < 7 ? k + 1 : k + 2; }
    static __device__ __forceinline__ int freecol(int k) { return k < 2 ? 5 + 3 * k : 9 + k; }
    static __device__ __forceinline__ void must_tile(int L, pg8::Unit& u) { const int xcd = L & 7, off = L >> 3; const int pmi = xcd * 8 + (off & 7); u.pm = pmi + (pmi >> 4) + 1; u.pn = mustcol(off >> 3); }
    static __device__ __forceinline__ void free_tile(int j, pg8::Unit& u) { const int pmi = j >> 2; u.pm = pmi + (pmi >> 4) + 1; u.pn = freecol(j & 3); }
    __device__ __forceinline__ bool next(int i, pg8::Unit& u) const {
        if (G == 256) {
            if (pass == 0) { if (c >= 16) { if (i >= 2) return false; must_tile(i * 240 + (c - 16), u); } else { if (i >= 1) return false; must_tile(480 + c, u); } return true; }
            if (pass == 1) { if (i >= 1) return false; if (c < 80) must_tile(496 + c, u); else if (c < 116) { const int t = c - 80; u.pm = (t / 9) * 17; u.pn = mustcol(t % 9); } else free_tile(c - 116, u); return true; }
            if (i >= 1 || c >= 132) return false;
            const int x = c & 7, t = (x < 4 ? 17 * x : 68 + 16 * (x - 4)) + (c >> 3);
            if (t < 116) free_tile(140 + t, u); else { const int q = t - 116; u.pm = (q >> 2) * 17; u.pn = freecol(q & 3); }
            return true; }
        if (pass != 0) return false; const long LL = (long)i * G + c; if (LL >= 884) return false; const int L = (int)LL;
        if (L < 748) { constexpr int nwg = 748, nM = 68, nN = 11; int wgid = L; { constexpr int q = nwg / pg8::NXCD, r = nwg % pg8::NXCD; const int xcd = wgid % pg8::NXCD, off = wgid / pg8::NXCD; wgid = (xcd < r ? xcd * (q + 1) : r * (q + 1) + (xcd - r) * q) + off; }
            constexpr int nig = pg8::WGM * nN; const int gid = wgid / nig, fm = gid * pg8::WGM, gsz = (nM - fm) < pg8::WGM ? (nM - fm) : pg8::WGM;
            u.pm = fm + ((wgid % nig) % gsz); u.pn = (wgid % nig) / gsz; }
        else { const int jt = L - 748; u.pm = jt >> 1; u.pn = 11 + (jt & 1); }
        return true; }
    __device__ __forceinline__ void a_ready(const pg8::Unit&) const {}
    __device__ __forceinline__ void done(const pg8::Unit&) const {}
};
struct EpiOut {
    static constexpr bool PERM = false, AFTER_DRAIN = false;
    const float *x_in, *ctx_in; float *x_out, *xc; const float* mod;
    __device__ __forceinline__ void operator()(const pg8::f32x4 (&acc)[2][2][4][2], const pg8::Unit& u, int wr, int wc, int fr, int fq) const {
        const int b = u.pm / 17, tt = u.pm % 17; const float* xi; float* xo; int mr;
        if (tt == 0) { xi = ctx_in + (size_t)b * CTX * DM; xo = xc + (size_t)b * CTX * DM; mr = 4; }
        else { const size_t o = ((size_t)b * SEQ + (size_t)(tt - 1) * 256) * DM; xi = x_in + o; xo = x_out + o; mr = b; }
        const float* gate = mod + mr * 3072 + 2048; const int col0 = u.pn * 256 + wc * 32 + 4 * fq;
#pragma unroll
        for (int bj = 0; bj < 2; ++bj)
#pragma unroll
            for (int n = 0; n < 2; ++n) { const pg8::f32x4 g = *(const pg8::f32x4*)(gate + col0 + bj * 128 + n * 16);
                { pg8::f32x4 xv[8];
#pragma unroll
                  for (int am = 0; am < 8; ++am) xv[am] = *(const pg8::f32x4*)(xi + (size_t)((am >> 2) * 128 + wr * 64 + (am & 3) * 16 + fr) * DM + col0 + bj * 128 + n * 16);
                  SB();
#pragma unroll
                  for (int am = 0; am < 8; ++am) *(pg8::f32x4*)(xo + (size_t)((am >> 2) * 128 + wr * 64 + (am & 3) * 16 + fr) * DM + col0 + bj * 128 + n * 16) = xv[am] + g * acc[am >> 2][bj][am & 3][n];
                  SB(); } }
    }
};

template <bool MAPPED> __device__ __forceinline__ void transpose_item(const float* W, int K, int N, bf16_t* WT, int NP  , float* scr, int item, int lane) {
    const int nblk = NP / 32, kb = item / nblk, nb = item % nblk, k0 = 64 * kb, n0 = 32 * nb;
    const int oc = MAPPED ? in_col_map(n0 + (lane & 31)) : (n0 + (lane & 31) < N ? n0 + (lane & 31) : -1);
    const int cb_ = MAPPED ? in_col_map(n0) : n0;
    if ((N & 3) == 0 && (!MAPPED || n0 < 416 || n0 >= 512)) {
        float4 wv[8];
#pragma unroll
        for (int i = 0; i < 8; ++i) wv[i] = *(const float4*)(W + (size_t)(k0 + 8 * i + (lane >> 3)) * N + cb_ + 4 * (lane & 7));
        SB();
#pragma unroll
        for (int i = 0; i < 8; ++i) { float* s_ = scr + (8 * i + (lane >> 3)) * 33 + 4 * (lane & 7); s_[0] = wv[i].x; s_[1] = wv[i].y; s_[2] = wv[i].z; s_[3] = wv[i].w; }
    } else {
#pragma unroll 1
    for (int i0 = 0; i0 < 32; i0 += 16) { float wv[16];
#pragma unroll
        for (int i = 0; i < 16; ++i) { const int kk = 2 * (i0 + i) + (lane >> 5); wv[i] = oc >= 0 ? W[(size_t)(k0 + kk) * N + oc] : 0.f; }
        SB();
#pragma unroll
        for (int i = 0; i < 16; ++i) { const int kk = 2 * (i0 + i) + (lane >> 5); scr[kk * 33 + (lane & 31)] = wv[i]; } }
    }
    asm volatile("s_waitcnt lgkmcnt(0)" ::: "memory");
    const int c = lane & 7;
#pragma unroll
    for (int j = 0; j < 4; ++j) { const int n = (lane >> 3) + 8 * j; const float* s = scr + (8 * c) * 33 + n;
        uint4 o; o.x = pk2bf(s[0], s[33]); o.y = pk2bf(s[2 * 33], s[3 * 33]);
        o.z = pk2bf(s[4 * 33], s[5 * 33]); o.w = pk2bf(s[6 * 33], s[7 * 33]);
        *(uint4*)(WT + (size_t)(n0 + n) * K + k0 + 8 * c) = o; }
    asm volatile("s_waitcnt lgkmcnt(0)" ::: "memory");
}
__device__ __forceinline__ void weights_layer(const P& p, char* lds, int l, int wgi, int nwg) {
    const int t5 = tid512_fresh(), lane = t5 & 63, gwave = wgi * 8 + (t5 >> 6), ngwaves = nwg * 8; float* scr = (float*)(lds + (t5 >> 6) * 8448);
    constexpr int I_IN = 16 * 104, I_OUT = 16 * 32, I_L = I_IN + I_OUT;
    for (int it = gwave; it < I_L; it += ngwaves) { int r = it;
        if (r < I_IN) { transpose_item<true>(p.w_in + (size_t)l * DM * IN_COLS, DM, IN_COLS, (bf16_t*)(p.ws + WS_WIN) + (size_t)l * 3328 * DM, 3328, scr, r, lane); continue; } r -= I_IN;
        transpose_item<false>(p.w_out + (size_t)l * DM * DM, DM, DM, (bf16_t*)(p.ws + WS_WOUT) + (size_t)l * DM * DM, DM, scr, r - 0, lane);
    }
}

__device__ __forceinline__ void mla_weight_frags(const P& p, int bx, int G) {
    for (int it = bx * 512 + tid512_fresh(); it < DEPTH * 20480; it += G * 512) { const int l = it / 20480; int r = it % 20480; const float* W; int N, t, ks, ln; bf16_t* dst;
        if (r < 12288) { W = p.w_q_up + (size_t)l * 256 * 384; N = 384; t = r >> 10; ks = (r >> 6) & 15; ln = r & 63; dst = (bf16_t*)(p.ws + WS_WQ) + (size_t)l * 98304 + (size_t)r * 8; }
        else { r -= 12288; W = p.w_kv_up + (size_t)l * 128 * 512; N = 512; t = r >> 9; ks = (r >> 6) & 7; ln = r & 63; dst = (bf16_t*)(p.ws + WS_WKV) + (size_t)l * 65536 + (size_t)r * 8; }
        const float* s = W + (size_t)(ks * 16 + (ln >> 5) * 8) * N + 32 * t + (ln & 31);
        uint4 o; o.x = pk2bf(s[0], s[N]); o.y = pk2bf(s[2 * N], s[3 * N]);
        o.z = pk2bf(s[4 * N], s[5 * N]); o.w = pk2bf(s[6 * N], s[7 * N]);
        *(uint4*)dst = o; }
}
namespace att {
typedef short bf16x8 __attribute__((ext_vector_type(8)));
typedef short s16x4 __attribute__((ext_vector_type(4)));
typedef float f32x16 __attribute__((ext_vector_type(16)));
typedef unsigned u32x4 __attribute__((ext_vector_type(4)));
#define ASBAR() __builtin_amdgcn_sched_barrier(0)
constexpr float THR2 = 6.f;
constexpr int SHM_V = 8192, SHM_K = 16384;
constexpr int LDS_VOFF = 0, LDS_KOFF = 3 * SHM_V, LDS_WSOFF = 3 * SHM_V + 3 * SHM_K, LDS_TOTAL = LDS_WSOFF + 8 * 256;
__device__ __forceinline__ int crow(int r, int hi) { return (r & 3) + 8 * (r >> 2) + 4 * hi; }
__device__ __forceinline__ unsigned cvtpk(float lo, float hi) { unsigned r; asm volatile("v_cvt_pk_bf16_f32 %0, %1, %2" : "=v"(r) : "v"(lo), "v"(hi)); return r; }
template <int DQ> __device__ __forceinline__ int kswz(int row, int ch) { return DQ == 64 ? row * 128 + ((ch ^ ((row >> 1) & 7)) << 4) : row * 256 + ((ch ^ (row & 15)) << 4); }
__device__ __forceinline__ int v_st(int k, int c) { const int kk = (k & ~0xC) | ((k & 4) << 1) | ((k & 8) >> 1); return ((kk >> 3) * 2 + (c >> 5)) * 512 + ((kk & 7) * 32 + (c & 31)) * 2; }
__device__ __forceinline__ int v_rd_base(int lane) { return ((lane & 3) << 3) | (((lane >> 2) & 3) << 6) | (((lane >> 4) & 1) << 5) | (((lane >> 5) & 1) << 8); }
constexpr int v_rd_off(int d0, int ks, int half) { return d0 * 512 + ks * 2048 + half * 1024; }
template <int OFF> __device__ __forceinline__ s16x4 tr_read(int vb) { s16x4 r; asm volatile("ds_read_b64_tr_b16 %0, %1 offset:%2" : "=&v"(r) : "v"(vb), "i"(OFF) : "memory"); return r; }

__device__ __forceinline__ void partialSM(f32x16& p0, f32x16& p1, float& m_reg, float& mn, float& alpha) {
    float pmax = p0[0];
#pragma unroll
    for (int r = 1; r < 16; ++r) pmax = fmaxf(pmax, p0[r]);
#pragma unroll
    for (int r = 0; r < 16; ++r) pmax = fmaxf(pmax, p1[r]);
    { auto rr = __builtin_amdgcn_permlane32_swap(__float_as_uint(pmax), __float_as_uint(pmax), false, false); pmax = fmaxf(__uint_as_float(rr[0]), __uint_as_float(rr[1])); }
    if (__builtin_expect(__all(pmax - m_reg <= THR2), 1)) { mn = m_reg; alpha = 1.f; }
    else { mn = fmaxf(m_reg, pmax); alpha = __builtin_amdgcn_exp2f(m_reg - mn); m_reg = mn; }
#pragma unroll
    for (int r = 0; r < 16; ++r) { p0[r] -= mn; p1[r] -= mn; }
#pragma unroll
    for (int r = 0; r < 16; ++r) p0[r] = __builtin_amdgcn_exp2f(p0[r]);
}
__device__ __forceinline__ void finishSM(f32x16& p0, f32x16& p1, float alpha, float& l_reg, bf16x8& pa0, bf16x8& pa1, bf16x8& pa2, bf16x8& pa3) {
#pragma unroll
    for (int r = 0; r < 16; ++r) p1[r] = __builtin_amdgcn_exp2f(p1[r]);
    float ps = 0;
#pragma unroll
    for (int r = 0; r < 16; ++r) ps += p0[r];
#pragma unroll
    for (int r = 0; r < 16; ++r) ps += p1[r];
    { auto rr = __builtin_amdgcn_permlane32_swap(__float_as_uint(ps), __float_as_uint(ps), false, false); ps = __uint_as_float(rr[0]) + __uint_as_float(rr[1]); }
    l_reg = l_reg * alpha + ps;
#define ATT_PK4(P, BASE, OUT) do { unsigned a0 = cvtpk(P[BASE + 0], P[BASE + 1]), a1 = cvtpk(P[BASE + 2], P[BASE + 3]);   \
    unsigned b0 = cvtpk(P[BASE + 4], P[BASE + 5]), b1 = cvtpk(P[BASE + 6], P[BASE + 7]);                              \
    auto r0 = __builtin_amdgcn_permlane32_swap(a0, b0, false, false); auto r1 = __builtin_amdgcn_permlane32_swap(a1, b1, false, false); \
    u32x4 w = {r0[0], r1[0], r0[1], r1[1]}; OUT = *reinterpret_cast<bf16x8*>(&w); } while (0)
    ATT_PK4(p0, 0, pa0); ATT_PK4(p0, 8, pa1); ATT_PK4(p1, 0, pa2); ATT_PK4(p1, 8, pa3);
#undef ATT_PK4
}
template <int DQ> __device__ __forceinline__ void qkt(f32x16& p0, f32x16& p1, const char* Ks, const bf16x8* qr, int r32, int hi) {
    p0 = f32x16{}; p1 = f32x16{};
#pragma unroll
    for (int d0 = 0; d0 < DQ / 16; ++d0) { const int ch = d0 * 2 + hi;
        const bf16x8 b0 = *reinterpret_cast<const bf16x8*>(Ks + kswz<DQ>(r32, ch));
        const bf16x8 b1 = *reinterpret_cast<const bf16x8*>(Ks + kswz<DQ>(32 + r32, ch));
        p0 = __builtin_amdgcn_mfma_f32_32x32x16_bf16(b0, qr[d0], p0, 0, 0, 0);
        p1 = __builtin_amdgcn_mfma_f32_32x32x16_bf16(b1, qr[d0], p1, 0, 0, 0); }
}
template <int D0> __device__ __forceinline__ void pv_one(f32x16& od, int vb, bf16x8 pa0, bf16x8 pa1, bf16x8 pa2, bf16x8 pa3) {
    const s16x4 l0 = tr_read<v_rd_off(D0, 0, 0)>(vb), h0 = tr_read<v_rd_off(D0, 0, 1)>(vb), l1 = tr_read<v_rd_off(D0, 1, 0)>(vb), h1 = tr_read<v_rd_off(D0, 1, 1)>(vb);
    const s16x4 l2 = tr_read<v_rd_off(D0, 2, 0)>(vb), h2 = tr_read<v_rd_off(D0, 2, 1)>(vb), l3 = tr_read<v_rd_off(D0, 3, 0)>(vb), h3 = tr_read<v_rd_off(D0, 3, 1)>(vb);
    asm volatile("s_waitcnt lgkmcnt(0)" ::: "memory"); ASBAR();
#define ATT_PK(L, H) (bf16x8){L[0], L[1], L[2], L[3], H[0], H[1], H[2], H[3]}
    od = __builtin_amdgcn_mfma_f32_32x32x16_bf16(pa0, ATT_PK(l0, h0), od, 0, 0, 0);
    od = __builtin_amdgcn_mfma_f32_32x32x16_bf16(pa1, ATT_PK(l1, h1), od, 0, 0, 0);
    od = __builtin_amdgcn_mfma_f32_32x32x16_bf16(pa2, ATT_PK(l2, h2), od, 0, 0, 0);
    od = __builtin_amdgcn_mfma_f32_32x32x16_bf16(pa3, ATT_PK(l3, h3), od, 0, 0, 0);
#undef ATT_PK
}
__device__ __forceinline__ void pv_all(f32x16* o, int vb, bf16x8 pa0, bf16x8 pa1, bf16x8 pa2, bf16x8 pa3) { pv_one<0>(o[0], vb, pa0, pa1, pa2, pa3); pv_one<1>(o[1], vb, pa0, pa1, pa2, pa3); }


template <int DQ> __device__ __forceinline__ void qkt2(f32x16& p0, f32x16& p1, const char* Ks, const bf16x8* qr, const f32x16& negm, int r32, int hi) {
#pragma unroll
    for (int d0 = 0; d0 < DQ / 16; ++d0) { const int ch = d0 * 2 + hi;
        const bf16x8 b0 = *reinterpret_cast<const bf16x8*>(Ks + kswz<DQ>(r32, ch));
        const bf16x8 b1 = *reinterpret_cast<const bf16x8*>(Ks + kswz<DQ>(32 + r32, ch));
        if (d0 == 0) { p0 = __builtin_amdgcn_mfma_f32_32x32x16_bf16(b0, qr[0], negm, 0, 0, 0); p1 = __builtin_amdgcn_mfma_f32_32x32x16_bf16(b1, qr[0], negm, 0, 0, 0); }
        else { p0 = __builtin_amdgcn_mfma_f32_32x32x16_bf16(b0, qr[d0], p0, 0, 0, 0); p1 = __builtin_amdgcn_mfma_f32_32x32x16_bf16(b1, qr[d0], p1, 0, 0, 0); } }
}
template <bool FIRST> __device__ __forceinline__ void partialSM2(f32x16& p0, f32x16& p1, float& m_ref, f32x16& negm, float& alpha) {
    float pmax = p0[0];
#pragma unroll
    for (int r = 1; r < 16; ++r) pmax = fmaxf(pmax, p0[r]);
#pragma unroll
    for (int r = 0; r < 16; ++r) pmax = fmaxf(pmax, p1[r]);
    { auto rr = __builtin_amdgcn_permlane32_swap(__float_as_uint(pmax), __float_as_uint(pmax), false, false); pmax = fmaxf(__uint_as_float(rr[0]), __uint_as_float(rr[1])); }
    alpha = 1.f;
    if (FIRST || !__builtin_expect(__all(pmax <= THR2), 1)) { const float dl = FIRST ? pmax : fmaxf(pmax, 0.f); m_ref += dl; if (!FIRST) alpha = __builtin_amdgcn_exp2f(-dl);
#pragma unroll
        for (int r = 0; r < 16; ++r) { p0[r] -= dl; p1[r] -= dl; }
#pragma unroll
        for (int r = 0; r < 16; ++r) negm[r] = -m_ref; }
#pragma unroll
    for (int r = 0; r < 16; ++r) p0[r] = __builtin_amdgcn_exp2f(p0[r]);
}
__device__ __forceinline__ void finishSM2(f32x16& p0, f32x16& p1, bf16x8& pa0, bf16x8& pa1, bf16x8& pa2, bf16x8& pa3) {
#pragma unroll
    for (int r = 0; r < 16; ++r) p1[r] = __builtin_amdgcn_exp2f(p1[r]);
#define ATT_PK4(P, BASE, OUT) do { unsigned a0 = cvtpk(P[BASE + 0], P[BASE + 1]), a1 = cvtpk(P[BASE + 2], P[BASE + 3]);   \
    unsigned b0 = cvtpk(P[BASE + 4], P[BASE + 5]), b1 = cvtpk(P[BASE + 6], P[BASE + 7]);                              \
    auto r0 = __builtin_amdgcn_permlane32_swap(a0, b0, false, false); auto r1 = __builtin_amdgcn_permlane32_swap(a1, b1, false, false); \
    u32x4 w = {r0[0], r1[0], r0[1], r1[1]}; OUT = *reinterpret_cast<bf16x8*>(&w); } while (0)
    ATT_PK4(p0, 0, pa0); ATT_PK4(p0, 8, pa1); ATT_PK4(p1, 0, pa2); ATT_PK4(p1, 8, pa3);
#undef ATT_PK4
}
__device__ __forceinline__ void pv_all2(f32x16* o, f32x16& osum, int vb, bf16x8 pa0, bf16x8 pa1, bf16x8 pa2, bf16x8 pa3) {
    pv_one<0>(o[0], vb, pa0, pa1, pa2, pa3); pv_one<1>(o[1], vb, pa0, pa1, pa2, pa3);
    const bf16x8 ones = {16256, 16256, 16256, 16256, 16256, 16256, 16256, 16256};
    osum = __builtin_amdgcn_mfma_f32_32x32x16_bf16(pa0, ones, osum, 0, 0, 0); osum = __builtin_amdgcn_mfma_f32_32x32x16_bf16(pa1, ones, osum, 0, 0, 0);
    osum = __builtin_amdgcn_mfma_f32_32x32x16_bf16(pa2, ones, osum, 0, 0, 0); osum = __builtin_amdgcn_mfma_f32_32x32x16_bf16(pa3, ones, osum, 0, 0, 0);
}
struct Unit {
    const bf16_t* Q; int ldq;
    const bf16_t* K; int ldk;
    const bf16_t* V; int ldv;
    const bf16_t* gate; bf16_t* out;
    int n1, n2, row2;
    int tq0; float sink_l2;
};
template <int DQ, int MODE> __device__ __forceinline__ void attn_unit(const Unit& U, char* lds) {
    const int tid = tid512_fresh(), wid = tid >> 6, lane = tid & 63, r32 = lane & 31, hi = lane >> 5;
    char* V_lds = lds + LDS_VOFF; char* K_lds = lds + LDS_KOFF;
    float* wsp = (float*)(lds + LDS_WSOFF) + wid * 64; float* li_l = wsp; float* al_l = wsp + 32;
    float m_reg = 0.f; f32x16 o[2] = {}, osum = {}, negm = {}; bf16x8 qr[DQ / 16];
    { const bf16_t* Qw = U.Q + (size_t)(wid * 32 + r32) * U.ldq + hi * 8;
#pragma unroll
      for (int d0 = 0; d0 < DQ / 16; ++d0) qr[d0] = *reinterpret_cast<const bf16x8*>(Qw + d0 * 16); }
    constexpr int KCH = DQ / 8;
    const int kr0 = tid / KCH, kc0 = tid % KCH, kr1 = (512 + tid) / KCH, kc1 = (512 + tid) % KCH; const bool k2 = (DQ == 96) && tid < 256;
    const int vr = tid >> 3, vc = (tid & 7) * 8;
    const int kst0 = kswz<DQ>(kr0, kc0), kst1 = kswz<DQ>(k2 ? kr1 : 0, k2 ? kc1 : 0), vst = v_st(vr, vc);
    const int vb0 = (int)(uintptr_t)V_lds + v_rd_base(lane);
    struct { bf16x8 ks0, ks1, vs0; } sr_[2];
    const int NT = U.n1 + U.n2;
#define ATT_TROW(j) ((j) < U.n1 ? 64 * (j) : U.row2 + 64 * ((j) - U.n1))
#define ATT_CROW(j) (MODE == 1 ? min(max(ATT_TROW(j), 0), SPB - 64) : ATT_TROW(j))
#define ATT_SLOAD(i, j) do { const int row_ = ATT_CROW(j); sr_[i].ks0 = *reinterpret_cast<const bf16x8*>(U.K + (size_t)(row_ + kr0) * U.ldk + kc0 * 8); \
    if (k2) sr_[i].ks1 = *reinterpret_cast<const bf16x8*>(U.K + (size_t)(row_ + kr1) * U.ldk + kc1 * 8); \
    sr_[i].vs0 = *reinterpret_cast<const bf16x8*>(U.V + (size_t)(row_ + vr) * U.ldv + vc); } while (0)
#define ATT_SWRITE(b, i) do { *(bf16x8*)(K_lds + (b) * SHM_K + kst0) = sr_[i].ks0; if (k2) *(bf16x8*)(K_lds + (b) * SHM_K + kst1) = sr_[i].ks1; *(bf16x8*)(V_lds + (b) * SHM_V + vst) = sr_[i].vs0; } while (0)
#define ATT_SWAIT() asm volatile("s_waitcnt vmcnt(2)" ::: "memory")
#define ATT_RESC(a) do { if (__any((a) < 1.f)) { if (hi == 0) al_l[r32] = (a); asm volatile("s_waitcnt lgkmcnt(0)" ::: "memory"); \
    _Pragma("unroll") for (int r = 0; r < 16; ++r) { const float a_ = al_l[crow(r, hi)]; o[0][r] *= a_; o[1][r] *= a_; osum[r] *= a_; } } } while (0)
    const int tq = U.tq0 + wid * 32 + r32;
#define ATT_MASK(P0, P1, j) do { if (MODE == 1 && (j) >= U.n1) { const int tk0_ = ATT_TROW(j) - CTX + 4 * hi; const int lo_ = max(tq - 128, 0), hi_ = min(tq + 128, SEQ - 1); \
    _Pragma("unroll") for (int r = 0; r < 16; ++r) { const int tk_ = tk0_ + (r & 3) + 8 * (r >> 2); if (tk_ < lo_ || tk_ > hi_) P0[r] = -1e30f; if (tk_ + 32 < lo_ || tk_ + 32 > hi_) P1[r] = -1e30f; } } } while (0)
    f32x16 pA0, pA1, pB0, pB1; float alA, alB; bf16x8 pa0, pa1, pa2, pa3;
    if (__builtin_amdgcn_readfirstlane(tid) >= 256) __builtin_amdgcn_s_setprio(1);
    ATT_SLOAD(0, 0); asm volatile("s_waitcnt vmcnt(0)" ::: "memory"); ATT_SWRITE(0, 0);
    ATT_SLOAD(1, 1); if (2 < NT) ATT_SLOAD(0, 2);
    __syncthreads();
    qkt2<DQ>(pA0, pA1, K_lds, qr, negm, r32, hi); ATT_MASK(pA0, pA1, 0); partialSM2<true>(pA0, pA1, m_reg, negm, alA);
    ATT_SWAIT(); ATT_SWRITE(1, 1); __syncthreads();
    int bprev = 0, bcur = 1, bnext = 2;
    for (int j = 1; j + 1 < NT; j += 2) {
        ASBAR(); qkt2<DQ>(pB0, pB1, K_lds + bcur * SHM_K, qr, negm, r32, hi);
        finishSM2(pA0, pA1, pa0, pa1, pa2, pa3); ASBAR();
        ATT_SLOAD(1, j + 2 < NT ? j + 2 : NT - 1); ASBAR();
        pv_all2(o, osum, vb0 + bprev * SHM_V, pa0, pa1, pa2, pa3); ATT_MASK(pB0, pB1, j); partialSM2<false>(pB0, pB1, m_reg, negm, alB);
        ATT_SWAIT(); ATT_SWRITE(bnext, 0);
        ATT_RESC(alB); __syncthreads();
        ASBAR(); qkt2<DQ>(pA0, pA1, K_lds + bnext * SHM_K, qr, negm, r32, hi);
        finishSM2(pB0, pB1, pa0, pa1, pa2, pa3); ASBAR();
        if (j + 3 < NT) ATT_SLOAD(0, j + 3); ASBAR();
        pv_all2(o, osum, vb0 + bcur * SHM_V, pa0, pa1, pa2, pa3); ATT_MASK(pA0, pA1, j + 1); partialSM2<false>(pA0, pA1, m_reg, negm, alA);
        ATT_SWAIT(); ATT_SWRITE(bprev, 1);
        ATT_RESC(alA); __syncthreads();
        { const int t_ = bprev; bprev = bnext; bnext = bcur; bcur = t_; }
    }
    ASBAR(); qkt2<DQ>(pB0, pB1, K_lds + bcur * SHM_K, qr, negm, r32, hi);
    finishSM2(pA0, pA1, pa0, pa1, pa2, pa3); ASBAR();
    pv_all2(o, osum, vb0 + bprev * SHM_V, pa0, pa1, pa2, pa3); ATT_MASK(pB0, pB1, NT - 1); partialSM2<false>(pB0, pB1, m_reg, negm, alB);
    ATT_RESC(alB);
    const size_t qrow = (size_t)(wid * 32 + r32); u32x4 gq[4];
#pragma unroll
    for (int k = 0; k < 4; ++k) gq[k] = *(const u32x4*)(U.gate + qrow * NKEEP + hi * 32 + k * 8);
    finishSM2(pB0, pB1, pa0, pa1, pa2, pa3); ASBAR();
    pv_all2(o, osum, vb0 + bcur * SHM_V, pa0, pa1, pa2, pa3);
    if (MODE == 1) {
        if (hi == 0) li_l[r32] = m_reg; asm volatile("s_waitcnt lgkmcnt(0)" ::: "memory");
#pragma unroll
        for (int r = 0; r < 16; ++r) osum[r] += __builtin_amdgcn_exp2f(U.sink_l2 - li_l[crow(r, hi)]); }
    float rli[16];
#pragma unroll
    for (int r = 0; r < 16; ++r) rli[r] = __builtin_amdgcn_rcpf(osum[r]);
    { char* tl = lds + 81920 + wid * 4608;
#pragma unroll
      for (int r = 0; r < 16; ++r) { const unsigned w_ = pk2bf(o[0][r] * rli[r], o[1][r] * rli[r]); bf16_t* tp = (bf16_t*)(tl + crow(r, hi) * 144) + r32; tp[0] = (bf16_t)(w_ & 0xffffu); tp[32] = (bf16_t)(w_ >> 16); }
      SB();
      u32x4 ov[4];
#pragma unroll
      for (int k = 0; k < 4; ++k) ov[k] = *(const u32x4*)(tl + r32 * 144 + hi * 64 + k * 16);
#pragma unroll
      for (int k = 0; k < 4; ++k) { u32x4 w;
#pragma unroll
          for (int e = 0; e < 4; ++e) { const unsigned vv = ov[k][e], gg = gq[k][e];
              w[e] = cvtpk(__uint_as_float(vv << 16) * silu_f(__uint_as_float(gg << 16)), __uint_as_float(vv & 0xffff0000u) * silu_f(__uint_as_float(gg & 0xffff0000u))); }
          *(u32x4*)(U.out + qrow * DM + hi * 32 + k * 8) = w; } }
    __builtin_amdgcn_s_setprio(0);
    __syncthreads();
#undef ATT_TROW
#undef ATT_CROW
#undef ATT_SLOAD
#undef ATT_SWRITE
#undef ATT_SWAIT
#undef ATT_RESC
#undef ATT_MASK
}
}

namespace attn_b {
using bf16=__hip_bfloat16;
using bf16x8=__attribute__((ext_vector_type(8)))short;
using s16x4=__attribute__((ext_vector_type(4)))short;
using f32x16=__attribute__((ext_vector_type(16)))float;
using u32x4=__attribute__((ext_vector_type(4)))unsigned;
constexpr int D=64;
constexpr int NW=8,QBLK=32,QB=QBLK*NW,KVBLK=64;
constexpr int ATTN_UNIT_ROWS=QB;
__device__ __forceinline__ int crow(int r,int hi){return (r&3)+8*(r>>2)+4*hi;}
#define SBAR() __builtin_amdgcn_sched_barrier(0)
__device__ __forceinline__ void cmask(f32x16&p0,f32x16&p1,int jb,int qrel,int hi){
  const float NEG=-INFINITY; int kb=64*jb+4*hi;
  #pragma unroll
  for(int r=0;r<16;++r){int kv=kb+(r&3)+8*(r>>2); if(kv>qrel)p0[r]=NEG; if(kv+32>qrel)p1[r]=NEG;}
}

constexpr int NSLOT=3, SLOTB=8192;
constexpr int LDS_K=0, LDS_V=NSLOT*SLOTB, LDS_WS=2*NSLOT*SLOTB, LDS_OST=LDS_WS+NW*64*4, LDS_BYTES=LDS_OST+NW*4096;
constexpr float C2=0.125f*1.4426950408889634f;
__device__ __forceinline__ void glds16(const void*gsrc,unsigned lds_dst){unsigned keep;
  asm volatile("s_mov_b32 %0, m0\n\ts_mov_b32 m0, %2\n\ts_nop 0\n\tglobal_load_lds_dwordx4 %1, off\n\ts_mov_b32 m0, %0":"=&s"(keep):"v"(gsrc),"s"(lds_dst):"memory");}
__device__ __forceinline__ float max3f(float a,float b,float c){float r;asm("v_max3_f32 %0, %1, %2, %3":"=v"(r):"v"(a),"v"(b),"v"(c));return r;}
__device__ __forceinline__ float max2f(float a,float b){float r;asm("v_max_f32_e32 %0, %1, %2":"=v"(r):"v"(a),"v"(b));return r;}
__device__ __forceinline__ float fadd_s(float a,float b){float r;asm("v_add_f32_e32 %0, %1, %2":"=v"(r):"v"(a),"v"(b));return r;}
__device__ __forceinline__ float fsub_s(float a,float b){float r;asm("v_sub_f32_e32 %0, %1, %2":"=v"(r):"v"(a),"v"(b));return r;}
typedef float f32x2_t __attribute__((ext_vector_type(2))); typedef __bf16 bf16x2_t __attribute__((ext_vector_type(2)));
__device__ __forceinline__ unsigned cvtpk_s(float lo,float hi){f32x2_t v={lo,hi};bf16x2_t b=__builtin_convertvector(v,bf16x2_t);return __builtin_bit_cast(unsigned,b);}
#define WAIT_BAR(N) asm volatile("s_waitcnt vmcnt(" #N ") lgkmcnt(0)\n\ts_barrier":::"memory")

__device__ __forceinline__ void qkt(f32x16&p0,f32x16&p1,const char*Kslot,const bf16x8*qr,const f32x16&negm,int r32,int hi){
  const char*kb=Kslot+hi*1024+r32*16;
  #pragma unroll
  for(int d0=0;d0<4;++d0){
    const bf16x8 b0=*reinterpret_cast<const bf16x8*>(kb+d0*2048);
    const bf16x8 b1=*reinterpret_cast<const bf16x8*>(kb+d0*2048+512);
    if(d0==0){p0=__builtin_amdgcn_mfma_f32_32x32x16_bf16(b0,qr[0],negm,0,0,0);p1=__builtin_amdgcn_mfma_f32_32x32x16_bf16(b1,qr[0],negm,0,0,0);}
    else{p0=__builtin_amdgcn_mfma_f32_32x32x16_bf16(b0,qr[d0],p0,0,0,0);p1=__builtin_amdgcn_mfma_f32_32x32x16_bf16(b1,qr[d0],p1,0,0,0);}}
}
typedef __attribute__((address_space(3))) const char* lds_cptr;
typedef short v4i16_t __attribute__((ext_vector_type(4)));
__device__ __forceinline__ void kload8(bf16x8*kf,lds_cptr kp){
  kf[0]=*(const __attribute__((address_space(3))) bf16x8*)(kp);      kf[1]=*(const __attribute__((address_space(3))) bf16x8*)(kp+512);
  kf[2]=*(const __attribute__((address_space(3))) bf16x8*)(kp+2048); kf[3]=*(const __attribute__((address_space(3))) bf16x8*)(kp+2560);
  kf[4]=*(const __attribute__((address_space(3))) bf16x8*)(kp+4096); kf[5]=*(const __attribute__((address_space(3))) bf16x8*)(kp+4608);
  kf[6]=*(const __attribute__((address_space(3))) bf16x8*)(kp+6144); kf[7]=*(const __attribute__((address_space(3))) bf16x8*)(kp+6656);
}
__device__ __forceinline__ void kload2(bf16x8*kf,lds_cptr kp,int j){ kf[2*j]=*(const __attribute__((address_space(3))) bf16x8*)(kp+j*2048); kf[2*j+1]=*(const __attribute__((address_space(3))) bf16x8*)(kp+j*2048+512); }
__device__ __forceinline__ s16x4 vtr(lds_cptr p){ return __builtin_bit_cast(s16x4,__builtin_amdgcn_ds_read_tr16_b64_v4i16((__attribute__((address_space(3))) v4i16_t*)p)); }
__device__ __forceinline__ float rowmax(const f32x16&p0,const f32x16&p1){
  float a=max3f(p0[0],p0[1],p1[0]),b=max3f(p0[2],p0[3],p1[1]);a=max3f(a,p1[2],p1[3]);
  #pragma unroll
  for(int r=4;r<16;r+=4){a=max3f(a,p0[r],p0[r+1]);b=max3f(b,p0[r+2],p0[r+3]);a=max3f(a,p1[r],p1[r+1]);b=max3f(b,p1[r+2],p1[r+3]);}
  const float m=max2f(a,b);
  auto rr=__builtin_amdgcn_permlane32_swap(__float_as_uint(m),__float_as_uint(m),false,false);
  return max2f(__uint_as_float(rr[0]),__uint_as_float(rr[1]));
}
__device__ __forceinline__ void pv(f32x16*o,int vb,bf16x8 pa0,bf16x8 pa1,bf16x8 pa2,bf16x8 pa3){
  #pragma unroll
  for(int d0=0;d0<2;++d0){s16x4 lo[4],hi[4];
    #pragma unroll
    for(int ks=0;ks<4;++ks){
      asm volatile("ds_read_b64_tr_b16 %0,%1 offset:%c2":"=&v"(lo[ks]):"v"(vb),"i"(d0*4096+ks*1024):"memory");
      asm volatile("ds_read_b64_tr_b16 %0,%1 offset:%c2":"=&v"(hi[ks]):"v"(vb),"i"(d0*4096+ks*1024+512):"memory");}
    asm volatile("s_waitcnt lgkmcnt(0)":::"memory");SBAR();
    #define PK(k) (bf16x8){lo[k][0],lo[k][1],lo[k][2],lo[k][3],hi[k][0],hi[k][1],hi[k][2],hi[k][3]}
    o[d0]=__builtin_amdgcn_mfma_f32_32x32x16_bf16(pa0,PK(0),o[d0],0,0,0);
    o[d0]=__builtin_amdgcn_mfma_f32_32x32x16_bf16(pa1,PK(1),o[d0],0,0,0);
    o[d0]=__builtin_amdgcn_mfma_f32_32x32x16_bf16(pa2,PK(2),o[d0],0,0,0);
    o[d0]=__builtin_amdgcn_mfma_f32_32x32x16_bf16(pa3,PK(3),o[d0],0,0,0);
    #undef PK
  }
}

#ifndef ATTN_STORE16
#define ATTN_STORE16(p,v) (*(u32x4*)(p)=(v))
#endif
template<int THRL,int LDI,int LDO> __device__ __forceinline__ void attn_unit(const bf16*Qb,const bf16*__restrict__ Kb,const bf16*__restrict__ Vb,const bf16*Gb,bf16*Ob,const int NT,char*shm){
  const int tid=tid512_fresh(),lane=tid&63,r32=lane&31,hi=lane>>5; const int wid=__builtin_amdgcn_readfirstlane(tid>>6);
  const bf16*Qw=Qb+(long)(wid*QBLK)*LDI;
  const bf16*Kh=Kb,*Vh=Vb;
  const unsigned lds0=(unsigned)(uintptr_t)shm;
  float*wsf=(float*)(shm+LDS_WS)+wid*64;
  const bf16*ksrc=Kh+(long)lane*LDI+wid*8;
  const bf16*vsrc=Vh+(long)(16*(wid&3)+(lane>>2))*LDI+(wid>>2)*32+(lane&3)*8;
  const unsigned kdst=lds0+LDS_K+wid*1024, vdst=lds0+LDS_V+wid*1024;
  #define DMA_K(t,slot) glds16(ksrc+(long)(t)*KVBLK*LDI,(unsigned)__builtin_amdgcn_readfirstlane(kdst+(slot)))
  #define DMA_V(t,slot) glds16(vsrc+(long)(t)*KVBLK*LDI,(unsigned)__builtin_amdgcn_readfirstlane(vdst+(slot)))
  const int vb0=(int)(lds0+LDS_V)+((lane>>4)&1)*32+(lane&3)*8+(4*hi+((lane&15)>>2))*64;
  const char*Kbase=shm+LDS_K; bf16x8 kf[8];
  const lds_cptr shm3=(lds_cptr)shm; const lds_cptr kp0=shm3+LDS_K+hi*1024+r32*16; const lds_cptr vp0=shm3+LDS_V+((lane>>4)&1)*32+(lane&3)*8+(4*hi+((lane&15)>>2))*64;
  DMA_K(0,0);DMA_V(0,0);DMA_K(1,SLOTB);
  bf16x8 qr[4];
  #pragma unroll
  for(int d0=0;d0<4;++d0)qr[d0]=*reinterpret_cast<const bf16x8*>(&Qw[(long)r32*LDI+d0*16+hi*8]);
  float mhat=0.f,l_reg=0.f;f32x16 o[2];o[0]=f32x16{};o[1]=f32x16{};f32x16 negm=f32x16{};asm volatile("":"+v"(negm));
  #define CMASK(P0,P1,t) do{}while(0)
  bool resc=false;
  #define START(P0,P1) do{ const float rm=rowmax(P0,P1); resc=false; \
    { const float dl=rm; mhat=fadd_s(mhat,dl); \
      _Pragma("unroll") for(int r=0;r<16;++r){P0[r]=fsub_s(P0[r],dl);P1[r]=fsub_s(P1[r],dl);} \
      _Pragma("unroll") for(int r=0;r<16;++r)negm[r]=-mhat; asm volatile("":"+v"(negm)); } \
    _Pragma("unroll") for(int r=0;r<16;++r)P0[r]=__builtin_amdgcn_exp2f(P0[r]); }while(0)
  #define RESC() do{ if(resc){ asm volatile("s_waitcnt lgkmcnt(0)":::"memory"); \
      _Pragma("unroll") for(int d_=0;d_<2;++d_) _Pragma("unroll") for(int r=0;r<16;++r)o[d_][r]*=wsf[crow(r,hi)]; } }while(0)
  f32x16 pA0,pA1,pB0,pB1;
  int sl_prev=0,sl_cur=0,sl_next=SLOTB;
  #define ROT() do{sl_prev=sl_cur;sl_cur=sl_next;sl_next=(sl_next==(NSLOT-1)*SLOTB)?0:sl_next+SLOTB;}while(0)
  DMA_K(2,2*SLOTB);
  WAIT_BAR(3);
  qkt(pA0,pA1,Kbase,qr,negm,r32,hi);asm volatile("s_nop 15\n\ts_nop 7":"+v"(pA0),"+v"(pA1));CMASK(pA0,pA1,0);
  START(pA0,pA1);
  _Pragma("unroll") for(int r=0;r<16;++r)pA1[r]=__builtin_amdgcn_exp2f(pA1[r]);
  WAIT_BAR(0);
  DMA_K(3,0);DMA_V(1,SLOTB);
  ROT();
  kload8(kf,kp0+sl_cur);
  WAIT_BAR(2);
  s16x4 vlo[8],vhi[8]; u32x4 pw0,pw1,pw2,pw3;
  #define PKW(P,B) cvtpk_s(P[B],P[B+1])
  #define PAF(k) __builtin_bit_cast(bf16x8,pw##k)
  #define VFR(i) (bf16x8){vlo[i][0],vlo[i][1],vlo[i][2],vlo[i][3],vhi[i][0],vhi[i][1],vhi[i][2],vhi[i][3]}
  #define PIN(x) asm volatile("":"+v"(x))
  #define MX3(a,b,c) __builtin_fmaxf(__builtin_fmaxf((a),(b)),(c))
  #define GAPA(MF,A0,A1,A2,A3,W0,W1,PW) do{ MF; sacc+=A0; sacc+=A1; sacc+=A2; sacc+=A3; PIN(sacc); W0; W1; PIN(PW); SBAR(); }while(0)
  #define EX(v) __builtin_amdgcn_exp2f(v)
  #define GAPB(MF,X,B) do{ MF; X[B]=EX(X[B]); X[B+1]=EX(X[B+1]); X[B+2]=EX(X[B+2]); X[B+3]=EX(X[B+3]); PIN(X); SBAR(); }while(0)
  #define VRD(i) do{ vlo[i]=vtr(vp_+(((i)>>2)*4096+((i)&3)*1024)); vhi[i]=vtr(vp_+(((i)>>2)*4096+((i)&3)*1024+512)); }while(0)
  #define KRD(G,j) do{ if(G){ kload2(kf,kp0+sl_next,j); SBAR(); } }while(0)
  #define STEP(C0,C1,P0,P1,t,GK,GV,GL) do{ SBAR(); \
    const lds_cptr vp_=vp0+sl_prev; \
    VRD(0); SBAR(); float sacc=(P0[0]+P0[1]); \
    GAPA(C0=__builtin_amdgcn_mfma_f32_32x32x16_bf16(kf[0],qr[0],negm,0,0,0), P0[2],P0[3],P0[4],P0[5],     pw0[0]=PKW(P0,0), pw0[1]=PKW(P0,2), pw0); \
    VRD(4); SBAR(); GAPA(C1=__builtin_amdgcn_mfma_f32_32x32x16_bf16(kf[1],qr[0],negm,0,0,0), P0[6],P0[7],P0[8],P0[9],     pw0[2]=PKW(P0,4), pw0[3]=PKW(P0,6), pw0); \
    VRD(1); SBAR(); GAPA(C0=__builtin_amdgcn_mfma_f32_32x32x16_bf16(kf[2],qr[1],C0,0,0,0),   P0[10],P0[11],P0[12],P0[13], pw1[0]=PKW(P0,8), pw1[1]=PKW(P0,10), pw1); \
    VRD(5); SBAR(); GAPA(C1=__builtin_amdgcn_mfma_f32_32x32x16_bf16(kf[3],qr[1],C1,0,0,0),   P0[14],P0[15],P1[0],P1[1],   pw1[2]=PKW(P0,12),pw1[3]=PKW(P0,14), pw1); \
    VRD(2); SBAR(); GAPA(C0=__builtin_amdgcn_mfma_f32_32x32x16_bf16(kf[4],qr[2],C0,0,0,0),   P1[2],P1[3],P1[4],P1[5],     pw2[0]=PKW(P1,0), pw2[1]=PKW(P1,2), pw2); \
    VRD(6); SBAR(); GAPA(C1=__builtin_amdgcn_mfma_f32_32x32x16_bf16(kf[5],qr[2],C1,0,0,0),   P1[6],P1[7],P1[8],P1[9],     pw2[2]=PKW(P1,4), pw2[3]=PKW(P1,6), pw2); \
    VRD(3); SBAR(); GAPA(C0=__builtin_amdgcn_mfma_f32_32x32x16_bf16(kf[6],qr[3],C0,0,0,0),   P1[10],P1[11],P1[12],P1[13], pw3[0]=PKW(P1,8), pw3[1]=PKW(P1,10), pw3); \
    VRD(7); SBAR(); GAPA(C1=__builtin_amdgcn_mfma_f32_32x32x16_bf16(kf[7],qr[3],C1,0,0,0),   P1[14],P1[15],0.f,0.f,       pw3[2]=PKW(P1,12),pw3[3]=PKW(P1,14), pw3); \
    l_reg+=sacc; \
    if(GK){DMA_K((t)+3,sl_cur);} if(GV){DMA_V((t)+1,sl_next);} \
    CMASK(C0,C1,t); \
    { float a=MX3(C0[0],C0[1],C1[0]),b=MX3(C0[2],C0[3],C1[1]); a=MX3(a,C1[2],C1[3]); \
      _Pragma("unroll") for(int r=4;r<16;r+=4){a=MX3(a,C0[r],C0[r+1]);b=MX3(b,C0[r+2],C0[r+3]);a=MX3(a,C1[r],C1[r+1]);b=MX3(b,C1[r+2],C1[r+3]);} \
      float rm=__builtin_fmaxf(a,b); { auto rr=__builtin_amdgcn_permlane32_swap(__float_as_uint(rm),__float_as_uint(rm),false,false); rm=__builtin_fmaxf(__uint_as_float(rr[0]),__uint_as_float(rr[1])); } \
      resc=false; \
      if(__builtin_expect(__any(rm>(float)THRL),0)){ const float dl=__builtin_fmaxf(rm,0.f); mhat+=dl; \
        _Pragma("unroll") for(int r=0;r<16;++r){C0[r]-=dl;C1[r]-=dl;} \
        _Pragma("unroll") for(int r=0;r<16;++r)negm[r]=-mhat; asm volatile("":"+v"(negm)); \
        const float f=__builtin_amdgcn_exp2f(-dl); l_reg*=f; if(hi==0)wsf[r32]=f; resc=true; } } \
    SBAR(); \
    GAPB(o[0]=__builtin_amdgcn_mfma_f32_32x32x16_bf16(PAF(0),VFR(0),o[0],0,0,0), C0,0); \
    GAPB(o[1]=__builtin_amdgcn_mfma_f32_32x32x16_bf16(PAF(0),VFR(4),o[1],0,0,0), C0,4); \
    KRD(GL,0); GAPB(o[0]=__builtin_amdgcn_mfma_f32_32x32x16_bf16(PAF(1),VFR(1),o[0],0,0,0), C0,8); \
    KRD(GL,1); GAPB(o[1]=__builtin_amdgcn_mfma_f32_32x32x16_bf16(PAF(1),VFR(5),o[1],0,0,0), C0,12); \
    KRD(GL,2); GAPB(o[0]=__builtin_amdgcn_mfma_f32_32x32x16_bf16(PAF(2),VFR(2),o[0],0,0,0), C1,0); \
    KRD(GL,3); GAPB(o[1]=__builtin_amdgcn_mfma_f32_32x32x16_bf16(PAF(2),VFR(6),o[1],0,0,0), C1,4); \
    GAPB(o[0]=__builtin_amdgcn_mfma_f32_32x32x16_bf16(PAF(3),VFR(3),o[0],0,0,0), C1,8); \
    GAPB(o[1]=__builtin_amdgcn_mfma_f32_32x32x16_bf16(PAF(3),VFR(7),o[1],0,0,0), C1,12); \
    }while(0)
  int t=1;
  #undef CMASK
  #define CMASK(P0,P1,t) do{}while(0)
  for(;t+5<NT;t+=2){
    STEP(pB0,pB1,pA0,pA1,t,true,true,true);     WAIT_BAR(2); RESC(); ROT();
    STEP(pA0,pA1,pB0,pB1,t+1,true,true,true);   WAIT_BAR(2); RESC(); ROT();
  }
  #undef CMASK
  #define CMASK(P0,P1,t) do{}while(0)
  #define ENDW(tt) do{ if((tt)+3<NT){WAIT_BAR(2);} else if((tt)+2<NT){WAIT_BAR(1);} else {WAIT_BAR(0);} }while(0)
  for(;t+1<NT;t+=2){
    STEP(pB0,pB1,pA0,pA1,t,(t+3<NT),(t+1<NT),(t+1<NT));       ENDW(t);   RESC(); ROT();
    STEP(pA0,pA1,pB0,pB1,t+1,(t+4<NT),(t+2<NT),(t+2<NT));     ENDW(t+1); RESC(); ROT();
  }
  STEP(pB0,pB1,pA0,pA1,NT-1,false,false,false); RESC();
  { float sacc=pB0[0]+pB0[1]; _Pragma("unroll") for(int r=2;r<16;++r)sacc+=pB0[r]; _Pragma("unroll") for(int r=0;r<16;++r)sacc+=pB1[r]; l_reg+=sacc;
    pw0=(u32x4){PKW(pB0,0),PKW(pB0,2),PKW(pB0,4),PKW(pB0,6)};pw1=(u32x4){PKW(pB0,8),PKW(pB0,10),PKW(pB0,12),PKW(pB0,14)};pw2=(u32x4){PKW(pB1,0),PKW(pB1,2),PKW(pB1,4),PKW(pB1,6)};pw3=(u32x4){PKW(pB1,8),PKW(pB1,10),PKW(pB1,12),PKW(pB1,14)};
    SBAR(); pv(o,vb0+sl_cur,PAF(0),PAF(1),PAF(2),PAF(3)); }
  #undef PKW
  #undef PAF
  #undef VFR
  #undef PIN
  #undef MX3
  #undef GAPA
  #undef GAPB
  #undef EX
  #undef VRD
  #undef KRD
  #undef STEP
  #undef ENDW
  {auto rr=__builtin_amdgcn_permlane32_swap(__float_as_uint(l_reg),__float_as_uint(l_reg),false,false);l_reg=__uint_as_float(rr[0])+__uint_as_float(rr[1]);}
  if(hi==0)wsf[32+r32]=l_reg;asm volatile("s_waitcnt lgkmcnt(0)":::"memory");
  float rli[16];
  #pragma unroll
  for(int r=0;r<16;++r)rli[r]=__builtin_amdgcn_rcpf(wsf[32+crow(r,hi)]);
  bf16*Ow=Ob+(long)(wid*QBLK)*LDO; const bf16*Gw=Gb+(long)(wid*QBLK)*LDI;
  { bf16*stg=(bf16*)(shm+LDS_OST)+wid*2048;
    #pragma unroll
    for(int r=0;r<16;++r){const int orow=crow(r,hi);
      #pragma unroll
      for(int d0=0;d0<2;++d0)stg[orow*64+d0*32+r32]=__float2bfloat16(o[d0][r]*rli[r]);}
    asm volatile("s_waitcnt lgkmcnt(0)":::"memory");
    #pragma unroll
    for(int i=0;i<4;++i){const int row=i*8+(lane>>3),ch=lane&7; const u32x4 v=*(const u32x4*)(stg+row*64+ch*8); const u32x4 g=*(const u32x4*)(Gw+(long)row*LDI+ch*8); u32x4 w;
      #pragma unroll
      for(int e=0;e<4;++e){ const float v0=__uint_as_float(v[e]<<16),v1=__uint_as_float(v[e]&0xffff0000u),g0=__uint_as_float(g[e]<<16),g1=__uint_as_float(g[e]&0xffff0000u);
        w[e]=cvtpk_s(v0*g0*__builtin_amdgcn_rcpf(1.f+__expf(-g0)),v1*g1*__builtin_amdgcn_rcpf(1.f+__expf(-g1))); }
      ATTN_STORE16(Ow+(long)row*LDO+ch*8,w);} }
  asm volatile("s_waitcnt lgkmcnt(0)\n\ts_barrier":::"memory");
  #undef DMA_K
  #undef DMA_V
  #undef CMASK
  #undef START
  #undef RESC
  #undef ROT
}
constexpr int ATTN_LDS_BYTES=LDS_BYTES;
#undef SBAR
#undef WAIT_BAR
}

namespace attn_a {
using bf16=__hip_bfloat16;
using bf16x8=__attribute__((ext_vector_type(8)))short;
using s16x4=__attribute__((ext_vector_type(4)))short;
using f32x16=__attribute__((ext_vector_type(16)))float;
using u32x4=__attribute__((ext_vector_type(4)))unsigned;
constexpr int D=64;
constexpr int NW=8,QBLK=32,QB=QBLK*NW,KVBLK=64;
constexpr int ATTN_UNIT_ROWS=QB;
__device__ __forceinline__ int crow(int r,int hi){return (r&3)+8*(r>>2)+4*hi;}
#define SBAR() __builtin_amdgcn_sched_barrier(0)
__device__ __forceinline__ void cmask(f32x16&p0,f32x16&p1,int jb,int qrel,int hi){
  const float NEG=-INFINITY; int kb=64*jb+4*hi;
  #pragma unroll
  for(int r=0;r<16;++r){int kv=kb+(r&3)+8*(r>>2); if(kv>qrel)p0[r]=NEG; if(kv+32>qrel)p1[r]=NEG;}
}

constexpr int NSLOT=3, SLOTB=8192, KSLOT=12288;
constexpr int LDS_K=0, LDS_V=NSLOT*KSLOT, LDS_WS=NSLOT*KSLOT+NSLOT*SLOTB, LDS_OST=LDS_WS+NW*64*4, LDS_BYTES=LDS_OST+NW*4096;
constexpr float C2=0.125f*1.4426950408889634f;
__device__ __forceinline__ void glds16(const void*gsrc,unsigned lds_dst){unsigned keep;
  asm volatile("s_mov_b32 %0, m0\n\ts_mov_b32 m0, %2\n\ts_nop 0\n\tglobal_load_lds_dwordx4 %1, off\n\ts_mov_b32 m0, %0":"=&s"(keep):"v"(gsrc),"s"(lds_dst):"memory");}
__device__ __forceinline__ float max3f(float a,float b,float c){float r;asm("v_max3_f32 %0, %1, %2, %3":"=v"(r):"v"(a),"v"(b),"v"(c));return r;}
__device__ __forceinline__ float max2f(float a,float b){float r;asm("v_max_f32_e32 %0, %1, %2":"=v"(r):"v"(a),"v"(b));return r;}
__device__ __forceinline__ float fadd_s(float a,float b){float r;asm("v_add_f32_e32 %0, %1, %2":"=v"(r):"v"(a),"v"(b));return r;}
__device__ __forceinline__ float fsub_s(float a,float b){float r;asm("v_sub_f32_e32 %0, %1, %2":"=v"(r):"v"(a),"v"(b));return r;}
typedef float f32x2_t __attribute__((ext_vector_type(2))); typedef __bf16 bf16x2_t __attribute__((ext_vector_type(2)));
__device__ __forceinline__ unsigned cvtpk_s(float lo,float hi){f32x2_t v={lo,hi};bf16x2_t b=__builtin_convertvector(v,bf16x2_t);return __builtin_bit_cast(unsigned,b);}
#define KS(s) ((s)+((s)>>1))
#define WAIT_BAR(N) asm volatile("s_waitcnt vmcnt(" #N ") lgkmcnt(0)\n\ts_barrier":::"memory")

__device__ __forceinline__ void qkt(f32x16&p0,f32x16&p1,const char*Kslot,const bf16x8*qr,const f32x16&negm,int r32,int hi){
  const char*kb=Kslot+hi*1024+r32*16;
  #pragma unroll
  for(int d0=0;d0<6;++d0){
    const bf16x8 b0=*reinterpret_cast<const bf16x8*>(kb+d0*2048);
    const bf16x8 b1=*reinterpret_cast<const bf16x8*>(kb+d0*2048+512);
    if(d0==0){p0=__builtin_amdgcn_mfma_f32_32x32x16_bf16(b0,qr[0],negm,0,0,0);p1=__builtin_amdgcn_mfma_f32_32x32x16_bf16(b1,qr[0],negm,0,0,0);}
    else{p0=__builtin_amdgcn_mfma_f32_32x32x16_bf16(b0,qr[d0],p0,0,0,0);p1=__builtin_amdgcn_mfma_f32_32x32x16_bf16(b1,qr[d0],p1,0,0,0);}}
}
typedef __attribute__((address_space(3))) const char* lds_cptr;
typedef short v4i16_t __attribute__((ext_vector_type(4)));
__device__ __forceinline__ void kload8(bf16x8*kf,lds_cptr kp){
  kf[0]=*(const __attribute__((address_space(3))) bf16x8*)(kp);      kf[1]=*(const __attribute__((address_space(3))) bf16x8*)(kp+512);
  kf[2]=*(const __attribute__((address_space(3))) bf16x8*)(kp+2048); kf[3]=*(const __attribute__((address_space(3))) bf16x8*)(kp+2560);
  kf[4]=*(const __attribute__((address_space(3))) bf16x8*)(kp+4096); kf[5]=*(const __attribute__((address_space(3))) bf16x8*)(kp+4608);
  kf[6]=*(const __attribute__((address_space(3))) bf16x8*)(kp+6144); kf[7]=*(const __attribute__((address_space(3))) bf16x8*)(kp+6656);
  kf[8]=*(const __attribute__((address_space(3))) bf16x8*)(kp+8192); kf[9]=*(const __attribute__((address_space(3))) bf16x8*)(kp+8704);
  kf[10]=*(const __attribute__((address_space(3))) bf16x8*)(kp+10240); kf[11]=*(const __attribute__((address_space(3))) bf16x8*)(kp+10752);
}
__device__ __forceinline__ void kload2(bf16x8*kf,lds_cptr kp,int j){ kf[2*j]=*(const __attribute__((address_space(3))) bf16x8*)(kp+j*2048); kf[2*j+1]=*(const __attribute__((address_space(3))) bf16x8*)(kp+j*2048+512); }
__device__ __forceinline__ s16x4 vtr(lds_cptr p){ return __builtin_bit_cast(s16x4,__builtin_amdgcn_ds_read_tr16_b64_v4i16((__attribute__((address_space(3))) v4i16_t*)p)); }
__device__ __forceinline__ float rowmax(const f32x16&p0,const f32x16&p1){
  float a=max3f(p0[0],p0[1],p1[0]),b=max3f(p0[2],p0[3],p1[1]);a=max3f(a,p1[2],p1[3]);
  #pragma unroll
  for(int r=4;r<16;r+=4){a=max3f(a,p0[r],p0[r+1]);b=max3f(b,p0[r+2],p0[r+3]);a=max3f(a,p1[r],p1[r+1]);b=max3f(b,p1[r+2],p1[r+3]);}
  const float m=max2f(a,b);
  auto rr=__builtin_amdgcn_permlane32_swap(__float_as_uint(m),__float_as_uint(m),false,false);
  return max2f(__uint_as_float(rr[0]),__uint_as_float(rr[1]));
}
__device__ __forceinline__ void pv(f32x16*o,int vb,bf16x8 pa0,bf16x8 pa1,bf16x8 pa2,bf16x8 pa3){
  #pragma unroll
  for(int d0=0;d0<2;++d0){s16x4 lo[4],hi[4];
    #pragma unroll
    for(int ks=0;ks<4;++ks){
      asm volatile("ds_read_b64_tr_b16 %0,%1 offset:%c2":"=&v"(lo[ks]):"v"(vb),"i"(d0*4096+ks*1024):"memory");
      asm volatile("ds_read_b64_tr_b16 %0,%1 offset:%c2":"=&v"(hi[ks]):"v"(vb),"i"(d0*4096+ks*1024+512):"memory");}
    asm volatile("s_waitcnt lgkmcnt(0)":::"memory");SBAR();
    #define PK(k) (bf16x8){lo[k][0],lo[k][1],lo[k][2],lo[k][3],hi[k][0],hi[k][1],hi[k][2],hi[k][3]}
    o[d0]=__builtin_amdgcn_mfma_f32_32x32x16_bf16(pa0,PK(0),o[d0],0,0,0);
    o[d0]=__builtin_amdgcn_mfma_f32_32x32x16_bf16(pa1,PK(1),o[d0],0,0,0);
    o[d0]=__builtin_amdgcn_mfma_f32_32x32x16_bf16(pa2,PK(2),o[d0],0,0,0);
    o[d0]=__builtin_amdgcn_mfma_f32_32x32x16_bf16(pa3,PK(3),o[d0],0,0,0);
    #undef PK
  }
}

#ifndef ATTN_STORE16
#define ATTN_STORE16(p,v) (*(u32x4*)(p)=(v))
#endif
template<int THRL,int LDQ,int LDK,int LDV,int LDG,int LDO> __device__ __forceinline__ void attn_unit(const bf16*Qb,const bf16*__restrict__ Kb,const bf16*__restrict__ Vb,const bf16*Gb,bf16*Ob,const int NT,char*shm){
  const int tid=tid512_fresh(),lane=tid&63,r32=lane&31,hi=lane>>5; const int wid=__builtin_amdgcn_readfirstlane(tid>>6);
  const bf16*Qw=Qb+(long)(wid*QBLK)*LDQ;
  const bf16*Kh=Kb,*Vh=Vb;
  const unsigned lds0=(unsigned)(uintptr_t)shm;
  float*wsf=(float*)(shm+LDS_WS)+wid*64;
  const bf16*ksrc=Kh+(long)lane*LDK+wid*8; const bf16*ksrc2=Kh+(long)lane*LDK+(8+(wid&3))*8;
  const bf16*vsrc=Vh+(long)(16*(wid&3)+(lane>>2))*LDV+(wid>>2)*32+(lane&3)*8;
  const unsigned kdst=lds0+LDS_K+wid*1024, kdst2=lds0+LDS_K+(8+(wid&3))*1024, vdst=lds0+LDS_V+wid*1024;
  #define DMA_K(t,slot) do{ glds16(ksrc+(long)(t)*KVBLK*LDK,(unsigned)__builtin_amdgcn_readfirstlane(kdst+KS(slot))); glds16(ksrc2+(long)(t)*KVBLK*LDK,(unsigned)__builtin_amdgcn_readfirstlane(kdst2+KS(slot))); }while(0)
  #define DMA_V(t,slot) glds16(vsrc+(long)(t)*KVBLK*LDV,(unsigned)__builtin_amdgcn_readfirstlane(vdst+(slot)))
  const int vb0=(int)(lds0+LDS_V)+((lane>>4)&1)*32+(lane&3)*8+(4*hi+((lane&15)>>2))*64;
  const char*Kbase=shm+LDS_K; bf16x8 kf[12];
  const lds_cptr shm3=(lds_cptr)shm; const lds_cptr kp0=shm3+LDS_K+hi*1024+r32*16; const lds_cptr vp0=shm3+LDS_V+((lane>>4)&1)*32+(lane&3)*8+(4*hi+((lane&15)>>2))*64;
  DMA_K(0,0);DMA_V(0,0);DMA_K(1,SLOTB);
  bf16x8 qr[6];
  #pragma unroll
  for(int d0=0;d0<6;++d0)qr[d0]=*reinterpret_cast<const bf16x8*>(&Qw[(long)r32*LDQ+d0*16+hi*8]);
  float mhat=0.f,l_reg=0.f;f32x16 o[2];o[0]=f32x16{};o[1]=f32x16{};f32x16 negm=f32x16{};asm volatile("":"+v"(negm));
  #define CMASK(P0,P1,t) do{}while(0)
  bool resc=false;
  #define START(P0,P1) do{ const float rm=rowmax(P0,P1); resc=false; \
    { const float dl=rm; mhat=fadd_s(mhat,dl); \
      _Pragma("unroll") for(int r=0;r<16;++r){P0[r]=fsub_s(P0[r],dl);P1[r]=fsub_s(P1[r],dl);} \
      _Pragma("unroll") for(int r=0;r<16;++r)negm[r]=-mhat; asm volatile("":"+v"(negm)); } \
    _Pragma("unroll") for(int r=0;r<16;++r)P0[r]=__builtin_amdgcn_exp2f(P0[r]); }while(0)
  #define RESC() do{ if(resc){ asm volatile("s_waitcnt lgkmcnt(0)":::"memory"); \
      _Pragma("unroll") for(int d_=0;d_<2;++d_) _Pragma("unroll") for(int r=0;r<16;++r)o[d_][r]*=wsf[crow(r,hi)]; } }while(0)
  f32x16 pA0,pA1,pB0,pB1;
  int sl_prev=0,sl_cur=0,sl_next=SLOTB;
  #define ROT() do{sl_prev=sl_cur;sl_cur=sl_next;sl_next=(sl_next==(NSLOT-1)*SLOTB)?0:sl_next+SLOTB;}while(0)
  DMA_K(2,2*SLOTB);
  WAIT_BAR(5);
  qkt(pA0,pA1,Kbase,qr,negm,r32,hi);asm volatile("s_nop 15\n\ts_nop 7":"+v"(pA0),"+v"(pA1));CMASK(pA0,pA1,0);
  START(pA0,pA1);
  _Pragma("unroll") for(int r=0;r<16;++r)pA1[r]=__builtin_amdgcn_exp2f(pA1[r]);
  WAIT_BAR(0);
  DMA_K(3,0);DMA_V(1,SLOTB);
  ROT();
  kload8(kf,kp0+KS(sl_cur));
  WAIT_BAR(3);
  s16x4 vlo[8],vhi[8]; u32x4 pw0,pw1,pw2,pw3;
  #define PKW(P,B) cvtpk_s(P[B],P[B+1])
  #define PAF(k) __builtin_bit_cast(bf16x8,pw##k)
  #define VFR(i) (bf16x8){vlo[i][0],vlo[i][1],vlo[i][2],vlo[i][3],vhi[i][0],vhi[i][1],vhi[i][2],vhi[i][3]}
  #define PIN(x) asm volatile("":"+v"(x))
  #define MX3(a,b,c) __builtin_fmaxf(__builtin_fmaxf((a),(b)),(c))
  #define GAPA(MF,A0,A1,A2,A3,W0,W1,PW) do{ MF; sacc+=A0; sacc+=A1; sacc+=A2; sacc+=A3; PIN(sacc); W0; W1; PIN(PW); SBAR(); }while(0)
  #define EX(v) __builtin_amdgcn_exp2f(v)
  #define GAPB(MF,X,B) do{ MF; X[B]=EX(X[B]); X[B+1]=EX(X[B+1]); X[B+2]=EX(X[B+2]); X[B+3]=EX(X[B+3]); PIN(X); SBAR(); }while(0)
  #define VRD(i) do{ vlo[i]=vtr(vp_+(((i)>>2)*4096+((i)&3)*1024)); vhi[i]=vtr(vp_+(((i)>>2)*4096+((i)&3)*1024+512)); }while(0)
  #define KRD(G,j) do{ if(G){ kload2(kf,kp0+KS(sl_next),j); SBAR(); } }while(0)
  #define STEP(C0,C1,P0,P1,t,GK,GV,GL) do{ SBAR(); \
    const lds_cptr vp_=vp0+sl_prev; \
    VRD(0); SBAR(); float sacc=(P0[0]+P0[1]); \
    GAPA(C0=__builtin_amdgcn_mfma_f32_32x32x16_bf16(kf[0],qr[0],negm,0,0,0), P0[2],P0[3],P0[4],P0[5],     pw0[0]=PKW(P0,0), pw0[1]=PKW(P0,2), pw0); \
    VRD(4); SBAR(); GAPA(C1=__builtin_amdgcn_mfma_f32_32x32x16_bf16(kf[1],qr[0],negm,0,0,0), P0[6],P0[7],P0[8],P0[9],     pw0[2]=PKW(P0,4), pw0[3]=PKW(P0,6), pw0); \
    VRD(1); SBAR(); GAPA(C0=__builtin_amdgcn_mfma_f32_32x32x16_bf16(kf[2],qr[1],C0,0,0,0),   P0[10],P0[11],P0[12],P0[13], pw1[0]=PKW(P0,8), pw1[1]=PKW(P0,10), pw1); \
    VRD(5); SBAR(); GAPA(C1=__builtin_amdgcn_mfma_f32_32x32x16_bf16(kf[3],qr[1],C1,0,0,0),   P0[14],P0[15],P1[0],P1[1],   pw1[2]=PKW(P0,12),pw1[3]=PKW(P0,14), pw1); \
    VRD(2); SBAR(); GAPA(C0=__builtin_amdgcn_mfma_f32_32x32x16_bf16(kf[4],qr[2],C0,0,0,0),   P1[2],P1[3],P1[4],P1[5],     pw2[0]=PKW(P1,0), pw2[1]=PKW(P1,2), pw2); \
    VRD(6); SBAR(); GAPA(C1=__builtin_amdgcn_mfma_f32_32x32x16_bf16(kf[5],qr[2],C1,0,0,0),   P1[6],P1[7],P1[8],P1[9],     pw2[2]=PKW(P1,4), pw2[3]=PKW(P1,6), pw2); \
    VRD(3); SBAR(); GAPA(C0=__builtin_amdgcn_mfma_f32_32x32x16_bf16(kf[6],qr[3],C0,0,0,0),   P1[10],P1[11],P1[12],P1[13], pw3[0]=PKW(P1,8), pw3[1]=PKW(P1,10), pw3); \
    VRD(7); SBAR(); GAPA(C1=__builtin_amdgcn_mfma_f32_32x32x16_bf16(kf[7],qr[3],C1,0,0,0),   P1[14],P1[15],0.f,0.f,       pw3[2]=PKW(P1,12),pw3[3]=PKW(P1,14), pw3); \
    C0=__builtin_amdgcn_mfma_f32_32x32x16_bf16(kf[8],qr[4],C0,0,0,0); C1=__builtin_amdgcn_mfma_f32_32x32x16_bf16(kf[9],qr[4],C1,0,0,0); SBAR(); \
    C0=__builtin_amdgcn_mfma_f32_32x32x16_bf16(kf[10],qr[5],C0,0,0,0); C1=__builtin_amdgcn_mfma_f32_32x32x16_bf16(kf[11],qr[5],C1,0,0,0); SBAR(); \
    l_reg+=sacc; \
    if(GK){DMA_K((t)+3,sl_cur);} if(GV){DMA_V((t)+1,sl_next);} \
    CMASK(C0,C1,t); \
    { float a=MX3(C0[0],C0[1],C1[0]),b=MX3(C0[2],C0[3],C1[1]); a=MX3(a,C1[2],C1[3]); \
      _Pragma("unroll") for(int r=4;r<16;r+=4){a=MX3(a,C0[r],C0[r+1]);b=MX3(b,C0[r+2],C0[r+3]);a=MX3(a,C1[r],C1[r+1]);b=MX3(b,C1[r+2],C1[r+3]);} \
      float rm=__builtin_fmaxf(a,b); { auto rr=__builtin_amdgcn_permlane32_swap(__float_as_uint(rm),__float_as_uint(rm),false,false); rm=__builtin_fmaxf(__uint_as_float(rr[0]),__uint_as_float(rr[1])); } \
      resc=false; \
      if(__builtin_expect(__any(rm>(float)THRL),0)){ const float dl=__builtin_fmaxf(rm,0.f); mhat+=dl; \
        _Pragma("unroll") for(int r=0;r<16;++r){C0[r]-=dl;C1[r]-=dl;} \
        _Pragma("unroll") for(int r=0;r<16;++r)negm[r]=-mhat; asm volatile("":"+v"(negm)); \
        const float f=__builtin_amdgcn_exp2f(-dl); l_reg*=f; if(hi==0)wsf[r32]=f; resc=true; } } \
    SBAR(); \
    GAPB(o[0]=__builtin_amdgcn_mfma_f32_32x32x16_bf16(PAF(0),VFR(0),o[0],0,0,0), C0,0); \
    GAPB(o[1]=__builtin_amdgcn_mfma_f32_32x32x16_bf16(PAF(0),VFR(4),o[1],0,0,0), C0,4); \
    KRD(GL,0); GAPB(o[0]=__builtin_amdgcn_mfma_f32_32x32x16_bf16(PAF(1),VFR(1),o[0],0,0,0), C0,8); \
    KRD(GL,1); GAPB(o[1]=__builtin_amdgcn_mfma_f32_32x32x16_bf16(PAF(1),VFR(5),o[1],0,0,0), C0,12); \
    KRD(GL,2); GAPB(o[0]=__builtin_amdgcn_mfma_f32_32x32x16_bf16(PAF(2),VFR(2),o[0],0,0,0), C1,0); \
    KRD(GL,3); GAPB(o[1]=__builtin_amdgcn_mfma_f32_32x32x16_bf16(PAF(2),VFR(6),o[1],0,0,0), C1,4); \
    KRD(GL,4); GAPB(o[0]=__builtin_amdgcn_mfma_f32_32x32x16_bf16(PAF(3),VFR(3),o[0],0,0,0), C1,8); \
    KRD(GL,5); GAPB(o[1]=__builtin_amdgcn_mfma_f32_32x32x16_bf16(PAF(3),VFR(7),o[1],0,0,0), C1,12); \
    }while(0)
  int t=1;
  #undef CMASK
  #define CMASK(P0,P1,t) do{}while(0)
  for(;t+5<NT;t+=2){
    STEP(pB0,pB1,pA0,pA1,t,true,true,true);     WAIT_BAR(3); RESC(); ROT();
    STEP(pA0,pA1,pB0,pB1,t+1,true,true,true);   WAIT_BAR(3); RESC(); ROT();
  }
  #undef CMASK
  #define CMASK(P0,P1,t) do{}while(0)
  #define ENDW(tt) do{ if((tt)+3<NT){WAIT_BAR(3);} else if((tt)+2<NT){WAIT_BAR(1);} else {WAIT_BAR(0);} }while(0)
  for(;t+1<NT;t+=2){
    STEP(pB0,pB1,pA0,pA1,t,(t+3<NT),(t+1<NT),(t+1<NT));       ENDW(t);   RESC(); ROT();
    STEP(pA0,pA1,pB0,pB1,t+1,(t+4<NT),(t+2<NT),(t+2<NT));     ENDW(t+1); RESC(); ROT();
  }
  STEP(pB0,pB1,pA0,pA1,NT-1,false,false,false); RESC();
  { float sacc=pB0[0]+pB0[1]; _Pragma("unroll") for(int r=2;r<16;++r)sacc+=pB0[r]; _Pragma("unroll") for(int r=0;r<16;++r)sacc+=pB1[r]; l_reg+=sacc;
    pw0=(u32x4){PKW(pB0,0),PKW(pB0,2),PKW(pB0,4),PKW(pB0,6)};pw1=(u32x4){PKW(pB0,8),PKW(pB0,10),PKW(pB0,12),PKW(pB0,14)};pw2=(u32x4){PKW(pB1,0),PKW(pB1,2),PKW(pB1,4),PKW(pB1,6)};pw3=(u32x4){PKW(pB1,8),PKW(pB1,10),PKW(pB1,12),PKW(pB1,14)};
    SBAR(); pv(o,vb0+sl_cur,PAF(0),PAF(1),PAF(2),PAF(3)); }
  #undef PKW
  #undef PAF
  #undef VFR
  #undef PIN
  #undef MX3
  #undef GAPA
  #undef GAPB
  #undef EX
  #undef VRD
  #undef KRD
  #undef STEP
  #undef ENDW
  {auto rr=__builtin_amdgcn_permlane32_swap(__float_as_uint(l_reg),__float_as_uint(l_reg),false,false);l_reg=__uint_as_float(rr[0])+__uint_as_float(rr[1]);}
  if(hi==0)wsf[32+r32]=l_reg;asm volatile("s_waitcnt lgkmcnt(0)":::"memory");
  float rli[16];
  #pragma unroll
  for(int r=0;r<16;++r)rli[r]=__builtin_amdgcn_rcpf(wsf[32+crow(r,hi)]);
  bf16*Ow=Ob+(long)(wid*QBLK)*LDO; const bf16*Gw=Gb+(long)(wid*QBLK)*LDG;
  { bf16*stg=(bf16*)(shm+LDS_OST)+wid*2048;
    #pragma unroll
    for(int r=0;r<16;++r){const int orow=crow(r,hi);
      #pragma unroll
      for(int d0=0;d0<2;++d0)stg[orow*64+d0*32+r32]=__float2bfloat16(o[d0][r]*rli[r]);}
    asm volatile("s_waitcnt lgkmcnt(0)":::"memory");
    #pragma unroll
    for(int i=0;i<4;++i){const int row=i*8+(lane>>3),ch=lane&7; const u32x4 v=*(const u32x4*)(stg+row*64+ch*8); const u32x4 g=*(const u32x4*)(Gw+(long)row*LDG+ch*8); u32x4 w;
      #pragma unroll
      for(int e=0;e<4;++e){ const float v0=__uint_as_float(v[e]<<16),v1=__uint_as_float(v[e]&0xffff0000u),g0=__uint_as_float(g[e]<<16),g1=__uint_as_float(g[e]&0xffff0000u);
        w[e]=cvtpk_s(v0*g0*__builtin_amdgcn_rcpf(1.f+__expf(-g0)),v1*g1*__builtin_amdgcn_rcpf(1.f+__expf(-g1))); }
      ATTN_STORE16(Ow+(long)row*LDO+ch*8,w);} }
  asm volatile("s_waitcnt lgkmcnt(0)\n\ts_barrier":::"memory");
  #undef DMA_K
  #undef DMA_V
  #undef CMASK
  #undef START
  #undef RESC
  #undef ROT
}
constexpr int ATTN_LDS_BYTES=LDS_BYTES;
#undef SBAR
#undef WAIT_BAR
#undef KS
}
__device__ __forceinline__ void attn_phase(const P& p, int layer, char* lds, int bx, int G, bool need_ctx, int stage) {
    const int vcu = (G % 8 == 0) ? (bx % 8) * (G / 8) + bx / 8 : bx;
    const bf16_t* QA = (const bf16_t*)(p.ws + WS_QA); const bf16_t* KA = (const bf16_t*)(p.ws + WS_KA); const bf16_t* VA = (const bf16_t*)(p.ws + WS_VA);
    const bf16_t* KEEP = (const bf16_t*)(p.ws + WS_KEEP); bf16_t* MIX = (bf16_t*)(p.ws + WS_H);
    for (int pass = 0; pass < 2; ++pass) {
        if (pass == 1 && (!need_ctx || stage != 2)) break;
        const int nu = pass == 0 ? 256 : 48;
        for (int u = pass == 0 ? vcu : bx - (G >= 112 ? 64 : 0); u >= 0 && u < nu; u += G) {
            int b, h, qb, grp = -1; if (pass == 0) { b = u >> 6; h = (u >> 4) & 3; qb = u & 15; } else { grp = u >> 4; b = (u >> 2) & 3; h = u & 3; qb = 0; }
            const size_t rowb = (size_t)b * SPB, rowq = rowb + (pass == 0 ? CTX + qb * 256 : 0); const int nk = pass == 0 ? SPB / 64 : CTX / 64;
            if ((pass == 0 && stage == 0) || grp == 0) { att::Unit U; U.Q = QA + rowq * 384 + h * 96; U.ldq = 384; U.K = KA + rowb * 384 + h * 96; U.ldk = 384; U.V = VA + rowb * 256 + h * 64; U.ldv = 256;
              U.gate = KEEP + rowq * NKEEP + K_GA + h * 64; U.out = MIX + rowq * DM + h * 64; U.n1 = nk; U.n2 = 0; U.row2 = 0; U.tq0 = 0; U.sink_l2 = 0.f;
              if (HAND_A) attn_a::attn_unit<8, 384, 384, 256, NKEEP, DM>((const attn_a::bf16*)U.Q, (const attn_a::bf16*)U.K, (const attn_a::bf16*)U.V, (const attn_a::bf16*)U.gate, (attn_a::bf16*)U.out, nk, lds);
              else att::attn_unit<96, 0>(U, lds); }
            if ((pass == 0 && stage == 1) || grp == 1) { att::Unit U; U.Q = KEEP + rowq * NKEEP + K_BQ + h * 64; U.ldq = NKEEP; U.K = KEEP + rowb * NKEEP + K_BK + (h >> 1) * 64; U.ldk = NKEEP; U.V = KEEP + rowb * NKEEP + K_BV + (h >> 1) * 64; U.ldv = NKEEP;
              U.gate = KEEP + rowq * NKEEP + K_BG + h * 64; U.out = MIX + rowq * DM + 256 + h * 64; U.n1 = nk; U.n2 = 0; U.row2 = 0; U.tq0 = 0; U.sink_l2 = 0.f;
              if (HAND_B) attn_b::attn_unit<8, NKEEP, DM>((const attn_b::bf16*)U.Q, (const attn_b::bf16*)U.K, (const attn_b::bf16*)U.V, (const attn_b::bf16*)U.gate, (attn_b::bf16*)U.out, nk, lds);
              else att::attn_unit<64, 0>(U, lds); }
            if ((pass == 0 && stage == 2) || grp == 2) { att::Unit U; U.Q = KEEP + rowq * NKEEP + K_CQ + h * 64; U.ldq = NKEEP; U.K = KEEP + rowb * NKEEP + K_CK + (h >> 1) * 64; U.ldk = NKEEP; U.V = KEEP + rowb * NKEEP + K_CV + (h >> 1) * 64; U.ldv = NKEEP;
              U.gate = KEEP + rowq * NKEEP + K_CG + h * 64; U.out = MIX + rowq * DM + 512 + h * 64; U.n1 = CTX / 64; U.n2 = pass == 0 ? 8 : 0; U.row2 = CTX + qb * 256 - 128; U.tq0 = qb * 256;
              U.sink_l2 = p.swa_sink[layer * 4 + h] * LOG2E;
              att::attn_unit<64, 1>(U, lds); }
        }
    }
}


namespace prep {
typedef short bf16x8 __attribute__((ext_vector_type(8)));
typedef float f32x16 __attribute__((ext_vector_type(16)));
constexpr int AQ_PITCH = 528, AKV_PITCH = 272;
constexpr int L_AQ = 0, L_AKV = 64 * AQ_PITCH, L_KR = L_AKV + 64 * AKV_PITCH, L_END = L_KR + 64 * 32 * 4;
__device__ __forceinline__ void unit(const P& p, int layer, int u, char* lds) {
    const int tid = tid512_fresh(), wid = tid >> 6, lane = tid & 63, r32 = lane & 31, hi = lane >> 5; const int row0 = u * 64;
    const bf16_t* tmp = (const bf16_t*)(p.ws + WS_TMP);
    { const float* qn = p.mla_q_norm + layer * 256 + lane * 4; const float* kvn = p.mla_kv_norm + layer * 128 + lane * 2;
      const float qn0 = qn[0], qn1 = qn[1], qn2 = qn[2], qn3 = qn[3], kn0 = kvn[0], kn1 = kvn[1];
      uint2 cqv[8]; unsigned ckv[8]; bf16_t krv[8];
#pragma unroll
      for (int i = 0; i < 8; ++i) { const bf16_t* row = tmp + (size_t)(row0 + wid * 8 + i) * NTMP; cqv[i] = *(const uint2*)(row + T_CQ + lane * 4); ckv[i] = *(const unsigned*)(row + T_CKV + lane * 2); krv[i] = row[T_KR + (lane & 31)]; }
      SB();
      float sq[8], sk[8];
#pragma unroll
      for (int i = 0; i < 8; ++i) { const float a0 = __uint_as_float(cqv[i].x << 16), a1 = __uint_as_float(cqv[i].x & 0xffff0000u), a2 = __uint_as_float(cqv[i].y << 16), a3 = __uint_as_float(cqv[i].y & 0xffff0000u);
          const float b0 = __uint_as_float(ckv[i] << 16), b1 = __uint_as_float(ckv[i] & 0xffff0000u); sq[i] = a0 * a0 + a1 * a1 + a2 * a2 + a3 * a3; sk[i] = b0 * b0 + b1 * b1; }
#pragma unroll
      for (int o = 1; o < 64; o <<= 1) {
#pragma unroll
          for (int i = 0; i < 8; ++i) { sq[i] += __shfl_xor(sq[i], o); sk[i] += __shfl_xor(sk[i], o); } }
#pragma unroll
      for (int i = 0; i < 8; ++i) { const int rr = wid * 8 + i; const float rq = rsqrtf(sq[i] * (1.f / 256.f) + EPS), rk = rsqrtf(sk[i] * (1.f / 128.f) + EPS);
          const float a0 = __uint_as_float(cqv[i].x << 16), a1 = __uint_as_float(cqv[i].x & 0xffff0000u), a2 = __uint_as_float(cqv[i].y << 16), a3 = __uint_as_float(cqv[i].y & 0xffff0000u);
          const float b0 = __uint_as_float(ckv[i] << 16), b1 = __uint_as_float(ckv[i] & 0xffff0000u);
          uint2 o; o.x = pk2bf(a0 * rq * qn0, a1 * rq * qn1); o.y = pk2bf(a2 * rq * qn2, a3 * rq * qn3);
          *(uint2*)(lds + L_AQ + rr * AQ_PITCH + lane * 8) = o;
          *(unsigned*)(lds + L_AKV + rr * AKV_PITCH + lane * 4) = pk2bf(b0 * rk * kn0, b1 * rk * kn1);
          if (lane < 32) ((float*)(lds + L_KR))[rr * 32 + lane] = bf2f(krv[i]); } }
    __syncthreads();
    { const int rt = wid & 1, h = wid >> 1;
      const bf16x8* WQF = (const bf16x8*)(p.ws + WS_WQ) + (size_t)layer * 12288 + lane; const bf16x8* WKVF = (const bf16x8*)(p.ws + WS_WKV) + (size_t)layer * 8192 + lane;
      f32x16 aq[3] = {};
      const char* ap = lds + L_AQ + (rt * 32 + r32) * AQ_PITCH + hi * 16;
#pragma unroll
      for (int kb = 0; kb < 2; ++kb) { bf16x8 wf[8][3], af[8];
#pragma unroll
          for (int k8 = 0; k8 < 8; ++k8) { af[k8] = *(const bf16x8*)(ap + (kb * 8 + k8) * 32);
#pragma unroll
              for (int j = 0; j < 3; ++j) wf[k8][j] = WQF[((3 * h + j) * 16 + kb * 8 + k8) * 64]; }
          SB();
#pragma unroll
          for (int k8 = 0; k8 < 8; ++k8)
#pragma unroll
              for (int j = 0; j < 3; ++j) aq[j] = __builtin_amdgcn_mfma_f32_32x32x16_bf16(wf[k8][j], af[k8], aq[j], 0, 0, 0);
          SB(); }
      f32x16 akv[4] = {};
      const char* ap2 = lds + L_AKV + (rt * 32 + r32) * AKV_PITCH + hi * 16;
#pragma unroll
      for (int kb = 0; kb < 2; ++kb) { bf16x8 wf[4][4], af[4];
#pragma unroll
          for (int k4 = 0; k4 < 4; ++k4) { af[k4] = *(const bf16x8*)(ap2 + (kb * 4 + k4) * 32);
#pragma unroll
              for (int j = 0; j < 4; ++j) wf[k4][j] = WKVF[((4 * h + j) * 8 + kb * 4 + k4) * 64]; }
          SB();
#pragma unroll
          for (int k4 = 0; k4 < 4; ++k4)
#pragma unroll
              for (int j = 0; j < 4; ++j) akv[j] = __builtin_amdgcn_mfma_f32_32x32x16_bf16(wf[k4][j], af[k4], akv[j], 0, 0, 0);
          SB(); }
      bf16_t* QA = (bf16_t*)(p.ws + WS_QA); bf16_t* KA = (bf16_t*)(p.ws + WS_KA); bf16_t* VA = (bf16_t*)(p.ws + WS_VA);
      const float qscale = LOG2E * 0.10206207261596577f;
      const int R = row0 + rt * 32 + r32, s = R % SPB;
      if (s >= CTX) { const float* rt32 = (const float*)(p.ws + WS_ROPE32) + (size_t)(s - CTX) * 32;
#pragma unroll
          for (int rq = 0; rq < 2; ++rq) { const float4 c01 = *(const float4*)(rt32 + (8 * rq + 4 * hi) * 2), c23 = *(const float4*)(rt32 + (8 * rq + 4 * hi) * 2 + 4);
              const float cs[4] = {c01.x, c01.z, c23.x, c23.z}, sn[4] = {c01.y, c01.w, c23.y, c23.w};
#pragma unroll
              for (int e = 0; e < 4; ++e) { const float x1 = aq[2][rq * 4 + e], x2 = aq[2][rq * 4 + 8 + e]; aq[2][rq * 4 + e] = x1 * cs[e] - x2 * sn[e]; aq[2][rq * 4 + 8 + e] = x1 * sn[e] + x2 * cs[e]; } } }
#define PREP_ST16(T, SC, DST) do { _Pragma("unroll") for (int m_ = 0; m_ < 2; ++m_) { \
          const unsigned a0_ = pk2bf(T[8 * m_ + 0] * (SC), T[8 * m_ + 1] * (SC)), a1_ = pk2bf(T[8 * m_ + 2] * (SC), T[8 * m_ + 3] * (SC)), b0_ = pk2bf(T[8 * m_ + 4] * (SC), T[8 * m_ + 5] * (SC)), b1_ = pk2bf(T[8 * m_ + 6] * (SC), T[8 * m_ + 7] * (SC)); \
          auto r0_ = __builtin_amdgcn_permlane32_swap(a0_, b0_, false, false); auto r1_ = __builtin_amdgcn_permlane32_swap(a1_, b1_, false, false); \
          *(uint4*)((DST) + 16 * m_ + 8 * hi) = make_uint4(r0_[0], r1_[0], r0_[1], r1_[1]); } } while (0)
#pragma unroll
      for (int j = 0; j < 3; ++j) PREP_ST16(aq[j], qscale, QA + (size_t)R * 384 + 96 * h + 32 * j);
#pragma unroll
      for (int j = 0; j < 2; ++j) PREP_ST16(akv[j], 1.f, KA + (size_t)R * 384 + 96 * h + 32 * j);
#pragma unroll
      for (int j = 2; j < 4; ++j) PREP_ST16(akv[j], 1.f, VA + (size_t)R * 256 + 64 * h + 32 * (j - 2));
#undef PREP_ST16
      { const int rr = tid >> 3, gq = tid & 3, hp = (tid >> 2) & 1; const int Rk = row0 + rr, sk_ = Rk % SPB; const float* kr = (const float*)(lds + L_KR) + rr * 32 + gq * 4;
        const float4 xa = *(const float4*)kr, xb = *(const float4*)(kr + 16);
        float x1[4] = {xa.x, xa.y, xa.z, xa.w}, x2[4] = {xb.x, xb.y, xb.z, xb.w};
        if (sk_ >= CTX) { const float* rp = (const float*)(p.ws + WS_ROPE32) + ((size_t)(sk_ - CTX) * 16 + gq * 4) * 2; const float4 c01 = *(const float4*)rp, c23 = *(const float4*)(rp + 4);
            const float cs[4] = {c01.x, c01.z, c23.x, c23.z}, sn[4] = {c01.y, c01.w, c23.y, c23.w};
#pragma unroll
            for (int e = 0; e < 4; ++e) { const float y1 = x1[e] * cs[e] - x2[e] * sn[e], y2 = x1[e] * sn[e] + x2[e] * cs[e]; x1[e] = y1; x2[e] = y2; } }
        uint2 o1, o2; o1.x = pk2bf(x1[0], x1[1]); o1.y = pk2bf(x1[2], x1[3]); o2.x = pk2bf(x2[0], x2[1]); o2.y = pk2bf(x2[2], x2[3]);
        bf16_t* kp = KA + (size_t)Rk * 384 + 64 + gq * 4 + hp * 192;
        *(uint2*)kp = o1; *(uint2*)(kp + 16) = o2; *(uint2*)(kp + 96) = o1; *(uint2*)(kp + 112) = o2; }
    }
    __syncthreads();
}
__device__ __forceinline__ void bc_rows(const P& p, int layer, int ck0, int ck1, int ckstep) {
    if (ck0 >= ck1) return;
    const int tid = tid512_fresh(), lane = tid & 63, slot = lane >> 4, j = lane & 15; const int wv = tid >> 6; const float qscale = 0.125f * LOG2E;
    int offs[3]; float sc[3], w1a[3], w1b[3], w2a[3], w2b[3]; bool nrm[3];
#pragma unroll
    for (int it = 0; it < 3; ++it) { const int hv = it * 4 + slot; const bool isq = hv < 4 || (hv >= 6 && hv < 10); nrm[it] = hv < 6;
        offs[it] = hv < 4 ? K_BQ + hv * 64 : hv < 6 ? K_BK + (hv - 4) * 64 : hv < 10 ? K_CQ + (hv - 6) * 64 : K_CK + (hv - 10) * 64; sc[it] = isq ? qscale : 1.f;
        const float* nw = hv < 4 ? p.gqa_q_norm + layer * 64 : p.gqa_k_norm + layer * 64;
        w1a[it] = nrm[it] ? nw[2 * j] : 1.f; w1b[it] = nrm[it] ? nw[2 * j + 1] : 1.f; w2a[it] = nrm[it] ? nw[32 + 2 * j] : 1.f; w2b[it] = nrm[it] ? nw[33 + 2 * j] : 1.f; }
    const float dtb = p.dt_bias[layer * 8 + (lane & 7)]; const bf16_t* tmp = (const bf16_t*)(p.ws + WS_TMP);
#pragma unroll 1
    for (int ck = ck0; ck < ck1; ck += 2 * ckstep) {
        unsigned x1[4][3], x2[4][3]; float4 cs[4]; float dtv[4]; const bool two = ck + ckstep < ck1;
#pragma unroll
        for (int q = 0; q < 4; ++q) { const int R = ((q >> 1) && two ? ck + ckstep : ck) * 16 + wv + (q & 1) * 8; const int s = R % SPB; const bf16_t* row = (const bf16_t*)(p.ws + WS_KEEP) + (size_t)R * NKEEP;
            cs[q] = make_float4(1.f, 0.f, 1.f, 0.f); if (s >= CTX) cs[q] = *(const float4*)((const float*)(p.ws + WS_ROPE64) + ((size_t)(s - CTX) * 32 + 2 * j) * 2);
            dtv[q] = bf2f(tmp[(size_t)R * NTMP + T_DT + (lane & 7)]);
#pragma unroll
            for (int it = 0; it < 3; ++it) { x1[q][it] = *(const unsigned*)(row + offs[it] + 2 * j); x2[q][it] = *(const unsigned*)(row + offs[it] + 32 + 2 * j); } }
        SB();
#pragma unroll
        for (int q = 0; q < 4; ++q) { if ((q >> 1) && !two) break; const int R = ((q >> 1) ? ck + ckstep : ck) * 16 + wv + (q & 1) * 8; bf16_t* row = (bf16_t*)(p.ws + WS_KEEP) + (size_t)R * NKEEP;
#pragma unroll
            for (int it = 0; it < 3; ++it) {
                float a0 = __uint_as_float(x1[q][it] << 16), a1 = __uint_as_float(x1[q][it] & 0xffff0000u), b0 = __uint_as_float(x2[q][it] << 16), b1 = __uint_as_float(x2[q][it] & 0xffff0000u);
                float ss = a0 * a0 + a1 * a1 + b0 * b0 + b1 * b1;
#pragma unroll
                for (int o = 1; o < 16; o <<= 1) ss += __shfl_xor(ss, o);
                const float rs = nrm[it] ? rsqrtf(ss * (1.f / 64.f) + EPS) : 1.f;
                a0 *= rs * w1a[it]; a1 *= rs * w1b[it]; b0 *= rs * w2a[it]; b1 *= rs * w2b[it];
                const float y10 = (a0 * cs[q].x - b0 * cs[q].y) * sc[it], y11 = (a1 * cs[q].z - b1 * cs[q].w) * sc[it], y20 = (a0 * cs[q].y + b0 * cs[q].x) * sc[it], y21 = (a1 * cs[q].w + b1 * cs[q].z) * sc[it];
                *(unsigned*)(row + offs[it] + 2 * j) = pk2bf(y10, y11); *(unsigned*)(row + offs[it] + 32 + 2 * j) = pk2bf(y20, y21); }
            if (lane < 8) { const float v = dtv[q] + dtb; const float e = __expf(-fabsf(v));
                const float l1p = e < 0.03f ? e * (1.f - e * (0.5f - e * 0.33333334f)) : __logf(1.f + e);
                ((float*)(p.ws + WS_DT))[(size_t)R * 8 + lane] = fmaxf(v, 0.f) + l1p; } } }
}
__device__ __forceinline__ void conv_items(const P& p, int layer, int it0, int itstep) {
    const int tid = tid512_fresh(); const bf16_t* tmp = (const bf16_t*)(p.ws + WS_TMP); bf16_t* U = (bf16_t*)(p.ws + WS_U);
#pragma unroll 1
    for (int it = it0; it < (MROWS / 16) * 96 / 512; it += itstep) { const int item = it * 512 + tid; const int seg = item / 96, cg = item % 96; const int R0 = seg * 16; const int s0 = R0 % SPB; const bool lat = s0 >= CTX; const int pos0 = lat ? s0 - CTX : s0, len = lat ? SEQ : CTX;
        const float* cw = p.conv_w + (size_t)layer * 5 * 768 + cg * 8; const float* cb = p.conv_b + layer * 768 + cg * 8;
        float w[5][8], bias[8];
#pragma unroll
        for (int e = 0; e < 8; ++e) bias[e] = cb[e];
#pragma unroll
        for (int j = 0; j < 5; ++j)
#pragma unroll
            for (int e = 0; e < 8; ++e) w[j][e] = cw[j * 768 + e];
        uint4 xin[20];
#pragma unroll
        for (int j = 0; j < 20; ++j) { const int pp = pos0 + j - 2; xin[j] = (pp >= 0 && pp < len) ? *(const uint4*)(tmp + (size_t)(R0 + j - 2) * NTMP + T_XBC + cg * 8) : make_uint4(0u, 0u, 0u, 0u); }
        SB();
#pragma unroll
        for (int rr = 0; rr < 16; ++rr) { float a[8];
#pragma unroll
            for (int e = 0; e < 8; ++e) a[e] = bias[e];
#pragma unroll
            for (int j = 0; j < 5; ++j) { const uint4 xv = xin[rr + j]; const unsigned xw[4] = {xv.x, xv.y, xv.z, xv.w};
#pragma unroll
                for (int e = 0; e < 4; ++e) { a[2 * e] += w[j][2 * e] * __uint_as_float(xw[e] << 16); a[2 * e + 1] += w[j][2 * e + 1] * __uint_as_float(xw[e] & 0xffff0000u); } }
            uint4 o; o.x = pk2bf(silu_f(a[0]), silu_f(a[1])); o.y = pk2bf(silu_f(a[2]), silu_f(a[3]));
            o.z = pk2bf(silu_f(a[4]), silu_f(a[5])); o.w = pk2bf(silu_f(a[6]), silu_f(a[7]));
            *(uint4*)(U + (size_t)(R0 + rr) * 768 + cg * 8) = o; } }
}
}


namespace ssdc {
typedef short bf16x8 __attribute__((ext_vector_type(8)));
typedef float f32x16 __attribute__((ext_vector_type(16)));
typedef unsigned u32x4 __attribute__((ext_vector_type(4)));
__device__ __forceinline__ void unit(const P& p, int layer, int u, char* lds) {
    const int tid = tid512_fresh(), wid = tid >> 6, lane = tid & 63, r32 = lane & 31, hi = lane >> 5; const int rt = wid & 1, h = wid >> 1, g = h >> 1;
    const int row0 = u * 64 + rt * 32; const int b = row0 / SPB, ch = (row0 % SPB) >> 7;
    const bf16_t* U = (const bf16_t*)(p.ws + WS_U); const bf16_t* ST = (const bf16_t*)(p.ws + WS_STATES); const float* ACUM = (const float*)(p.ws + WS_ACUM);
    bf16x8 cf[8];
    { const bf16_t* Cp = U + (size_t)(row0 + r32) * 768 + 512 + g * 128 + hi * 8;
#pragma unroll
      for (int ks = 0; ks < 8; ++ks) cf[ks] = *(const bf16x8*)(Cp + ks * 16); }
    f32x16 y0 = {}, y1 = {};
    constexpr int PP = 272;
    char* pl = lds + 4096;
#pragma unroll 1
    for (int d = 0; d < 2; ++d) {
        { u32x4 sv[8]; const u32x4* gp = (const u32x4*)(ST + ((size_t)(b * 34 + ch) * 2 + d) * 4 * 8192) + tid;
#pragma unroll
          for (int i = 0; i < 8; ++i) sv[i] = gp[512 * i];
          SB();
#pragma unroll
          for (int i = 0; i < 8; ++i) { const int c = tid + 512 * i; const int hh = c >> 10, pp = ((c >> 9) & 1) * 32 + (c & 31), n8 = (c >> 5) & 15;
              *(u32x4*)(pl + (hh * 64 + pp) * PP + n8 * 16) = sv[i]; } }
        __syncthreads();
        f32x16 t0 = {}, t1 = {};
        const char* bp = pl + (h * 64 + r32) * PP + hi * 16;
#pragma unroll
        for (int ks = 0; ks < 8; ++ks) {
            const bf16x8 b0 = *(const bf16x8*)(bp + ks * 32), b1 = *(const bf16x8*)(bp + 32 * PP + ks * 32);
            t0 = __builtin_amdgcn_mfma_f32_32x32x16_bf16(b0, cf[ks], t0, 0, 0, 0);
            t1 = __builtin_amdgcn_mfma_f32_32x32x16_bf16(b1, cf[ks], t1, 0, 0, 0); }
        const float dec = __expf(ACUM[(size_t)(row0 + r32) * 8 + d * 4 + h]);
#pragma unroll
        for (int r = 0; r < 16; ++r) { y0[r] += dec * t0[r]; y1[r] += dec * t1[r]; }
        __syncthreads(); }
    const bf16_t* Y = (const bf16_t*)(p.ws + WS_Y); const bf16_t* keep = (const bf16_t*)(p.ws + WS_KEEP); const float skip = p.ssd_d[layer * 4 + h];
    float* ssum = (float*)lds;
    const size_t R = (size_t)(row0 + r32); float ss = 0.f;
    uint2 yv8[8], xv8[8], zv8[8];
#pragma unroll
    for (int q8 = 0; q8 < 8; ++q8) { const int c0 = h * 64 + (q8 >> 2) * 32 + 8 * (q8 & 3) + 4 * hi; yv8[q8] = *(const uint2*)(Y + R * 256 + c0); xv8[q8] = *(const uint2*)(U + R * 768 + c0); zv8[q8] = *(const uint2*)(keep + R * NKEEP + K_Z + c0); }
    SB();
#pragma unroll
    for (int pt = 0; pt < 2; ++pt)
#pragma unroll
        for (int rq = 0; rq < 4; ++rq) {
            const uint2 yv = yv8[pt * 4 + rq], xv = xv8[pt * 4 + rq], zv = zv8[pt * 4 + rq];
            const float ye[4] = {__uint_as_float(yv.x << 16), __uint_as_float(yv.x & 0xffff0000u), __uint_as_float(yv.y << 16), __uint_as_float(yv.y & 0xffff0000u)};
            const float xe[4] = {__uint_as_float(xv.x << 16), __uint_as_float(xv.x & 0xffff0000u), __uint_as_float(xv.y << 16), __uint_as_float(xv.y & 0xffff0000u)};
            const float ze[4] = {__uint_as_float(zv.x << 16), __uint_as_float(zv.x & 0xffff0000u), __uint_as_float(zv.y << 16), __uint_as_float(zv.y & 0xffff0000u)};
#pragma unroll
            for (int e = 0; e < 4; ++e) { const float acc = pt == 0 ? y0[rq * 4 + e] : y1[rq * 4 + e]; const float v = (acc + ye[e] + skip * xe[e]) * silu_f(ze[e]); ss += v * v;
                if (pt == 0) y0[rq * 4 + e] = v; else y1[rq * 4 + e] = v; } }
    ss += __shfl_xor(ss, 32);
    if (hi == 0) ssum[(rt * 4 + h) * 32 + r32] = ss;
    __syncthreads();
    const float tot = ssum[(rt * 4 + 0) * 32 + r32] + ssum[(rt * 4 + 1) * 32 + r32] + ssum[(rt * 4 + 2) * 32 + r32] + ssum[(rt * 4 + 3) * 32 + r32];
    const float rs = rsqrtf(tot * (1.f / 256.f) + EPS); bf16_t* mix = (bf16_t*)(p.ws + WS_H);
#pragma unroll
    for (int pt = 0; pt < 2; ++pt)
#pragma unroll
        for (int m = 0; m < 2; ++m) {
            const int c0 = h * 64 + pt * 32 + 16 * m + 4 * hi; const float4 nwa = *(const float4*)(p.ssd_norm_w + layer * 256 + c0), nwb = *(const float4*)(p.ssd_norm_w + layer * 256 + c0 + 8);
            const float va0 = pt == 0 ? y0[8 * m + 0] : y1[8 * m + 0], va1 = pt == 0 ? y0[8 * m + 1] : y1[8 * m + 1], va2 = pt == 0 ? y0[8 * m + 2] : y1[8 * m + 2], va3 = pt == 0 ? y0[8 * m + 3] : y1[8 * m + 3];
            const float vb0 = pt == 0 ? y0[8 * m + 4] : y1[8 * m + 4], vb1 = pt == 0 ? y0[8 * m + 5] : y1[8 * m + 5], vb2 = pt == 0 ? y0[8 * m + 6] : y1[8 * m + 6], vb3 = pt == 0 ? y0[8 * m + 7] : y1[8 * m + 7];
            const unsigned a0_ = att::cvtpk(va0 * rs * nwa.x, va1 * rs * nwa.y), a1_ = att::cvtpk(va2 * rs * nwa.z, va3 * rs * nwa.w), b0_ = att::cvtpk(vb0 * rs * nwb.x, vb1 * rs * nwb.y), b1_ = att::cvtpk(vb2 * rs * nwb.z, vb3 * rs * nwb.w);
            auto r0_ = __builtin_amdgcn_permlane32_swap(a0_, b0_, false, false); auto r1_ = __builtin_amdgcn_permlane32_swap(a1_, b1_, false, false);
            *(uint4*)(mix + R * DM + 768 + h * 64 + pt * 32 + 16 * m + 8 * hi) = make_uint4(r0_[0], r1_[0], r0_[1], r1_[1]); }
    __syncthreads();
}
}


namespace ssda {
using att::bf16x8; using att::s16x4; using att::f32x16; using att::u32x4;
constexpr int L_KB = 0, L_VX = 32768, L_VB = 65536, L_VEC = 98304, L_END = L_VEC + 12 * 512;
__device__ __forceinline__ int v_st4(int k, int c) { const int kk = (k & ~0xC) | ((k & 4) << 1) | ((k & 8) >> 1); return ((kk >> 3) * 4 + (c >> 5)) * 512 + ((kk & 7) * 32 + (c & 31)) * 2; }
constexpr int v4_off(int d0, int ks, int half) { return d0 * 512 + ks * 4096 + half * 2048; }
#define SSDA_PK(L, H) (bf16x8){L[0], L[1], L[2], L[3], H[0], H[1], H[2], H[3]}
template <int PT, int KS> __device__ __forceinline__ bf16x8 xfrag(int vb) { const s16x4 l = att::tr_read<att::v_rd_off(PT, KS, 0)>(vb), h = att::tr_read<att::v_rd_off(PT, KS, 1)>(vb); asm volatile("s_waitcnt lgkmcnt(0)" ::: "memory"); __builtin_amdgcn_sched_barrier(0); return SSDA_PK(l, h); }
template <int NT, int KS> __device__ __forceinline__ bf16x8 bfrag(int vb) { const s16x4 l = att::tr_read<v4_off(NT, KS, 0)>(vb), h = att::tr_read<v4_off(NT, KS, 1)>(vb); asm volatile("s_waitcnt lgkmcnt(0)" ::: "memory"); __builtin_amdgcn_sched_barrier(0); return SSDA_PK(l, h); }
__device__ __forceinline__ bf16x8 scale8(bf16x8 x, const float* w) {
    const float4 w0 = *(const float4*)w, w1 = *(const float4*)(w + 4); u32x4 xi = *reinterpret_cast<u32x4*>(&x), o;
    o[0] = att::cvtpk(__uint_as_float(xi[0] << 16) * w0.x, __uint_as_float(xi[0] & 0xffff0000u) * w0.y); o[1] = att::cvtpk(__uint_as_float(xi[1] << 16) * w0.z, __uint_as_float(xi[1] & 0xffff0000u) * w0.w);
    o[2] = att::cvtpk(__uint_as_float(xi[2] << 16) * w1.x, __uint_as_float(xi[2] & 0xffff0000u) * w1.y); o[3] = att::cvtpk(__uint_as_float(xi[3] << 16) * w1.z, __uint_as_float(xi[3] & 0xffff0000u) * w1.w);
    return *reinterpret_cast<bf16x8*>(&o);
}
template <int D0> __device__ __forceinline__ void pvT_one(f32x16& od, int vb, bf16x8 pa0, bf16x8 pa1, bf16x8 pa2, bf16x8 pa3) {
    const s16x4 l0 = att::tr_read<att::v_rd_off(D0, 0, 0)>(vb), h0 = att::tr_read<att::v_rd_off(D0, 0, 1)>(vb), l1 = att::tr_read<att::v_rd_off(D0, 1, 0)>(vb), h1 = att::tr_read<att::v_rd_off(D0, 1, 1)>(vb);
    const s16x4 l2 = att::tr_read<att::v_rd_off(D0, 2, 0)>(vb), h2 = att::tr_read<att::v_rd_off(D0, 2, 1)>(vb), l3 = att::tr_read<att::v_rd_off(D0, 3, 0)>(vb), h3 = att::tr_read<att::v_rd_off(D0, 3, 1)>(vb);
    asm volatile("s_waitcnt lgkmcnt(0)" ::: "memory"); __builtin_amdgcn_sched_barrier(0);
    od = __builtin_amdgcn_mfma_f32_32x32x16_bf16(SSDA_PK(l0, h0), pa0, od, 0, 0, 0);
    od = __builtin_amdgcn_mfma_f32_32x32x16_bf16(SSDA_PK(l1, h1), pa1, od, 0, 0, 0);
    od = __builtin_amdgcn_mfma_f32_32x32x16_bf16(SSDA_PK(l2, h2), pa2, od, 0, 0, 0);
    od = __builtin_amdgcn_mfma_f32_32x32x16_bf16(SSDA_PK(l3, h3), pa3, od, 0, 0, 0);
}
template <int PT, int KT> __device__ __forceinline__ void state_tile(f32x16* acc, int vx, int vbb, const float* wsv, int hi) {
#define SSDA_STEP(KS) do { \
    const s16x4 xl = att::tr_read<att::v_rd_off(PT, KS, 0)>(vx), xh = att::tr_read<att::v_rd_off(PT, KS, 1)>(vx); \
    const s16x4 l0 = att::tr_read<v4_off(0, KS, 0)>(vbb), h0 = att::tr_read<v4_off(0, KS, 1)>(vbb), l1 = att::tr_read<v4_off(1, KS, 0)>(vbb), h1 = att::tr_read<v4_off(1, KS, 1)>(vbb); \
    const s16x4 l2 = att::tr_read<v4_off(2, KS, 0)>(vbb), h2 = att::tr_read<v4_off(2, KS, 1)>(vbb), l3 = att::tr_read<v4_off(3, KS, 0)>(vbb), h3 = att::tr_read<v4_off(3, KS, 1)>(vbb); \
    asm volatile("s_waitcnt lgkmcnt(0)" ::: "memory"); __builtin_amdgcn_sched_barrier(0); \
    const bf16x8 a = scale8(SSDA_PK(xl, xh), wsv + KT * 64 + KS * 16 + hi * 8); \
    acc[0] = __builtin_amdgcn_mfma_f32_32x32x16_bf16(SSDA_PK(l0, h0), a, acc[0], 0, 0, 0); acc[1] = __builtin_amdgcn_mfma_f32_32x32x16_bf16(SSDA_PK(l1, h1), a, acc[1], 0, 0, 0); \
    acc[2] = __builtin_amdgcn_mfma_f32_32x32x16_bf16(SSDA_PK(l2, h2), a, acc[2], 0, 0, 0); acc[3] = __builtin_amdgcn_mfma_f32_32x32x16_bf16(SSDA_PK(l3, h3), a, acc[3], 0, 0, 0); \
    __builtin_amdgcn_sched_barrier(0); } while (0)
    SSDA_STEP(0); SSDA_STEP(1); SSDA_STEP(2); SSDA_STEP(3);
#undef SSDA_STEP
}
__device__ __forceinline__ void unit(const P& p, int layer, int u, int hm, char* lds) {
    const int tid = tid512_fresh(), wid = tid >> 6, lane = tid & 63, r32 = lane & 31, hi = lane >> 5; const int g = u & 1, bc = u >> 1, ch = bc % 34, b = bc / 34;
    const size_t R0 = (size_t)b * SPB + ch * 128; const bf16_t* U = (const bf16_t*)(p.ws + WS_U); const float* DT = (const float*)(p.ws + WS_DT);
    float* vec = (float*)(lds + L_VEC);
    bf16x8 qr[8];
    { const int hh_ = wid >> 2, qt_ = wid & 3; const bf16_t* Cp = U + (R0 + qt_ * 32 + r32) * 768 + 512 + g * 128 + hi * 8;
#pragma unroll
      for (int d0 = 0; d0 < 8; ++d0) qr[d0] = *(const bf16x8*)(Cp + d0 * 16); (void)hh_; }
    float dtl0 = 0.f, dtl1 = 0.f;
    if (wid < 4) { const int d = wid & 1, h = 2 * g + (wid >> 1); const int k0 = d == 0 ? 2 * lane : 127 - 2 * lane, k1 = d == 0 ? 2 * lane + 1 : 126 - 2 * lane; dtl0 = DT[(R0 + k0) * 8 + d * 4 + h]; dtl1 = DT[(R0 + k1) * 8 + d * 4 + h]; }
    { bf16x8 vb[4], vx[4];
#pragma unroll
      for (int i = 0; i < 4; ++i) { const int c = tid + 512 * i; vb[i] = *(const bf16x8*)(U + (R0 + (c >> 4)) * 768 + 256 + g * 128 + (c & 15) * 8); vx[i] = *(const bf16x8*)(U + (R0 + ((c >> 3) & 127)) * 768 + (2 * g + (c >> 10)) * 64 + (c & 7) * 8); }
      SB();
#pragma unroll
      for (int i = 0; i < 4; ++i) { const int c = tid + 512 * i, row = c >> 4, chk = c & 15;
          *(bf16x8*)(lds + L_KB + att::kswz<128>(row, chk)) = vb[i]; *(bf16x8*)(lds + L_VB + (row >> 6) * 16384 + v_st4(row & 63, chk * 8)) = vb[i]; }
#pragma unroll
      for (int i = 0; i < 4; ++i) { const int c = tid + 512 * i, hh = c >> 10, row = (c >> 3) & 127, chk = c & 7;
          *(bf16x8*)(lds + L_VX + (hh * 2 + (row >> 6)) * 8192 + att::v_st(row & 63, chk * 8)) = vx[i]; } }
    if (wid < 4) { const int hh = wid >> 1, d = wid & 1, h = 2 * g + hh; const float a = -__expf(p.a_log[layer * 8 + d * 4 + h]);
        const int k0 = d == 0 ? 2 * lane : 127 - 2 * lane, k1 = d == 0 ? 2 * lane + 1 : 126 - 2 * lane;
        const float dt0 = dtl0, dt1 = dtl1; const float c1 = dt0 * a, c2 = c1 + dt1 * a;
        float sc = c2;
#pragma unroll
        for (int o = 1; o < 64; o <<= 1) { const float t = __shfl_up(sc, o); if (lane >= o) sc += t; }
        const float ex = sc - c2, ac_0 = ex + c1, ac_1 = ex + c2; const float atot = __shfl(sc, 63);
        float* v = vec + (hh * 2 + d) * 384;
        v[k0] = ac_0; v[k1] = ac_1; v[128 + k0] = dt0; v[128 + k1] = dt1; v[256 + k0] = __expf(atot - ac_0) * dt0; v[256 + k1] = __expf(atot - ac_1) * dt1;
        if (hm < 0 || hm == hh) { float* ACUM = (float*)(p.ws + WS_ACUM); ACUM[(R0 + k0) * 8 + d * 4 + h] = ac_0; ACUM[(R0 + k1) * 8 + d * 4 + h] = ac_1;
            if (lane == 0) ((float*)(p.ws + WS_ATOT))[(b * 34 + ch) * 8 + d * 4 + h] = atot; } }
    __syncthreads();
    if (hm < 0 || wid < 4) { const int hh = hm < 0 ? wid >> 2 : hm, qt = wid & 3, h = 2 * g + hh; const int q = qt * 32 + r32;
      const float* v0 = vec + (hh * 2 + 0) * 384; const float* v1 = vec + (hh * 2 + 1) * 384; const float ac0q = v0[q], ac1q = v1[q];
      f32x16 o[2] = {};
#pragma unroll
      for (int kt = 0; kt < 2; ++kt) { f32x16 p0, p1; att::qkt<128>(p0, p1, lds + L_KB + kt * 64 * 256, qr, r32, hi);
#pragma unroll
          for (int rq = 0; rq < 4; ++rq) {
#pragma unroll
              for (int hf = 0; hf < 2; ++hf) { const int kb = kt * 64 + hf * 32 + 8 * rq + 4 * hi;
                  const float4 a0 = *(const float4*)(v0 + kb), d0v = *(const float4*)(v0 + 128 + kb), a1 = *(const float4*)(v1 + kb), d1v = *(const float4*)(v1 + 128 + kb);
                  const float a0e[4] = {a0.x, a0.y, a0.z, a0.w}, d0e[4] = {d0v.x, d0v.y, d0v.z, d0v.w}, a1e[4] = {a1.x, a1.y, a1.z, a1.w}, d1e[4] = {d1v.x, d1v.y, d1v.z, d1v.w};
#pragma unroll
                  for (int e = 0; e < 4; ++e) { const int k = kb + e; float w = 0.f; if (k <= q) w += __expf(ac0q - a0e[e]) * d0e[e]; if (k >= q) w += __expf(ac1q - a1e[e]) * d1e[e];
                      if (hf == 0) p0[rq * 4 + e] *= w; else p1[rq * 4 + e] *= w; } } }
          bf16x8 pa0, pa1, pa2, pa3;
#define SSDA_PK4(PP, BASE, OUT) do { unsigned a0_ = att::cvtpk(PP[BASE + 0], PP[BASE + 1]), a1_ = att::cvtpk(PP[BASE + 2], PP[BASE + 3]); unsigned b0_ = att::cvtpk(PP[BASE + 4], PP[BASE + 5]), b1_ = att::cvtpk(PP[BASE + 6], PP[BASE + 7]); \
    auto r0_ = __builtin_amdgcn_permlane32_swap(a0_, b0_, false, false); auto r1_ = __builtin_amdgcn_permlane32_swap(a1_, b1_, false, false); u32x4 w_ = {r0_[0], r1_[0], r0_[1], r1_[1]}; OUT = *reinterpret_cast<bf16x8*>(&w_); } while (0)
          SSDA_PK4(p0, 0, pa0); SSDA_PK4(p0, 8, pa1); SSDA_PK4(p1, 0, pa2); SSDA_PK4(p1, 8, pa3);
#undef SSDA_PK4
          { const int vbx = (int)(uintptr_t)(lds + L_VX + (hh * 2 + kt) * 8192) + att::v_rd_base(lane); pvT_one<0>(o[0], vbx, pa0, pa1, pa2, pa3); pvT_one<1>(o[1], vbx, pa0, pa1, pa2, pa3); } }
      bf16_t* Yr = (bf16_t*)(p.ws + WS_Y) + (R0 + qt * 32 + r32) * 256 + h * 64 + 8 * hi;
#pragma unroll
      for (int pt = 0; pt < 2; ++pt)
#pragma unroll
          for (int m = 0; m < 2; ++m) { const unsigned a0_ = pk2bf(o[pt][8 * m + 0], o[pt][8 * m + 1]), a1_ = pk2bf(o[pt][8 * m + 2], o[pt][8 * m + 3]), b0_ = pk2bf(o[pt][8 * m + 4], o[pt][8 * m + 5]), b1_ = pk2bf(o[pt][8 * m + 6], o[pt][8 * m + 7]);
              auto r0_ = __builtin_amdgcn_permlane32_swap(a0_, b0_, false, false); auto r1_ = __builtin_amdgcn_permlane32_swap(a1_, b1_, false, false);
              *(uint4*)(Yr + pt * 32 + 16 * m) = make_uint4(r0_[0], r1_[0], r0_[1], r1_[1]); } }
    if (hm < 0 || wid >= 4) { const int hh = hm < 0 ? wid >> 2 : hm, d = (wid >> 1) & 1, pt = wid & 1, h = 2 * g + hh; const float* wsv = vec + (hh * 2 + d) * 384 + 256;
      const int vx0 = (int)(uintptr_t)(lds + L_VX + (hh * 2 + 0) * 8192) + att::v_rd_base(lane), vx1 = vx0 + 8192;
      const int vb0 = (int)(uintptr_t)(lds + L_VB) + att::v_rd_base(lane), vb1 = vb0 + 16384;
      f32x16 acc[4] = {};
      if (pt == 0) { state_tile<0, 0>(acc, vx0, vb0, wsv, hi); state_tile<0, 1>(acc, vx1, vb1, wsv, hi); } else { state_tile<1, 0>(acc, vx0, vb0, wsv, hi); state_tile<1, 1>(acc, vx1, vb1, wsv, hi); }
      uint4* sp = (uint4*)((bf16_t*)(p.ws + WS_STATES) + (((size_t)(b * 34 + ch) * 2 + d) * 4 + h) * 8192) + pt * 512 + lane;
#pragma unroll
      for (int nt = 0; nt < 4; ++nt)
#pragma unroll
          for (int j = 0; j < 2; ++j) { const unsigned a0_ = pk2bf(acc[nt][j * 8 + 0], acc[nt][j * 8 + 1]), a1_ = pk2bf(acc[nt][j * 8 + 2], acc[nt][j * 8 + 3]), b0_ = pk2bf(acc[nt][j * 8 + 4], acc[nt][j * 8 + 5]), b1_ = pk2bf(acc[nt][j * 8 + 6], acc[nt][j * 8 + 7]);
              auto r0_ = __builtin_amdgcn_permlane32_swap(a0_, b0_, false, false); auto r1_ = __builtin_amdgcn_permlane32_swap(a1_, b1_, false, false);
              sp[(nt * 2 + j) * 64] = make_uint4(r0_[0], r1_[0], r0_[1], r1_[1]); } }
    __syncthreads();
}
#undef SSDA_PK
}

#define LAS __attribute__((address_space(3)))
#define XB_TMO      128
#define XB_XCNT(j)  (256  + 64 * (j))
#define XB_XSUB(j)  (1280 + 64 * (j))
#define XB_XGEN(j)  (2304 + 64 * (j))
#define XB_TOP      3328
#define XB_TOPGEN   3392
#define XCD_BAR_WORDS 3456
#define XB_SPIN_CAP (1u << 18)

__device__ __forceinline__ unsigned xb_ld(unsigned* p)              { return __hip_atomic_load(p, __ATOMIC_RELAXED, __HIP_MEMORY_SCOPE_AGENT); }
__device__ __forceinline__ unsigned xb_add(unsigned* p, unsigned v) { return __hip_atomic_fetch_add(p, v, __ATOMIC_RELAXED, __HIP_MEMORY_SCOPE_AGENT); }
__device__ __forceinline__ unsigned xb_xcc_id() { return (unsigned)__builtin_amdgcn_s_getreg((3 << 11) | 20) & 0xFu; }
#define XB_SPIN(cond, bar) do { unsigned _sp = 0; while (cond) { __builtin_amdgcn_s_sleep(1); \
    if ((++_sp & 255u) == 0u) { if (xb_ld(&(bar)[XB_TMO])) break; if (_sp > XB_SPIN_CAP) { atomicAdd(&(bar)[XB_TMO], 1u); break; } } } } while (0)

struct XcdBarrier {
    unsigned* bar; unsigned x;
    volatile LAS unsigned* st;
};

__device__ __forceinline__ XcdBarrier xcd_barrier_post(unsigned* bar, volatile LAS unsigned* st) {
    XcdBarrier b; b.bar = bar; b.x = xb_xcc_id(); b.st = st;
    if (threadIdx.x == 0) (void)xb_add(&bar[XB_XCNT(b.x)], 1u);
    return b;
}
__device__ __forceinline__ void xcd_barrier_complete(unsigned* bar, unsigned x, unsigned& nloc, unsigned& nx) {
    const unsigned G = gridDim.x * gridDim.y * gridDim.z;
    unsigned sum, cnt, mine, sp = 0u;
    for (;;) {
        sum = 0u; cnt = 0u; mine = 0u;
#pragma unroll
        for (unsigned j = 0; j < 16; ++j) { const unsigned c = xb_ld(&bar[XB_XCNT(j)]); sum += c; cnt += (c > 0u) ? 1u : 0u; mine = (j == x) ? c : mine; }
        if (sum == G) break;
        __builtin_amdgcn_s_sleep(1);
        if ((++sp & 255u) == 0u) { if (xb_ld(&bar[XB_TMO])) break; if (sp > XB_SPIN_CAP) { atomicAdd(&bar[XB_TMO], 1u); break; } }
    }
    nloc = mine > 0u ? mine : 1u; nx = cnt > 0u ? cnt : 1u;
}

__device__ __forceinline__ void xcd_barrier(const XcdBarrier& b) {
    asm volatile("s_waitcnt vmcnt(0)" ::: "memory");
    __syncthreads();
    if (threadIdx.x == 0) {
        unsigned* bar = b.bar;
        __builtin_amdgcn_s_waitcnt(0);
        unsigned nloc = b.st[0], nx = b.st[1];
        if (nloc == 0u) { xcd_barrier_complete(bar, b.x, nloc, nx); b.st[0] = nloc; b.st[1] = nx; }
        const unsigned old = xb_add(&bar[XB_XSUB(b.x)], 1u);
        const unsigned gen = old / nloc;
        if (old + 1u == (gen + 1u) * nloc) {
            __builtin_amdgcn_fence(__ATOMIC_RELEASE, "agent");
            asm volatile("s_waitcnt vmcnt(0)" ::: "memory");
            const unsigned og = xb_add(&bar[XB_TOP], 1u);
            const unsigned tg = og / nx;
            if (og + 1u == (tg + 1u) * nx) xb_add(&bar[XB_TOPGEN], 1u);
            else XB_SPIN(xb_ld(&bar[XB_TOPGEN]) == tg, bar);
            __builtin_amdgcn_fence(__ATOMIC_ACQUIRE, "agent");
            xb_add(&bar[XB_XGEN(b.x)], 1u);
            asm volatile("s_waitcnt vmcnt(0)" ::: "memory");
        } else {
            XB_SPIN(xb_ld(&bar[XB_XGEN(b.x)]) == gen, bar);
            __builtin_amdgcn_fence(__ATOMIC_ACQUIRE, "agent");
            asm volatile("s_waitcnt vmcnt(0)" ::: "memory");
        }
    }
    __syncthreads();
}


__device__ __forceinline__ void split_arrive(const XcdBarrier& b, unsigned* bar2, int slot = 2) {
    asm volatile("s_waitcnt vmcnt(0)" ::: "memory"); __syncthreads();
    if (threadIdx.x == 0) { __builtin_amdgcn_s_waitcnt(0); unsigned bx_ = b.x; asm volatile("" : "+s"(bx_));
        const unsigned nloc = b.st[0], nx = b.st[1]; const unsigned old = xb_add(&bar2[XB_XSUB(bx_)], 1u); const unsigned gen = old / nloc; b.st[slot] = gen;
        if (old + 1u == (gen + 1u) * nloc) { __builtin_amdgcn_fence(__ATOMIC_RELEASE, "agent"); asm volatile("s_waitcnt vmcnt(0)" ::: "memory");
            const unsigned og = xb_add(&bar2[XB_TOP], 1u); const unsigned tg = og / nx; if (og + 1u == (tg + 1u) * nx) xb_add(&bar2[XB_TOPGEN], 1u); } }
}
__device__ __forceinline__ void split_wait(const XcdBarrier& b, unsigned* bar2, int slot = 2) {
    if (threadIdx.x == 0) { const unsigned gen = b.st[slot]; XB_SPIN(xb_ld(&bar2[XB_TOPGEN]) <= gen, b.bar);
        __builtin_amdgcn_fence(__ATOMIC_ACQUIRE, "agent"); asm volatile("s_waitcnt vmcnt(0)" ::: "memory"); }
    __syncthreads();
}

#define REP_PREP 1
#define REP_ATTN 1
#define REP_SSDA 1
#define REP_SSDC 1
#define REP_GEMM_IN 1
#define BCW_X 8
#define BCW_Y 22
#define BCW_Z1 59
#define BCW_Z2 86
#define REP_NORM 1
#define EXTRA_SYNCS 0
constexpr int NTHREADS = 512, LDS_BYTES = 147456, HALF_LDS = 65536, LDS_CTL_OFF = 131072 + 256;
__global__ void __launch_bounds__(NTHREADS, 2) mega(P p) {
    extern __shared__ __attribute__((aligned(16))) char lds[];
    cg::grid_group grid = cg::this_grid();
    const int G = gridDim.x, bx = blockIdx.x;
    volatile LAS unsigned* bst = (volatile LAS unsigned*)((LAS unsigned char*)lds + LDS_CTL_OFF);
    if (threadIdx.x < 16) bst[threadIdx.x] = 0u;
    __syncthreads();
    XcdBarrier xbar = xcd_barrier_post((unsigned*)(p.ws + WS_CTL), bst);
#define GSYNC() do { XcdBarrier xb_ = xbar; size_t o_ = WS_CTL; asm volatile("" : "+s"(o_), "+s"(xb_.x)); xb_.bar = (unsigned*)(p.ws + o_); xcd_barrier(xb_); } while (0)
#define PHASE(n, call) do { const int half = tid512_fresh() >> 8; char* smem = lds + half * HALF_LDS; (void)smem; for (int vb = bx * 2 + half; vb < (n); vb += 2 * G) { call; __syncthreads(); } } while (0)
    weights_layer(p, lds, 0, bx, G);
    __syncthreads();
    mla_weight_frags(p, bx, G);
    for (int u = bx; u < 96; u += G) mod_unit(p, u, lds);
    PHASE(SEQ * 48 / 256, rope_body(p, vb));
    if (p.never) grid.sync();
    GSYNC();
    { const int t5 = tid512_fresh(); for (int r = bx * 8 + (t5 >> 6); r < MROWS; r += 2 * G * 8) norm_row2(p, 0, r, r + G * 8 < MROWS ? r + G * 8 : -1, t5 & 63); }
    GSYNC();
    for (int l = 0; l < DEPTH; ++l) {
        { pg8::Gemm g{(const bf16_t*)(p.ws + WS_H), (const bf16_t*)(p.ws + WS_WIN) + (size_t)l * 3328 * DM, MROWS, 3328, DM};
          EpiIn E{(bf16_t*)(p.ws + WS_TMP), (bf16_t*)(p.ws + WS_KEEP)};
          if (G == 256 && l > 0) { size_t o5_ = 65536; asm volatile("" : "+s"(o5_)); split_wait(xbar, (unsigned*)(p.ws + o5_), 5); }
#pragma unroll 1
          for (int pass = 0; pass < 3; ++pass) { InOrder S{G, bx, pass};
              if (pass == 1 && G == 256 && l > 0) { size_t o4_ = 49152; asm volatile("" : "+s"(o4_)); split_wait(xbar, (unsigned*)(p.ws + o4_), 4); }
              pg8::gemm_phase<EpiIn, InOrder, true, true>((PG8_LAS unsigned char*)lds, g, S, E);
              if (pass == 1) { size_t o6_ = 98304; asm volatile("" : "+s"(o6_)); split_arrive(xbar, (unsigned*)(p.ws + o6_), 6); } }
          { size_t o6_ = 98304; asm volatile("" : "+s"(o6_)); split_wait(xbar, (unsigned*)(p.ws + o6_), 6); } }
        { int u2 = 1 << 20, cv0 = 1 << 20, cvs = 1 << 20, ck0 = 0, ck1 = 0, cks = 1;
          if (G == 256) {
              constexpr int B1 = (132 * BCW_X) >> 3, B2 = B1 + ((16 * BCW_Y) >> 3), B3 = B2 + ((72 * BCW_Z1) >> 3);
              if (bx < 132) { const int i = bx; if (bx < 16 || bx >= 64) cv0 = bx; ck0 = (i * BCW_X) >> 3; ck1 = ((i + 1) * BCW_X) >> 3; }
              else if (bx < 148) { const int i = bx - 132; u2 = 256 + i; if (i < 12) cv0 = 52 + i; ck0 = B1 + ((i * BCW_Y) >> 3); ck1 = B1 + (((i + 1) * BCW_Y) >> 3); }
              else if (bx < 220) { const int i = bx - 148; cv0 = 132 + i; ck0 = B2 + ((i * BCW_Z1) >> 3); ck1 = B2 + (((i + 1) * BCW_Z1) >> 3); }
              else { const int i = bx - 220; cv0 = 16 + i; ck0 = B3 + ((i * BCW_Z2) >> 3); ck1 = bx == 255 ? MROWS / 16 : B3 + (((i + 1) * BCW_Z2) >> 3); }
              if (ck1 > MROWS / 16) ck1 = MROWS / 16; if (ck0 > ck1) ck0 = ck1;
          } else { u2 = bx + G; cv0 = bx; cvs = G; ck0 = bx; ck1 = MROWS / 16; cks = G; }
          for (int u = bx; u < MROWS / 64; u = (G == 256 ? (u < 256 ? u2 : 1 << 20) : u + G)) prep::unit(p, l, u, lds);
          { size_t o7_ = 114688; asm volatile("" : "+s"(o7_)); split_arrive(xbar, (unsigned*)(p.ws + o7_), 7); }
          prep::conv_items(p, l, cv0, cvs); prep::bc_rows(p, l, ck0, ck1, cks);
          { size_t o8_ = 131072; asm volatile("" : "+s"(o8_)); split_arrive(xbar, (unsigned*)(p.ws + o8_), 8); } }
        { size_t o2_ = 16384; asm volatile("" : "+s"(o2_)); unsigned* bar2 = (unsigned*)(p.ws + o2_);
          { size_t o7_ = 114688; asm volatile("" : "+s"(o7_)); split_wait(xbar, (unsigned*)(p.ws + o7_), 7); }
          attn_phase(p, l, lds, bx, G, l < DEPTH - 1, 0);
          { size_t o8_ = 131072; asm volatile("" : "+s"(o8_)); split_wait(xbar, (unsigned*)(p.ws + o8_), 8); }
          for (int u = bx, hm = -1; u < NB * 34 * 2; ) { ssda::unit(p, l, u, hm, lds);
              if (G == 256) { if (u < 256 && bx >= 16 && bx < 48) { u = 256 + ((bx - 16) >> 1); hm = (bx - 16) & 1; } else u = 1 << 20; } else u += G; }
          split_arrive(xbar, bar2);
          attn_phase(p, l, lds, bx, G, l < DEPTH - 1, 1);
          split_wait(xbar, bar2);
          for (int idx = bx * NTHREADS + tid512_fresh(); idx < NB * 2 * 4 * 4096; idx += G * NTHREADS) ssd_chunk_scan_body(p, idx);
          split_arrive(xbar, bar2);
          attn_phase(p, l, lds, bx, G, l < DEPTH - 1, 2);
          split_wait(xbar, bar2);
          for (int u = bx; u < MROWS / 64; u = (G == 256 ? ((u < 256 && bx >= 48 && bx < 64) ? 256 + bx - 48 : 1 << 20) : u + G)) ssdc::unit(p, l, u, lds);
          if (l + 1 < DEPTH) { int wgi = bx, nwg = G; if (G == 256) { wgi = (bx >= 112 && bx < 160) ? bx - 112 : bx < 16 ? 48 + bx : bx >= 160 ? 64 + bx - 160 : bx >= 64 ? 160 + bx - 64 : 1 << 20; nwg = 208; }
              weights_layer(p, lds, l + 1, wgi, nwg);
              __syncthreads();
              for (int u = (G == 256 ? bx - 160 : bx); u >= 0 && u < 96; u += G) mod_unit(p, 96 * (l + 1) + u, lds); } }
        GSYNC();
        { pg8::Gemm g{(const bf16_t*)(p.ws + WS_H), (const bf16_t*)(p.ws + WS_WOUT) + (size_t)l * DM * DM, MROWS, DM, DM};
          EpiOut E{l == 0 ? p.x : (const float*)p.out, l == 0 ? p.ctx : (const float*)(p.ws + WS_XC), p.out, (float*)(p.ws + WS_XC), (const float*)(p.ws + WS_MOD) + (size_t)l * 5 * 3072};
          if (l == DEPTH - 1) { LatentOrder SL{G, bx}; pg8::gemm_phase<EpiOut, LatentOrder, true, true>((PG8_LAS unsigned char*)lds, g, SL, E); GSYNC(); }
          else if (G != 256) { pg8::StaticOrder S; S.init(MROWS, DM, G, bx); pg8::gemm_phase<EpiOut, pg8::StaticOrder, true, true>((PG8_LAS unsigned char*)lds, g, S, E); GSYNC();
              for (int r = bx * 8 + (tid512_fresh() >> 6); r < MROWS; r += G * 8) norm_row(p, l + 1, r, tid512_fresh() & 63);
              GSYNC(); }
          else {
              size_t o3_ = 32768, o4_ = 49152, o5_ = 65536, oc_ = 81920 + (size_t)l * 256; asm volatile("" : "+s"(o3_), "+s"(o4_), "+s"(o5_), "+s"(oc_));
              unsigned* bar3 = (unsigned*)(p.ws + o3_); unsigned* bar4 = (unsigned*)(p.ws + o4_); unsigned* bar5 = (unsigned*)(p.ws + o5_); unsigned* cnt16 = (unsigned*)(p.ws + oc_);
              { LatentOrder SL{G, bx}; pg8::gemm_phase<EpiOut, LatentOrder, true, true>((PG8_LAS unsigned char*)lds, g, SL, E); }
              split_arrive(xbar, bar3, 3);
              if (bx < 16) split_arrive(xbar, bar5, 5);
              if (bx < 16) {
                  { CtxOrder SC{G, bx}; pg8::gemm_phase<EpiOut, CtxOrder, true, true>((PG8_LAS unsigned char*)lds, g, SC, E); }
                  asm volatile("s_waitcnt vmcnt(0)" ::: "memory"); __syncthreads();
                  if (threadIdx.x == 0) { __builtin_amdgcn_fence(__ATOMIC_RELEASE, "agent"); asm volatile("s_waitcnt vmcnt(0)" ::: "memory"); (void)xb_add(cnt16, 1u);
                      unsigned sp_ = 0; while (xb_ld(cnt16) < 16u && ++sp_ < (1u << 22)) __builtin_amdgcn_s_sleep(2);
                      __builtin_amdgcn_fence(__ATOMIC_ACQUIRE, "agent"); asm volatile("s_waitcnt vmcnt(0)" ::: "memory"); }
                  __syncthreads();
                  { const int t5 = tid512_fresh(); for (int rc = bx * 8 + (t5 >> 6); rc < NB * CTX; rc += 2 * 128) { const int r2 = rc + 128;
                      norm_row2(p, l + 1, (rc >> 8) * SPB + (rc & 255), r2 < NB * CTX ? (r2 >> 8) * SPB + (r2 & 255) : -1, t5 & 63); } } }
              split_arrive(xbar, bar4, 4);
              if (bx >= 16) { split_wait(xbar, bar3, 3);
                  const int t5 = tid512_fresh(); for (int rl = (bx - 16) * 8 + (t5 >> 6); rl < NB * SEQ; rl += 2 * 240 * 8) { const int r2 = rl + 240 * 8;
                  norm_row2(p, l + 1, (rl >> 12) * SPB + CTX + (rl & 4095), r2 < NB * SEQ ? (r2 >> 12) * SPB + CTX + (r2 & 4095) : -1, t5 & 63); }
                  split_arrive(xbar, bar5, 5); } } }
    }
    PHASE(NB * SEQ / 4, final_norm_body(p, vb));
#undef PHASE
}

extern "C" void kernel_launch(void* const* d_in, const int* in_sizes, int n_in, void* d_out, int out_size, void* d_ws, size_t ws_size, hipStream_t stream) {
    if (n_in != 23 || ws_size < WS_END) { fprintf(stderr, "kernel_launch: unexpected n_in %d / ws_size %zu\n", n_in, ws_size); return; }
    static int grid_blocks = 0;
    if (!grid_blocks) {
        int dev = 0, cus = 0, per_cu = 0;
        (void)hipGetDevice(&dev); (void)hipDeviceGetAttribute(&cus, hipDeviceAttributeMultiprocessorCount, dev);
        if (hipFuncSetAttribute((const void*)mega, hipFuncAttributeMaxDynamicSharedMemorySize, LDS_BYTES) != hipSuccess) fprintf(stderr, "kernel_launch: hipFuncSetAttribute failed\n");
        if (hipOccupancyMaxActiveBlocksPerMultiprocessor(&per_cu, mega, NTHREADS, LDS_BYTES) != hipSuccess || per_cu < 1) { fprintf(stderr, "kernel_launch: occupancy query says %d\n", per_cu); per_cu = 1; }
        grid_blocks = cus * per_cu;
    }
    P p{};
    const float** f = (const float**)&p;
    for (int i = 0; i < 23; ++i) f[i] = (const float*)d_in[i];
    p.out = (float*)d_out; p.ws = (unsigned char*)d_ws;
    (void)hipMemsetAsync(d_ws, 0, 131072 + 16384, stream);
    void* args[] = {&p};
    hipError_t e = hipLaunchCooperativeKernel((void*)mega, dim3(grid_blocks), dim3(NTHREADS), args, LDS_BYTES, stream);
    if (e != hipSuccess) fprintf(stderr, "cooperative launch failed: %s (grid %d)\n", hipGetErrorString(e), grid_blocks);
}
```

```cpp
#include <hip/hip_runtime.h>
#include <hip/hip_cooperative_groups.h>
#include <hip/hip_bf16.h>
#include <stdint.h>
#include <stdio.h>
namespace cg = cooperative_groups;
#include <math.h>

#define SB() __builtin_amdgcn_sched_barrier(0)
__device__ __forceinline__ int tid512_fresh() { int t = (int)threadIdx.x; asm volatile("" : "+v"(t)); return t; }
__device__ __forceinline__ int tid_fresh() { int t = (int)(threadIdx.x & 255u); asm volatile("" : "+v"(t)); return t; }
#define TIDX tidl
#define HAND_A 1
#define HAND_B 1
typedef unsigned short bf16_t;
__device__ __forceinline__ float bf2f(bf16_t v) { return __uint_as_float(((unsigned)v) << 16); }
__device__ __forceinline__ bf16_t f2bf(float f) { unsigned u = __float_as_uint(f); return (bf16_t)((u + 0x7fffu + ((u >> 16) & 1u)) >> 16); }
typedef float pk_f32x2_t __attribute__((ext_vector_type(2))); typedef __bf16 pk_bf16x2_t __attribute__((ext_vector_type(2)));
__device__ __forceinline__ unsigned pk2bf(float lo, float hi) { const pk_f32x2_t v = {lo, hi}; const pk_bf16x2_t b = __builtin_convertvector(v, pk_bf16x2_t); return __builtin_bit_cast(unsigned, b); }
__device__ __forceinline__ float silu_f(float v) { return v * __builtin_amdgcn_rcpf(1.f + __expf(-v)); }

constexpr int DM = 1024, NB = 4, SEQ = 4096, CTX = 256, SPB = CTX + SEQ  , MROWS = NB * SPB  ;
constexpr int DEPTH = 4, GRIDW = 64;
constexpr int IN_COLS = 3240;
constexpr int NTMP = 1280, NKEEP = 2048;
constexpr float EPS = 1e-6f;
constexpr float LOG2E = 1.4426950408889634f;
constexpr int T_CQ = 0, T_CKV = 256, T_KR = 384, T_DT = 416, T_XBC = 512;
constexpr int K_GA = 0, K_BQ = 256, K_BK = 512, K_BV = 640, K_BG = 768, K_CQ = 1024, K_CK = 1280, K_CV = 1408, K_CG = 1536, K_Z = 1792;

constexpr size_t MiB = 1u << 20;
constexpr size_t WS_CTL = 0;
constexpr size_t WS_MOD = 1 * MiB;
constexpr size_t WS_ATOT = 1 * MiB + 256 * 1024;
constexpr size_t WS_ACUM = 256 * 1024;
constexpr size_t WS_ROPE64 = 2 * MiB;
constexpr size_t WS_ROPE32 = 3 * MiB;
constexpr size_t WS_DT = 4 * MiB;
constexpr size_t WS_XC = 5 * MiB;
constexpr size_t WS_H = 9 * MiB;
constexpr size_t WS_TMP = 43 * MiB;
constexpr size_t WS_STATES = WS_TMP;
constexpr size_t WS_Y = WS_TMP + (size_t)NB * 34 * 2 * 4 * 64 * 128 * 4;
constexpr size_t WS_KEEP = 86 * MiB;
constexpr size_t WS_QA = 154 * MiB;
constexpr size_t WS_KA = 167 * MiB;
constexpr size_t WS_VA = 180 * MiB;
constexpr size_t WS_U = 189 * MiB;
constexpr size_t WS_WIN = 215 * MiB;
constexpr size_t WS_WOUT = 241 * MiB;
constexpr size_t WS_WQ = 249 * MiB;
constexpr size_t WS_WKV = 250 * MiB;
constexpr size_t WS_END = 251 * MiB;

struct P {
    const float *x, *c, *ctx, *c_ctx, *norm_w, *w_mod, *b_mod, *w_in, *mla_q_norm, *mla_kv_norm, *w_q_up, *w_kv_up, *gqa_q_norm, *gqa_k_norm,
        *swa_sink, *conv_w, *conv_b, *a_log, *dt_bias, *ssd_d, *ssd_norm_w, *w_out, *final_norm_w;
    float* out; unsigned char* ws;
    int never, pad;
};


__device__ __forceinline__ void mod_unit(const P& p, int u, char* lds) {
    const int tid = tid512_fresh(), col = tid & 31, kg = tid >> 5; const int l = u / 96, j = (u % 96) * 32 + col;
    float* red = (float*)lds;
    float* sc = (float*)(lds + 16384);
    const float* w = p.w_mod + (size_t)l * DM * 3072 + (size_t)kg * 64 * 3072 + j;
    float wv[64];
#pragma unroll
    for (int k = 0; k < 64; ++k) wv[k] = w[(size_t)k * 3072];
    SB();
#pragma unroll
    for (int i = 0; i < 2; ++i) { const int kk = tid + 512 * i;
#pragma unroll
        for (int r = 0; r < 4; ++r) sc[kk * 5 + r] = silu_f(p.c[r * DM + kk]);
        sc[kk * 5 + 4] = silu_f(p.c_ctx[kk]); }
    __syncthreads();
    float acc[5] = {0.f, 0.f, 0.f, 0.f, 0.f};
#pragma unroll
    for (int k = 0; k < 64; ++k) { const float* s5 = sc + (kg * 64 + k) * 5;
#pragma unroll
        for (int r = 0; r < 5; ++r) acc[r] += s5[r] * wv[k]; }
#pragma unroll
    for (int r = 0; r < 5; ++r) red[(kg * 5 + r) * 32 + col] = acc[r];
    __syncthreads();
    if (tid < 160) { const int r = tid >> 5, c = tid & 31; float s = p.b_mod[l * 3072 + (u % 96) * 32 + c];
#pragma unroll
        for (int g = 0; g < 16; ++g) s += red[(g * 5 + r) * 32 + c];
        ((float*)(p.ws + WS_MOD))[((size_t)l * 5 + r) * 3072 + (u % 96) * 32 + c] = s; }
    __syncthreads();
}

__device__ __forceinline__ void sincos_acc(float ang, float& c, float& s) {
    const double x = (double)ang; const double jd = rint(x * 0.63661977236758134308); const int j = (int)jd;
    const float y = (float)(x - jd * 1.57079632679489661923); const float z = y * y;
    const float sn = y + y * z * (-1.6666654611e-1f + z * (8.3321608736e-3f + z * (-1.9515295891e-4f)));
    const float cs = 1.f - 0.5f * z + z * z * (4.166664568298827e-2f + z * (-1.388731625493765e-3f + z * 2.443315711809948e-5f));
    switch (j & 3) { case 0: c = cs; s = sn; break; case 1: c = -sn; s = cs; break; case 2: c = -cs; s = -sn; break; default: c = sn; s = -cs; break; }
}
__device__ __forceinline__ void rope_body(const P& p, int vb) {
    const int tidl = tid_fresh();
    const int idx = vb * 256 + TIDX;
    if (idx >= SEQ * 48) return;
    const int t = idx / 48, i = idx % 48; const float row = (float)(t / GRIDW), col = (float)(t % GRIDW);
    if (i < 32) { const int f = i & 15; const float invf = powf(10000.f, -(float)f / 16.f); const float ang = (i < 16 ? row : col) * invf; float c, s; sincos_acc(ang, c, s);
        float* o = (float*)(p.ws + WS_ROPE64) + ((size_t)t * 32 + i) * 2; o[0] = c; o[1] = s; }
    else { const int ii = i - 32, f = ii & 7; const float invf = powf(10000.f, -(float)f / 8.f); const float ang = (ii < 8 ? row : col) * invf; float c, s; sincos_acc(ang, c, s);
        float* o = (float*)(p.ws + WS_ROPE32) + ((size_t)t * 16 + ii) * 2; o[0] = c; o[1] = s; }
}

__device__ __forceinline__ const float* xrow_in(const P& p, int layer, int r) {
    const int b = r / SPB, s = r % SPB;
    if (s < CTX) return (layer == 0 ? p.ctx : (const float*)(p.ws + WS_XC)) + ((size_t)b * CTX + s) * DM;
    return (layer == 0 ? p.x : (const float*)p.out) + ((size_t)b * SEQ + (s - CTX)) * DM;
}
__device__ __forceinline__ float* xrow_out(const P& p, int r) {
    const int b = r / SPB, s = r % SPB;
    if (s < CTX) return (float*)(p.ws + WS_XC) + ((size_t)b * CTX + s) * DM;
    return p.out + ((size_t)b * SEQ + (s - CTX)) * DM;
}
__device__ __forceinline__ float wave_sum(float v) {
#pragma unroll
    for (int o = 1; o < 64; o <<= 1) v += __shfl_xor(v, o);
    return v;
}

__device__ __forceinline__ void norm_body(const P& p, int layer, int vb) {
    const int tidl = tid_fresh();
    const int r = vb * 4 + (TIDX >> 6), lane = TIDX & 63;
    const float* xr = xrow_in(p, layer, r); const int b = r / SPB, s = r % SPB; const int mr = s < CTX ? 4 : b;
    const float* mod = (const float*)(p.ws + WS_MOD) + ((size_t)layer * 5 + mr) * 3072; const float* nw = p.norm_w + layer * DM;
    float v[16]; float ss = 0.f;
#pragma unroll
    for (int j = 0; j < 4; ++j) { const float4 t = *(const float4*)(xr + j * 256 + lane * 4); v[4 * j] = t.x; v[4 * j + 1] = t.y; v[4 * j + 2] = t.z; v[4 * j + 3] = t.w; ss += t.x * t.x + t.y * t.y + t.z * t.z + t.w * t.w; }
    const float rstd = rsqrtf(wave_sum(ss) * (1.f / DM) + EPS);
    bf16_t* h = (bf16_t*)(p.ws + WS_H) + (size_t)r * DM;
#pragma unroll
    for (int j = 0; j < 4; ++j)
#pragma unroll
        for (int e = 0; e < 4; ++e) { const int col = j * 256 + lane * 4 + e; h[col] = f2bf(v[4 * j + e] * rstd * nw[col] * (1.f + mod[1024 + col]) + mod[col]); }
}

__device__ __forceinline__ void norm_row2(const P& p, int layer, int R0, int R1, int lane) {
    const bool two = R1 >= 0; const int Rb = two ? R1 : R0;
    const float* xa = xrow_in(p, layer, R0); const float* xb = xrow_in(p, layer, Rb);
    float4 va[4], vb[4];
#pragma unroll
    for (int j = 0; j < 4; ++j) { va[j] = *(const float4*)(xa + j * 256 + lane * 4); vb[j] = *(const float4*)(xb + j * 256 + lane * 4); }
    SB();
    float sa = 0.f, sb = 0.f;
#pragma unroll
    for (int j = 0; j < 4; ++j) { sa += va[j].x * va[j].x + va[j].y * va[j].y + va[j].z * va[j].z + va[j].w * va[j].w; sb += vb[j].x * vb[j].x + vb[j].y * vb[j].y + vb[j].z * vb[j].z + vb[j].w * vb[j].w; }
#pragma unroll
    for (int o = 1; o < 64; o <<= 1) { sa += __shfl_xor(sa, o); sb += __shfl_xor(sb, o); }
    const float ra = rsqrtf(sa * (1.f / DM) + EPS), rb = rsqrtf(sb * (1.f / DM) + EPS); const float* nw = p.norm_w + layer * DM;
#pragma unroll
    for (int q = 0; q < 2; ++q) { if (q == 1 && !two) break; const int R = q == 0 ? R0 : R1; const float rstd = q == 0 ? ra : rb; const int b = R / SPB, s = R % SPB; const int mr = s < CTX ? 4 : b;
        const float* mod = (const float*)(p.ws + WS_MOD) + ((size_t)layer * 5 + mr) * 3072; bf16_t* h = (bf16_t*)(p.ws + WS_H) + (size_t)R * DM;
#pragma unroll
        for (int j = 0; j < 4; ++j) { const float4 v = q == 0 ? va[j] : vb[j]; const int col = j * 256 + lane * 4; const float4 w = *(const float4*)(nw + col), sc = *(const float4*)(mod + 1024 + col), sh = *(const float4*)(mod + col);
            uint2 o; o.x = pk2bf(v.x * rstd * w.x * (1.f + sc.x) + sh.x, v.y * rstd * w.y * (1.f + sc.y) + sh.y);
            o.y = pk2bf(v.z * rstd * w.z * (1.f + sc.z) + sh.z, v.w * rstd * w.w * (1.f + sc.w) + sh.w);
            *(uint2*)(h + col) = o; } }
}
__device__ __forceinline__ void norm_row(const P& p, int layer, int R, int lane) {
    const float* xr = xrow_in(p, layer, R); const int b = R / SPB, s = R % SPB; const int mr = s < CTX ? 4 : b;
    const float* mod = (const float*)(p.ws + WS_MOD) + ((size_t)layer * 5 + mr) * 3072; const float* nw = p.norm_w + layer * DM;
    float4 v[4]; float ss = 0.f;
#pragma unroll
    for (int j = 0; j < 4; ++j) { v[j] = *(const float4*)(xr + j * 256 + lane * 4); ss += v[j].x * v[j].x + v[j].y * v[j].y + v[j].z * v[j].z + v[j].w * v[j].w; }
    const float rstd = rsqrtf(wave_sum(ss) * (1.f / DM) + EPS);
    bf16_t* h = (bf16_t*)(p.ws + WS_H) + (size_t)R * DM;
#pragma unroll
    for (int j = 0; j < 4; ++j) { const int col = j * 256 + lane * 4; const float4 w = *(const float4*)(nw + col), sc = *(const float4*)(mod + 1024 + col), sh = *(const float4*)(mod + col);
        uint2 o; o.x = pk2bf(v[j].x * rstd * w.x * (1.f + sc.x) + sh.x, v[j].y * rstd * w.y * (1.f + sc.y) + sh.y);
        o.y = pk2bf(v[j].z * rstd * w.z * (1.f + sc.z) + sh.z, v[j].w * rstd * w.w * (1.f + sc.w) + sh.w);
        *(uint2*)(h + col) = o; }
}
__device__ __forceinline__ int in_col_map(int n) {
    if (n < 416) return n; if (n < 424) return 3232 + (n - 416); if (n < 512) return -1; if (n < 1280) return 2464 + (n - 512); return 416 + (n - 1280);
}
template <int MODE> __device__ __forceinline__ void gemm_body(const P& p, int layer, int vb, char* smem) {
    const int tidl = tid_fresh();
    float (*As)[65] = (float (*)[65])smem; float (*Ws)[65] = (float (*)[65])(smem + 16 * 65 * 4);
    constexpr int NBX = MODE == 0 ? 3328 / 64 : DM / 64;
    const int tid = TIDX, tx = tid & 15, ty = tid >> 4; const int m0 = (vb / NBX) * 64, n0 = (vb % NBX) * 64;
    const bf16_t* A = (const bf16_t*)(p.ws + WS_H); const int ldw = MODE == 0 ? IN_COLS : DM;
    const float* W = MODE == 0 ? p.w_in + (size_t)layer * DM * IN_COLS : p.w_out + (size_t)layer * DM * DM;
    float acc[4][4] = {};
    const int lr = tid >> 2, lk = (tid & 3) * 4;
    const int wk = tid >> 4, wn = (tid & 15) * 4;
    int wc[4];
#pragma unroll
    for (int e = 0; e < 4; ++e) wc[e] = MODE == 0 ? in_col_map(n0 + wn + e) : n0 + wn + e;
    for (int k0 = 0; k0 < DM; k0 += 16) {
        const uint2 av = *(const uint2*)(A + (size_t)(m0 + lr) * DM + k0 + lk);
        As[lk][lr] = __uint_as_float(av.x << 16); As[lk + 1][lr] = __uint_as_float(av.x & 0xffff0000u); As[lk + 2][lr] = __uint_as_float(av.y << 16); As[lk + 3][lr] = __uint_as_float(av.y & 0xffff0000u);
#pragma unroll
        for (int e = 0; e < 4; ++e) Ws[wk][wn + e] = wc[e] >= 0 ? W[(size_t)(k0 + wk) * ldw + wc[e]] : 0.f;
        __syncthreads();
#pragma unroll
        for (int k = 0; k < 16; ++k) { float a[4], w[4];
#pragma unroll
            for (int i = 0; i < 4; ++i) { a[i] = As[k][ty * 4 + i]; w[i] = Ws[k][tx * 4 + i]; }
#pragma unroll
            for (int i = 0; i < 4; ++i)
#pragma unroll
                for (int j = 0; j < 4; ++j) acc[i][j] += a[i] * w[j]; }
        __syncthreads();
    }
#pragma unroll
    for (int i = 0; i < 4; ++i) { const int r = m0 + ty * 4 + i;
        if (MODE == 0) {
#pragma unroll
            for (int j = 0; j < 4; ++j) { const int n = n0 + tx * 4 + j;
                if (n < NTMP) ((bf16_t*)(p.ws + WS_TMP))[(size_t)r * NTMP + n] = f2bf(acc[i][j]); else ((bf16_t*)(p.ws + WS_KEEP))[(size_t)r * NKEEP + (n - NTMP)] = f2bf(acc[i][j]); }
        } else {
            const int b = r / SPB, s = r % SPB; const int mr = s < CTX ? 4 : b; const float* gate = (const float*)(p.ws + WS_MOD) + ((size_t)layer * 5 + mr) * 3072 + 2048;
            const float* xi = xrow_in(p, layer, r); float* xo = xrow_out(p, r);
#pragma unroll
            for (int j = 0; j < 4; ++j) { const int n = n0 + tx * 4 + j; xo[n] = xi[n] + gate[n] * acc[i][j]; }
        }
    }
}

__device__ __forceinline__ void prep_mla_body(const P& p, int layer, int vb, char* smem) {
    const int tidl = tid_fresh();
    float (*sq)[256] = (float (*)[256])smem; float (*skv)[128] = (float (*)[128])(smem + 8192); float (*oq)[384] = (float (*)[384])(smem + 12288);
    float (*okv)[512] = (float (*)[512])(smem + 24576); float (*skr)[32] = (float (*)[32])(smem + 40960);
    const int tid = TIDX, r0 = vb * 8; const bf16_t* tmp = (const bf16_t*)(p.ws + WS_TMP);
    const float* qn = p.mla_q_norm + layer * 256; const float* kvn = p.mla_kv_norm + layer * 128;
    { const int rr = tid >> 5, l32 = tid & 31; const bf16_t* row = tmp + (size_t)(r0 + rr) * NTMP;
        float v[8], ss = 0.f;
#pragma unroll
        for (int j = 0; j < 8; ++j) { v[j] = bf2f(row[T_CQ + l32 + 32 * j]); ss += v[j] * v[j]; }
#pragma unroll
        for (int o = 1; o < 32; o <<= 1) ss += __shfl_xor(ss, o);
        const float rs = rsqrtf(ss * (1.f / 256.f) + EPS);
#pragma unroll
        for (int j = 0; j < 8; ++j) sq[rr][l32 + 32 * j] = v[j] * rs * qn[l32 + 32 * j];
        float w[4], s2 = 0.f;
#pragma unroll
        for (int j = 0; j < 4; ++j) { w[j] = bf2f(row[T_CKV + l32 + 32 * j]); s2 += w[j] * w[j]; }
#pragma unroll
        for (int o = 1; o < 32; o <<= 1) s2 += __shfl_xor(s2, o);
        const float rs2 = rsqrtf(s2 * (1.f / 128.f) + EPS);
#pragma unroll
        for (int j = 0; j < 4; ++j) skv[rr][l32 + 32 * j] = w[j] * rs2 * kvn[l32 + 32 * j];
        skr[rr][l32] = bf2f(row[T_KR + l32]);
    }
    __syncthreads();
    const float* wq = p.w_q_up + (size_t)layer * 256 * 384; const float* wkv = p.w_kv_up + (size_t)layer * 128 * 512;
    for (int col = tid; col < 384; col += 256) { float acc[8] = {};
        for (int k = 0; k < 256; ++k) { const float w = wq[k * 384 + col];
#pragma unroll
            for (int r = 0; r < 8; ++r) acc[r] += sq[r][k] * w; }
#pragma unroll
        for (int r = 0; r < 8; ++r) oq[r][col] = acc[r]; }
    for (int col = tid; col < 512; col += 256) { float acc[8] = {};
        for (int k = 0; k < 128; ++k) { const float w = wkv[k * 512 + col];
#pragma unroll
            for (int r = 0; r < 8; ++r) acc[r] += skv[r][k] * w; }
#pragma unroll
        for (int r = 0; r < 8; ++r) okv[r][col] = acc[r]; }
    __syncthreads();
    bf16_t* QA = (bf16_t*)(p.ws + WS_QA); bf16_t* KA = (bf16_t*)(p.ws + WS_KA); bf16_t* VA = (bf16_t*)(p.ws + WS_VA);
    const float qscale = LOG2E / sqrtf(96.f);
    for (int i = tid; i < 8 * 384; i += 256) { const int rr = i / 384, col = i % 384, h = col / 96, d = col % 96; const int r = r0 + rr, s = r % SPB;
        float v = oq[rr][col];
        if (d >= 64 && s >= CTX) { const int t = s - CTX, e = d - 64, ii = e & 15; const float* cs = (const float*)(p.ws + WS_ROPE32) + ((size_t)t * 16 + ii) * 2;
            const float x1 = oq[rr][h * 96 + 64 + ii], x2 = oq[rr][h * 96 + 80 + ii]; v = e < 16 ? x1 * cs[0] - x2 * cs[1] : x1 * cs[1] + x2 * cs[0]; }
        QA[(size_t)r * 384 + col] = f2bf(v * qscale);
        float kv;
        if (d < 64) kv = okv[rr][h * 128 + d];
        else { const int e = d - 64, ii = e & 15; const float x1 = skr[rr][ii], x2 = skr[rr][16 + ii];
            if (s >= CTX) { const int t = s - CTX; const float* cs = (const float*)(p.ws + WS_ROPE32) + ((size_t)t * 16 + ii) * 2; kv = e < 16 ? x1 * cs[0] - x2 * cs[1] : x1 * cs[1] + x2 * cs[0]; }
            else kv = skr[rr][e]; }
        KA[(size_t)r * 384 + col] = f2bf(kv);
    }
    for (int i = tid; i < 8 * 256; i += 256) { const int rr = i / 256, col = i % 256, h = col / 64, d = col % 64; VA[(size_t)(r0 + rr) * 256 + col] = f2bf(okv[rr][h * 128 + 64 + d]); }
}

__device__ __forceinline__ void prep_bc_body(const P& p, int layer, int vb) {
    const int tidl = tid_fresh();
    const int r = vb * 4 + (TIDX >> 6), lane = TIDX & 63, half = lane >> 5, i = lane & 31;
    const int s = r % SPB; const bool lat = s >= CTX; const int t = s - CTX;
    bf16_t* row = (bf16_t*)(p.ws + WS_KEEP) + (size_t)r * NKEEP;
    float cs0 = 1.f, sn0 = 0.f; if (lat) { const float* cs = (const float*)(p.ws + WS_ROPE64) + ((size_t)t * 32 + i) * 2; cs0 = cs[0]; sn0 = cs[1]; }
    const float qscale = 0.125f * LOG2E;
#pragma unroll
    for (int it = 0; it < 6; ++it) { const int hv = it * 2 + half; int off; bool isq, nrm; const float* nw = nullptr;
        if (hv < 4) { off = K_BQ + hv * 64; isq = true; nrm = true; nw = p.gqa_q_norm + layer * 64; }
        else if (hv < 6) { off = K_BK + (hv - 4) * 64; isq = false; nrm = true; nw = p.gqa_k_norm + layer * 64; }
        else if (hv < 10) { off = K_CQ + (hv - 6) * 64; isq = true; nrm = false; }
        else { off = K_CK + (hv - 10) * 64; isq = false; nrm = false; }
        float x1 = bf2f(row[off + i]), x2 = bf2f(row[off + 32 + i]);
        if (nrm) { float ss = x1 * x1 + x2 * x2;
#pragma unroll
            for (int o = 1; o < 32; o <<= 1) ss += __shfl_xor(ss, o);
            const float rs = rsqrtf(ss * (1.f / 64.f) + EPS); x1 = x1 * rs * nw[i]; x2 = x2 * rs * nw[32 + i]; }
        float y1 = x1 * cs0 - x2 * sn0, y2 = x1 * sn0 + x2 * cs0;
        if (isq) { y1 *= qscale; y2 *= qscale; }
        row[off + i] = f2bf(y1); row[off + 32 + i] = f2bf(y2);
    }
}

__device__ __forceinline__ void prep_d_body(const P& p, int layer, int vb) {
    const int tidl = tid_fresh();
    const int r = vb, tid = TIDX; const int s = r % SPB; const bool lat = s >= CTX; const int pos = lat ? s - CTX : s, len = lat ? SEQ : CTX;
    const bf16_t* tmp = (const bf16_t*)(p.ws + WS_TMP); bf16_t* U = (bf16_t*)(p.ws + WS_U) + (size_t)r * 768;
    const float* cw = p.conv_w + (size_t)layer * 5 * 768; const float* cb = p.conv_b + layer * 768;
    for (int c = tid; c < 768; c += 256) { float a = cb[c];
#pragma unroll
        for (int j = 0; j < 5; ++j) { const int pp = pos + j - 2; if (pp >= 0 && pp < len) a += cw[j * 768 + c] * bf2f(tmp[(size_t)(r + j - 2) * NTMP + T_XBC + c]); }
        U[c] = f2bf(silu_f(a)); }
    if (tid < 8) { const float v = bf2f(tmp[(size_t)r * NTMP + T_DT + tid]) + p.dt_bias[layer * 8 + tid]; const float sp = v > 20.f ? v : log1pf(__expf(v)); ((float*)(p.ws + WS_DT))[(size_t)r * 8 + tid] = sp; }
}

template <int GROUP> __device__ __forceinline__ void attn_body(const P& p, int layer, int qkind, int vb, char* smem) {
    const int tidl = tid_fresh();
    constexpr int DQ = GROUP == 0 ? 96 : 64, DV = 64;
    float (*Ks)[DQ] = (float (*)[DQ])smem; float (*Vs)[DV] = (float (*)[DV])(smem + 64 * DQ * 4);
    const int nqb = qkind == 0 ? 16 : 1;
    const int tid = TIDX, qb = vb % nqb, h = (vb / nqb) & 3, b = vb / (nqb * 4); const int kvh = GROUP == 0 ? h : h >> 1;
    const int srow = qkind == 0 ? CTX + qb * 256 + tid : tid;
    const size_t r = (size_t)b * SPB + srow;
    const bf16_t *Qp, *Kp, *Vp, *Gp; int ldq, ldk, ldv;
    if (GROUP == 0) { Qp = (const bf16_t*)(p.ws + WS_QA) + h * 96; ldq = 384; Kp = (const bf16_t*)(p.ws + WS_KA) + h * 96; ldk = 384; Vp = (const bf16_t*)(p.ws + WS_VA) + h * 64; ldv = 256; Gp = (const bf16_t*)(p.ws + WS_KEEP) + K_GA + h * 64; }
    else if (GROUP == 1) { const bf16_t* kp = (const bf16_t*)(p.ws + WS_KEEP); Qp = kp + K_BQ + h * 64; Kp = kp + K_BK + kvh * 64; Vp = kp + K_BV + kvh * 64; Gp = kp + K_BG + h * 64; ldq = ldk = ldv = NKEEP; }
    else { const bf16_t* kp = (const bf16_t*)(p.ws + WS_KEEP); Qp = kp + K_CQ + h * 64; Kp = kp + K_CK + kvh * 64; Vp = kp + K_CV + kvh * 64; Gp = kp + K_CG + h * 64; ldq = ldk = ldv = NKEEP; }
    unsigned qpk[DQ / 2];
#pragma unroll
    for (int d = 0; d < DQ / 2; ++d) qpk[d] = *(const unsigned*)(Qp + r * ldq + 2 * d);
    float o[DV];
#pragma unroll
    for (int d = 0; d < DV; ++d) o[d] = 0.f;
    float m = -INFINITY, l = 0.f;
    int k_lo = 0, k_hi = CTX;
    int w_lo = 0, w_hi = 0;
    if (qkind == 0) { if (GROUP == 2) { const int t0 = qb * 256; w_lo = CTX + t0 - 128; w_hi = w_lo + 512;   } else { w_lo = CTX; w_hi = SPB; } }
    const int tq = srow - CTX;
    for (int pass = 0; pass < 2; ++pass) {
        const int lo = pass == 0 ? k_lo : w_lo, hi = pass == 0 ? k_hi : w_hi;
        for (int kt = lo; kt < hi; kt += 64) {
            const bool in_range = kt >= (pass == 0 ? 0 : CTX) && kt < SPB;
            __syncthreads();
            if (in_range) {
                for (int i = tid; i < 64 * DQ; i += 256) { const int kk = i / DQ, d = i % DQ; Ks[kk][d] = bf2f(Kp[((size_t)b * SPB + kt + kk) * ldk + d]); }
                for (int i = tid; i < 64 * DV; i += 256) { const int kk = i / DV, d = i % DV; Vs[kk][d] = bf2f(Vp[((size_t)b * SPB + kt + kk) * ldv + d]); }
            }
            __syncthreads();
            if (in_range) {
#pragma unroll 1
            for (int j = 0; j < 64; ++j) { float a = 0.f;
#pragma unroll
                for (int d = 0; d < DQ / 2; ++d) a += __uint_as_float(qpk[d] << 16) * Ks[j][2 * d] + __uint_as_float(qpk[d] & 0xffff0000u) * Ks[j][2 * d + 1];
                bool valid = true;
                if (GROUP == 2 && pass == 1) { const int tk = kt + j - CTX; valid = (tk - tq <= 128) && (tq - tk <= 128); }
                const float sv = valid ? a : -INFINITY; const float mx = fmaxf(m, sv);
                const float f = exp2f(m - mx), pj = exp2f(sv - mx); m = mx; l = l * f + pj;
#pragma unroll
                for (int d = 0; d < DV; ++d) o[d] = o[d] * f + pj * Vs[j][d]; }
            }
        }
    }
    if (GROUP == 2) { const float sk = p.swa_sink[layer * 4 + h] * LOG2E; const float mx = fmaxf(m, sk); const float f = exp2f(m - mx); l = l * f + exp2f(sk - mx);
#pragma unroll
        for (int d = 0; d < DV; ++d) o[d] *= f; }
    const float il = 1.f / l;
    bf16_t* mix = (bf16_t*)(p.ws + WS_H) + r * DM + GROUP * 256 + h * 64;
#pragma unroll
    for (int d = 0; d < DV; ++d) { const float g = bf2f(Gp[r * NKEEP + d]); mix[d] = f2bf(o[d] * il * silu_f(g)); }
}

__device__ __forceinline__ int ssd_order(int d, int i) { return d == 0 ? i : (i < 2 ? 1 - i : 35 - i); }
__device__ __forceinline__ void ssd_local_body(const P& p, int layer, int w) {
    const int lane = tid512_fresh() & 63, pl = lane & 15, nq = lane >> 4; const int pq = w & 3, h = (w >> 2) & 3, bc = w >> 4, ch = bc % 34, b = bc / 34;
    const int pcol = h * 64 + pq * 16 + pl, g = h >> 1;
    const bf16_t* U = (const bf16_t*)(p.ws + WS_U); const float* DT = (const float*)(p.ws + WS_DT); bf16_t* Y = (bf16_t*)(p.ws + WS_Y);
    float* ACUM = (float*)(p.ws + WS_ACUM); float* ATOT = (float*)(p.ws + WS_ATOT); float* ST = (float*)(p.ws + WS_STATES);
    for (int dir = 0; dir < 2; ++dir) {
        const float a = -__expf(p.a_log[layer * 8 + dir * 4 + h]);
        float st[32];
#pragma unroll
        for (int n = 0; n < 32; ++n) st[n] = 0.f;
        float acc = 0.f;
        for (int step = 0; step < 128; ++step) {
            const int kpos = dir == 0 ? step : 127 - step; const size_t r = (size_t)b * SPB + ch * 128 + kpos; const bf16_t* u = U + r * 768;
            const float dt = DT[r * 8 + dir * 4 + h]; const float da = dt * a; const float dA = __expf(da); const float xdt = bf2f(u[pcol]) * dt; acc += da;
            if (pq == 0 && lane == 0) ACUM[r * 8 + dir * 4 + h] = acc;
            float y = 0.f;
            const uint4* bp = (const uint4*)(u + 256 + g * 128 + nq * 32); const uint4* cp = (const uint4*)(u + 512 + g * 128 + nq * 32);
#pragma unroll
            for (int v4 = 0; v4 < 4; ++v4) { const uint4 bv = bp[v4], cv = cp[v4]; const unsigned bw[4] = {bv.x, bv.y, bv.z, bv.w}, cw[4] = {cv.x, cv.y, cv.z, cv.w};
#pragma unroll
                for (int e = 0; e < 4; ++e) { const int n = v4 * 8 + e * 2;
                    st[n] = st[n] * dA + xdt * __uint_as_float(bw[e] << 16); y += st[n] * __uint_as_float(cw[e] << 16);
                    st[n + 1] = st[n + 1] * dA + xdt * __uint_as_float(bw[e] & 0xffff0000u); y += st[n + 1] * __uint_as_float(cw[e] & 0xffff0000u); } }
            y += __shfl_xor(y, 16); y += __shfl_xor(y, 32);
            if (nq == 0) { if (dir == 0) Y[r * 256 + pcol] = f2bf(y); else Y[r * 256 + pcol] = f2bf(bf2f(Y[r * 256 + pcol]) + y); }
        }
        if (pq == 0 && lane == 0) ATOT[(b * 34 + ch) * 8 + dir * 4 + h] = acc;
        float* sp = ST + ((((size_t)(b * 34 + ch) * 2 + dir) * 4 + h) * 64 + pq * 16 + pl) * 128 + nq * 32;
#pragma unroll
        for (int n = 0; n < 32; n += 4) *(float4*)(sp + n) = make_float4(st[n], st[n + 1], st[n + 2], st[n + 3]);
    }
}
__device__ __forceinline__ void ssd_chunk_scan_body(const P& p, int idx) {
    const int e = idx & 4095, h = (idx >> 12) & 3, d = (idx >> 14) & 1, b = idx >> 15;
    unsigned* ST = (unsigned*)(p.ws + WS_STATES); const float* ATOT = (const float*)(p.ws + WS_ATOT);
    unsigned loc[34]; float dec[34];
#pragma unroll
    for (int i = 0; i < 34; ++i) { const int ch = ssd_order(d, i); loc[i] = ST[(((size_t)(b * 34 + ch) * 2 + d) * 4 + h) * 4096 + e]; dec[i] = ATOT[(b * 34 + ch) * 8 + d * 4 + h]; }
    SB();
    float s0 = 0.f, s1 = 0.f;
#pragma unroll
    for (int i = 0; i < 34; ++i) { const int ch = ssd_order(d, i); ST[(((size_t)(b * 34 + ch) * 2 + d) * 4 + h) * 4096 + e] = pk2bf(s0, s1);
        const float ex = __expf(dec[i]); s0 = s0 * ex + __uint_as_float(loc[i] << 16); s1 = s1 * ex + __uint_as_float(loc[i] & 0xffff0000u); }
}
__device__ __forceinline__ void ssd_final_body(const P& p, int layer, int vb) {
    const int tidl = tid_fresh();
    const int r = vb * 4 + (TIDX >> 6), lane = TIDX & 63; const int b = r / SPB, ch = (r % SPB) >> 7;
    const bf16_t* U = (const bf16_t*)(p.ws + WS_U) + (size_t)r * 768; const bf16_t* keep = (const bf16_t*)(p.ws + WS_KEEP) + (size_t)r * NKEEP;
    const bf16_t* Y = (const bf16_t*)(p.ws + WS_Y) + (size_t)r * 256; const float* ACUM = (const float*)(p.ws + WS_ACUM) + (size_t)r * 8; const float* ST = (const float*)(p.ws + WS_STATES);
    const int c0 = lane * 4, h = c0 >> 6, g = h >> 1;
    float yo[4] = {0.f, 0.f, 0.f, 0.f};
    for (int d = 0; d < 2; ++d) { const float dec = __expf(ACUM[d * 4 + h]); const float* pv = ST + ((((size_t)(b * 34 + ch) * 2 + d) * 4 + h) * 64 + (c0 & 63)) * 128;
        float s4[4] = {0.f, 0.f, 0.f, 0.f};
        for (int n = 0; n < 128; n += 4) { const uint2 cv = *(const uint2*)(U + 512 + g * 128 + n); const float cf[4] = {__uint_as_float(cv.x << 16), __uint_as_float(cv.x & 0xffff0000u), __uint_as_float(cv.y << 16), __uint_as_float(cv.y & 0xffff0000u)};
#pragma unroll
            for (int e = 0; e < 4; ++e) { const float4 pr = *(const float4*)(pv + e * 128 + n); s4[e] += cf[0] * pr.x + cf[1] * pr.y + cf[2] * pr.z + cf[3] * pr.w; } }
#pragma unroll
        for (int e = 0; e < 4; ++e) yo[e] += dec * s4[e]; }
    float v[4], ss = 0.f;
#pragma unroll
    for (int e = 0; e < 4; ++e) { const int c = c0 + e; const float y = p.ssd_d[layer * 4 + h] * bf2f(U[c]) + bf2f(Y[c]) + yo[e]; v[e] = y * silu_f(bf2f(keep[K_Z + c])); ss += v[e] * v[e]; }
    const float rs = rsqrtf(wave_sum(ss) * (1.f / 256.f) + EPS);
    bf16_t* mix = (bf16_t*)(p.ws + WS_H) + (size_t)r * DM + 768;
#pragma unroll
    for (int e = 0; e < 4; ++e) { const int c = c0 + e; mix[c] = f2bf(v[e] * rs * p.ssd_norm_w[layer * 256 + c]); }
}

__device__ __forceinline__ void final_norm_body(const P& p, int vb) {
    const int tidl = tid_fresh();
    const int r = vb * 4 + (TIDX >> 6), lane = TIDX & 63; float* xr = p.out + (size_t)r * DM;
    float4 v[4]; float ss = 0.f;
#pragma unroll
    for (int j = 0; j < 4; ++j) { v[j] = *(const float4*)(xr + j * 256 + lane * 4); ss += v[j].x * v[j].x + v[j].y * v[j].y + v[j].z * v[j].z + v[j].w * v[j].w; }
    const float rstd = rsqrtf(wave_sum(ss) * (1.f / DM) + EPS);
#pragma unroll
    for (int j = 0; j < 4; ++j) { const float4 w = *(const float4*)(p.final_norm_w + j * 256 + lane * 4); float4 o; o.x = v[j].x * rstd * w.x; o.y = v[j].y * rstd * w.y; o.z = v[j].z * rstd * w.z; o.w = v[j].w * rstd * w.w; *(float4*)(xr + j * 256 + lane * 4) = o; }
}


namespace pg8 {
#define PG8_LAS __attribute__((address_space(3)))
typedef unsigned short bf16_t;
typedef short bf16x8 __attribute__((ext_vector_type(8)));
typedef float f32x4 __attribute__((ext_vector_type(4)));
typedef unsigned u32x4 __attribute__((ext_vector_type(4)));
constexpr int BM = 256, BK = 64, HALF = 128, HTB = HALF * BK * 2  , STAGE_BYTES = 8 * HTB, NXCD = 8, WGM = 8;

__host__ __device__ __forceinline__ int lds_byte(int r, int c) { const int st = (r >> 4) * 2 + (c >> 5), rr = r & 15, cc = c & 31, ob = rr * 64 + cc * 2; return st * 1024 + (ob ^ (((ob >> 9) & 1) << 5)); }
__host__ __device__ __forceinline__ void stage_rc(int b, int& R, int& C) { const int st = b / 1024, sb = b % 1024, swz = sb ^ (((sb >> 9) & 1) << 5); R = (st >> 1) * 16 + swz / 64; C = (st & 1) * 32 + (swz % 64) / 2; }
__host__ __device__ __forceinline__ int perm32(int rho) { const int n = rho >> 4, i = rho & 15; return 8 * (i >> 2) + 4 * n + (i & 3); }

struct Unit { int pm, pn; };
struct Gemm { const bf16_t* A; const bf16_t* Bt; int M, N, K; };

struct StaticOrder {
    int nM, nN, nwg, G, c;
    __host__ __device__ void init(int M, int N, int G_, int c_) { nM = M / BM; nN = N / BM; nwg = nM * nN; G = G_; c = c_; }
    __host__ __device__ bool next(int i, Unit& u) const {
        const long L = (long)i * G + c; if (L >= nwg) return false;
        int wgid = (int)L; { const int q = nwg / NXCD, r = nwg % NXCD, xcd = wgid % NXCD, off = wgid / NXCD; wgid = (xcd < r ? xcd * (q + 1) : r * (q + 1) + (xcd - r) * q) + off; }
        const int nig = WGM * nN, gid = wgid / nig, fm = gid * WGM, gsz = (nM - fm) < WGM ? (nM - fm) : WGM;
        u.pm = fm + ((wgid % nig) % gsz); u.pn = (wgid % nig) / gsz; return true;
    }
    __device__ __forceinline__ void a_ready(const Unit&) const {}
    __device__ __forceinline__ void done(const Unit&) const {}
};

__device__ __forceinline__ unsigned cvt_pk_bf16(float lo, float hi) { unsigned r; asm volatile("v_cvt_pk_bf16_f32 %0, %1, %2" : "=v"(r) : "v"(lo), "v"(hi)); return r; }
template <class Epi, class Sched, bool ALIGN_EPI = false, bool SP2 = false>
__device__ __forceinline__ void gemm_phase(PG8_LAS unsigned char* lds, const Gemm g, const Sched& S, const Epi& E) {
    const int tid = tid512_fresh(), wid = __builtin_amdgcn_readfirstlane(tid >> 6), lane = tid & 63, wr = wid >> 2, wc = wid & 3, fr = lane & 15, fq = lane >> 4;
    const int K = g.K, nt = K / BK;
    unsigned voffA[2], voffB[2];
#pragma unroll
    for (int i = 0; i < 2; ++i) { int R, C; stage_rc(tid * 16 + i * 8192, R, C); const int Rb = Epi::PERM ? ((R & ~31) + perm32(R & 31)) : R;
        voffA[i] = (unsigned)(R * K + C) * 2u; voffB[i] = (unsigned)(Rb * K + C) * 2u; }
    const size_t kstep = (size_t)(BK * 2);
    const size_t hstep = (size_t)HALF * K * 2;
    const size_t tstep = 2 * hstep;
    const unsigned ldsw = (unsigned)wid * 1024u;
    const int aoff = lds_byte(wr * 64 + fr, fq * 8), boff = lds_byte(wc * 32 + fr, fq * 8);
#define PG8_SA(b, h) (((b) * 2 + (h)) * HTB)
#define PG8_SB(b, h) ((4 + (b) * 2 + (h)) * HTB)
#define PG8_STAGE(bufoff, gbase, voff) do { _Pragma("unroll") for (int _i = 0; _i < 2; ++_i) \
        __builtin_amdgcn_global_load_lds((const unsigned*)((const char*)(gbase) + (voff)[_i]), (PG8_LAS unsigned*)(lds + (bufoff) + ldsw + _i * 8192), 16, 0, 0); } while (0)
#define PG8_LDA(dst, b, h) do { _Pragma("unroll") for (int m = 0; m < 4; ++m) _Pragma("unroll") for (int k = 0; k < 2; ++k) dst[m][k] = *(const PG8_LAS bf16x8*)(lds + PG8_SA(b, h) + aoff + m * 2048 + k * 1024); } while (0)
#define PG8_LDB(dst, b, h) do { _Pragma("unroll") for (int n = 0; n < 2; ++n) _Pragma("unroll") for (int k = 0; k < 2; ++k) dst[n][k] = *(const PG8_LAS bf16x8*)(lds + PG8_SB(b, h) + boff + n * 2048 + k * 1024); } while (0)
#define PG8_MMA(ai, bj, At, Bt) do { __builtin_amdgcn_s_setprio(1); _Pragma("unroll") for (int m = 0; m < 4; ++m) _Pragma("unroll") for (int n = 0; n < 2; ++n) _Pragma("unroll") for (int k = 0; k < 2; ++k) \
        acc[ai][bj][m][n] = __builtin_amdgcn_mfma_f32_16x16x32_bf16(Bt[n][k], At[m][k], acc[ai][bj][m][n], 0, 0, 0); __builtin_amdgcn_s_setprio(0); } while (0)
#define PG8_WAIT_V(n) asm volatile("s_waitcnt vmcnt(" #n ")" ::: "memory")
#define PG8_WAIT_L(n) asm volatile("s_waitcnt lgkmcnt(" #n ")" ::: "memory")
#define PG8_BAR __builtin_amdgcn_s_barrier()
#define PG8_SCHED __builtin_amdgcn_sched_barrier(0)
    Unit cur, nxt; int ui = 0;
    if (!S.next(0, cur)) return;
    f32x4 acc[2][2][4][2];
#pragma unroll
    for (int a = 0; a < 2; ++a)
#pragma unroll
        for (int b = 0; b < 2; ++b)
#pragma unroll
            for (int m = 0; m < 4; ++m)
#pragma unroll
                for (int n = 0; n < 2; ++n) acc[a][b][m][n] = (f32x4){0.f, 0.f, 0.f, 0.f};
    bf16x8 At[4][2], B0[2][2], B1[2][2];
    const char* cA = (const char*)g.A + (size_t)cur.pm * tstep; const char* cB = (const char*)g.Bt + (size_t)cur.pn * tstep;
    S.a_ready(cur);
    if constexpr (SP2) {
        PG8_STAGE(PG8_SB(0, 0), cB, voffB); PG8_STAGE(PG8_SB(0, 1), cB + hstep, voffB); PG8_STAGE(PG8_SA(0, 0), cA, voffA); PG8_STAGE(PG8_SA(0, 1), cA + hstep, voffA);
        if (wr == 1) PG8_BAR;
        PG8_WAIT_V(2); PG8_BAR;
        PG8_STAGE(PG8_SB(1, 0), cB + kstep, voffB); PG8_STAGE(PG8_SA(1, 0), cA + kstep, voffA); PG8_STAGE(PG8_SB(1, 1), cB + hstep + kstep, voffB);
        PG8_WAIT_V(6); PG8_BAR;
    } else {
        PG8_STAGE(PG8_SB(0, 0), cB, voffB); PG8_STAGE(PG8_SA(0, 0), cA, voffA); PG8_STAGE(PG8_SB(0, 1), cB + hstep, voffB); PG8_STAGE(PG8_SA(0, 1), cA + hstep, voffA);
        if (wr == 1) PG8_BAR;
        PG8_WAIT_V(4); PG8_BAR;
        PG8_STAGE(PG8_SB(1, 0), cB + kstep, voffB); PG8_STAGE(PG8_SA(1, 0), cA + kstep, voffA); PG8_STAGE(PG8_SB(1, 1), cB + hstep + kstep, voffB);
        PG8_WAIT_V(6); PG8_BAR;
    }
    for (;;) {
        const bool has_next = S.next(ui + 1, nxt);
        const char* nA = has_next ? (const char*)g.A + (size_t)nxt.pm * tstep : cA; const char* nB = has_next ? (const char*)g.Bt + (size_t)nxt.pn * tstep : cB;
        for (int t = 0; t < nt; t += 2) {
            const bool last = (t == nt - 2);
            const char* a1 = cA + (size_t)(t + 1) * kstep;
            const char* a2 = last ? nA : cA + (size_t)(t + 2) * kstep; const char* b2 = last ? nB : cB + (size_t)(t + 2) * kstep;
            const char* a3 = a2 + kstep; const char* b3 = b2 + kstep;
            if (last && has_next) S.a_ready(nxt);
            if constexpr (SP2) {
            PG8_LDB(B0, 0, 0); PG8_LDB(B1, 0, 1); PG8_SCHED; PG8_LDA(At, 0, 0); PG8_STAGE(PG8_SA(1, 1), a1 + hstep, voffA);
            PG8_WAIT_V(8); PG8_WAIT_L(0); PG8_BAR; PG8_MMA(0, 0, At, B0); PG8_MMA(0, 1, At, B1); PG8_BAR; PG8_SCHED;
            PG8_LDA(At, 0, 1); PG8_STAGE(PG8_SB(0, 0), b2, voffB); PG8_STAGE(PG8_SB(0, 1), b2 + hstep, voffB); PG8_STAGE(PG8_SA(0, 0), a2, voffA);
            PG8_WAIT_V(8); PG8_WAIT_L(0); PG8_BAR; PG8_MMA(1, 0, At, B0); PG8_MMA(1, 1, At, B1); PG8_BAR; PG8_SCHED;
            PG8_LDB(B0, 1, 0); PG8_LDB(B1, 1, 1); PG8_SCHED; PG8_LDA(At, 1, 0); PG8_STAGE(PG8_SA(0, 1), a2 + hstep, voffA);
            PG8_WAIT_V(8); PG8_WAIT_L(0); PG8_BAR; PG8_MMA(0, 0, At, B0); PG8_MMA(0, 1, At, B1); PG8_BAR; PG8_SCHED;
            PG8_LDA(At, 1, 1); PG8_STAGE(PG8_SB(1, 0), b3, voffB); PG8_STAGE(PG8_SB(1, 1), b3 + hstep, voffB); PG8_STAGE(PG8_SA(1, 0), a3, voffA);
            PG8_WAIT_V(8); PG8_WAIT_L(0); PG8_BAR; PG8_MMA(1, 0, At, B0); PG8_MMA(1, 1, At, B1); PG8_BAR; PG8_SCHED;
            } else {
            PG8_LDB(B0, 0, 0); PG8_SCHED; PG8_LDA(At, 0, 0); PG8_STAGE(PG8_SA(1, 1), a1 + hstep, voffA);
            PG8_WAIT_L(8); PG8_BAR; PG8_WAIT_L(0); PG8_MMA(0, 0, At, B0); PG8_BAR; PG8_SCHED;
            PG8_LDB(B1, 0, 1); PG8_STAGE(PG8_SB(0, 0), b2, voffB);
            PG8_BAR; PG8_WAIT_L(0); PG8_MMA(0, 1, At, B1); PG8_BAR;
            PG8_LDA(At, 0, 1); PG8_STAGE(PG8_SA(0, 0), a2, voffA);
            PG8_BAR; PG8_WAIT_L(0); PG8_MMA(1, 0, At, B0); PG8_BAR; PG8_SCHED;
            PG8_STAGE(PG8_SB(0, 1), b2 + hstep, voffB);
            PG8_WAIT_V(6); PG8_BAR; PG8_MMA(1, 1, At, B1); PG8_BAR;
            PG8_LDB(B0, 1, 0); PG8_SCHED; PG8_LDA(At, 1, 0); PG8_STAGE(PG8_SA(0, 1), a2 + hstep, voffA);
            PG8_WAIT_L(8); PG8_BAR; PG8_WAIT_L(0); PG8_MMA(0, 0, At, B0); PG8_BAR; PG8_SCHED;
            PG8_LDB(B1, 1, 1); PG8_STAGE(PG8_SB(1, 0), b3, voffB);
            PG8_BAR; PG8_WAIT_L(0); PG8_MMA(0, 1, At, B1); PG8_BAR;
            PG8_LDA(At, 1, 1); PG8_STAGE(PG8_SA(1, 0), a3, voffA);
            PG8_BAR; PG8_WAIT_L(0); PG8_MMA(1, 0, At, B0); PG8_BAR; PG8_SCHED;
            PG8_STAGE(PG8_SB(1, 1), b3 + hstep, voffB);
            PG8_WAIT_V(6); PG8_BAR; PG8_MMA(1, 1, At, B1); PG8_BAR;
            }
        }
        if constexpr (ALIGN_EPI) { if (wr == 0) PG8_BAR; }
        if constexpr (!Epi::AFTER_DRAIN) { E(acc, cur, wr, wc, fr, fq); S.done(cur); }
        if (!has_next) break;
#pragma unroll
        for (int a = 0; a < 2; ++a)
#pragma unroll
            for (int b = 0; b < 2; ++b)
#pragma unroll
                for (int m = 0; m < 4; ++m)
#pragma unroll
                    for (int n = 0; n < 2; ++n) acc[a][b][m][n] = (f32x4){0.f, 0.f, 0.f, 0.f};
        cur = nxt; cA = nA; cB = nB; ++ui;
        if constexpr (ALIGN_EPI) { if (wr == 1) PG8_BAR; }
    }
    PG8_WAIT_V(0);
    if constexpr (!ALIGN_EPI) { if (wr == 0) PG8_BAR; }
    PG8_BAR;
    if constexpr (Epi::AFTER_DRAIN) { E.fused(acc, cur, wr, wc, fr, fq, lds, wid, lane); S.done(cur); }
#undef PG8_SA
#undef PG8_SB
#undef PG8_STAGE
#undef PG8_LDA
#undef PG8_LDB
#undef PG8_MMA
#undef PG8_WAIT_V
#undef PG8_WAIT_L
#undef PG8_BAR
#undef PG8_SCHED
}
}

struct EpiIn {
    static constexpr bool PERM = true, AFTER_DRAIN = false;
    bf16_t* tmp; bf16_t* keep;
    __device__ __forceinline__ void operator()(const pg8::f32x4 (&acc)[2][2][4][2], const pg8::Unit& u, int wr, int wc, int fr, int fq) const {
        const int row0 = u.pm * 256 + wr * 64 + fr, colt = u.pn * 256; bf16_t* base; int ldc;
        if (colt < NTMP) { base = tmp + colt; ldc = NTMP; } else { base = keep + (colt - NTMP); ldc = NKEEP; }
        const int col0 = wc * 32 + 8 * fq;
#pragma unroll
        for (int ai = 0; ai < 2; ++ai)
#pragma unroll
            for (int m = 0; m < 4; ++m) { bf16_t* rowp = base + (size_t)(row0 + ai * 128 + m * 16) * ldc + col0;
#pragma unroll
                for (int bj = 0; bj < 2; ++bj) { const pg8::f32x4 v0 = acc[ai][bj][m][0], v1 = acc[ai][bj][m][1]; pg8::u32x4 w;
                    w.x = pk2bf(v0[0], v0[1]); w.y = pk2bf(v0[2], v0[3]); w.z = pk2bf(v1[0], v1[1]); w.w = pk2bf(v1[2], v1[3]);
                    *(pg8::u32x4*)(rowp + bj * 128) = w; } }
    }
};
struct LatentOrder {
    int G, c;
    __device__ __forceinline__ bool next(int i, pg8::Unit& u) const { const int L = i * G + c; if (L >= 256) return false; const int pl = L >> 2; u.pm = (pl >> 4) * 17 + 1 + (pl & 15); u.pn = L & 3; return true; }
    __device__ __forceinline__ void a_ready(const pg8::Unit&) const {}
    __device__ __forceinline__ void done(const pg8::Unit&) const {}
};
struct CtxOrder {
    int G, c;
    __device__ __forceinline__ bool next(int i, pg8::Unit& u) const { const int L = i * G + c; if (L >= 16) return false; u.pm = (L >> 2) * 17; u.pn = L & 3; return true; }
    __device__ __forceinline__ void a_ready(const pg8::Unit&) const {}
    __device__ __forceinline__ void done(const pg8::Unit&) const {}
};
struct InOrder {
    int G, c, pass;
    static __device__ __forceinline__ int mustcol(int k) { return k < 5 ? k : k < 7 ? k + 1 : k + 2; }
    static __device__ __forceinline__ int freecol(int k) { return k < 2 ? 5 + 3 * k : 9 + k; }
    static __device__ __forceinline__ void must_tile(int L, pg8::Unit& u) { const int xcd = L & 7, off = L >> 3; const int pmi = xcd * 8 + (off & 7); u.pm = pmi + (pmi >> 4) + 1; u.pn = mustcol(off >> 3); }
    static __device__ __forceinline__ void free_tile(int j, pg8::Unit& u) { const int pmi = j >> 2; u.pm = pmi + (pmi >> 4) + 1; u.pn = freecol(j & 3); }
    __device__ __forceinline__ bool next(int i, pg8::Unit& u) const {
        if (G == 256) {
            if (pass == 0) { if (c >= 16) { if (i >= 2) return false; must_tile(i * 240 + (c - 16), u); } else { if (i >= 1) return false; must_tile(480 + c, u); } return true; }
            if (pass == 1) { if (i >= 1) return false; if (c < 80) must_tile(496 + c, u); else if (c < 116) { const int t = c - 80; u.pm = (t / 9) * 17; u.pn = mustcol(t % 9); } else free_tile(c - 116, u); return true; }
            if (i >= 1 || c >= 132) return false;
            const int x = c & 7, t = (x < 4 ? 17 * x : 68 + 16 * (x - 4)) + (c >> 3);
            if (t < 116) free_tile(140 + t, u); else { const int q = t - 116; u.pm = (q >> 2) * 17; u.pn = freecol(q & 3); }
            return true; }
        if (pass != 0) return false; const long LL = (long)i * G + c; if (LL >= 884) return false; const int L = (int)LL;
        if (L < 748) { constexpr int nwg = 748, nM = 68, nN = 11; int wgid = L; { constexpr int q = nwg / pg8::NXCD, r = nwg % pg8::NXCD; const int xcd = wgid % pg8::NXCD, off = wgid / pg8::NXCD; wgid = (xcd < r ? xcd * (q + 1) : r * (q + 1) + (xcd - r) * q) + off; }
            constexpr int nig = pg8::WGM * nN; const int gid = wgid / nig, fm = gid * pg8::WGM, gsz = (nM - fm) < pg8::WGM ? (nM - fm) : pg8::WGM;
            u.pm = fm + ((wgid % nig) % gsz); u.pn = (wgid % nig) / gsz; }
        else { const int jt = L - 748; u.pm = jt >> 1; u.pn = 11 + (jt & 1); }
        return true; }
    __device__ __forceinline__ void a_ready(const pg8::Unit&) const {}
    __device__ __forceinline__ void done(const pg8::Unit&) const {}
};
struct EpiOut {
    static constexpr bool PERM = false, AFTER_DRAIN = false;
    const float *x_in, *ctx_in; float *x_out, *xc; const float* mod;
    __device__ __forceinline__ void operator()(const pg8::f32x4 (&acc)[2][2][4][2], const pg8::Unit& u, int wr, int wc, int fr, int fq) const {
        const int b = u.pm / 17, tt = u.pm % 17; const float* xi; float* xo; int mr;
        if (tt == 0) { xi = ctx_in + (size_t)b * CTX * DM; xo = xc + (size_t)b * CTX * DM; mr = 4; }
        else { const size_t o = ((size_t)b * SEQ + (size_t)(tt - 1) * 256) * DM; xi = x_in + o; xo = x_out + o; mr = b; }
        const float* gate = mod + mr * 3072 + 2048; const int col0 = u.pn * 256 + wc * 32 + 4 * fq;
#pragma unroll
        for (int bj = 0; bj < 2; ++bj)
#pragma unroll
            for (int n = 0; n < 2; ++n) { const pg8::f32x4 g = *(const pg8::f32x4*)(gate + col0 + bj * 128 + n * 16);
                { pg8::f32x4 xv[8];
#pragma unroll
                  for (int am = 0; am < 8; ++am) xv[am] = *(const pg8::f32x4*)(xi + (size_t)((am >> 2) * 128 + wr * 64 + (am & 3) * 16 + fr) * DM + col0 + bj * 128 + n * 16);
                  SB();
#pragma unroll
                  for (int am = 0; am < 8; ++am) *(pg8::f32x4*)(xo + (size_t)((am >> 2) * 128 + wr * 64 + (am & 3) * 16 + fr) * DM + col0 + bj * 128 + n * 16) = xv[am] + g * acc[am >> 2][bj][am & 3][n];
                  SB(); } }
    }
};

template <bool MAPPED> __device__ __forceinline__ void transpose_item(const float* W, int K, int N, bf16_t* WT, int NP  , float* scr, int item, int lane) {
    const int nblk = NP / 32, kb = item / nblk, nb = item % nblk, k0 = 64 * kb, n0 = 32 * nb;
    const int oc = MAPPED ? in_col_map(n0 + (lane & 31)) : (n0 + (lane & 31) < N ? n0 + (lane & 31) : -1);
    const int cb_ = MAPPED ? in_col_map(n0) : n0;
    if ((N & 3) == 0 && (!MAPPED || n0 < 416 || n0 >= 512)) {
        float4 wv[8];
#pragma unroll
        for (int i = 0; i < 8; ++i) wv[i] = *(const float4*)(W + (size_t)(k0 + 8 * i + (lane >> 3)) * N + cb_ + 4 * (lane & 7));
        SB();
#pragma unroll
        for (int i = 0; i < 8; ++i) { float* s_ = scr + (8 * i + (lane >> 3)) * 33 + 4 * (lane & 7); s_[0] = wv[i].x; s_[1] = wv[i].y; s_[2] = wv[i].z; s_[3] = wv[i].w; }
    } else {
#pragma unroll 1
    for (int i0 = 0; i0 < 32; i0 += 16) { float wv[16];
#pragma unroll
        for (int i = 0; i < 16; ++i) { const int kk = 2 * (i0 + i) + (lane >> 5); wv[i] = oc >= 0 ? W[(size_t)(k0 + kk) * N + oc] : 0.f; }
        SB();
#pragma unroll
        for (int i = 0; i < 16; ++i) { const int kk = 2 * (i0 + i) + (lane >> 5); scr[kk * 33 + (lane & 31)] = wv[i]; } }
    }
    asm volatile("s_waitcnt lgkmcnt(0)" ::: "memory");
    const int c = lane & 7;
#pragma unroll
    for (int j = 0; j < 4; ++j) { const int n = (lane >> 3) + 8 * j; const float* s = scr + (8 * c) * 33 + n;
        uint4 o; o.x = pk2bf(s[0], s[33]); o.y = pk2bf(s[2 * 33], s[3 * 33]);
        o.z = pk2bf(s[4 * 33], s[5 * 33]); o.w = pk2bf(s[6 * 33], s[7 * 33]);
        *(uint4*)(WT + (size_t)(n0 + n) * K + k0 + 8 * c) = o; }
    asm volatile("s_waitcnt lgkmcnt(0)" ::: "memory");
}
__device__ __forceinline__ void weights_layer(const P& p, char* lds, int l, int wgi, int nwg) {
    const int t5 = tid512_fresh(), lane = t5 & 63, gwave = wgi * 8 + (t5 >> 6), ngwaves = nwg * 8; float* scr = (float*)(lds + (t5 >> 6) * 8448);
    constexpr int I_IN = 16 * 104, I_OUT = 16 * 32, I_L = I_IN + I_OUT;
    for (int it = gwave; it < I_L; it += ngwaves) { int r = it;
        if (r < I_IN) { transpose_item<true>(p.w_in + (size_t)l * DM * IN_COLS, DM, IN_COLS, (bf16_t*)(p.ws + WS_WIN) + (size_t)l * 3328 * DM, 3328, scr, r, lane); continue; } r -= I_IN;
        transpose_item<false>(p.w_out + (size_t)l * DM * DM, DM, DM, (bf16_t*)(p.ws + WS_WOUT) + (size_t)l * DM * DM, DM, scr, r - 0, lane);
    }
}

__device__ __forceinline__ void mla_weight_frags(const P& p, int bx, int G) {
    for (int it = bx * 512 + tid512_fresh(); it < DEPTH * 20480; it += G * 512) { const int l = it / 20480; int r = it % 20480; const float* W; int N, t, ks, ln; bf16_t* dst;
        if (r < 12288) { W = p.w_q_up + (size_t)l * 256 * 384; N = 384; t = r >> 10; ks = (r >> 6) & 15; ln = r & 63; dst = (bf16_t*)(p.ws + WS_WQ) + (size_t)l * 98304 + (size_t)r * 8; }
        else { r -= 12288; W = p.w_kv_up + (size_t)l * 128 * 512; N = 512; t = r >> 9; ks = (r >> 6) & 7; ln = r & 63; dst = (bf16_t*)(p.ws + WS_WKV) + (size_t)l * 65536 + (size_t)r * 8; }
        const float* s = W + (size_t)(ks * 16 + (ln >> 5) * 8) * N + 32 * t + (ln & 31);
        uint4 o; o.x = pk2bf(s[0], s[N]); o.y = pk2bf(s[2 * N], s[3 * N]);
        o.z = pk2bf(s[4 * N], s[5 * N]); o.w = pk2bf(s[6 * N], s[7 * N]);
        *(uint4*)dst = o; }
}
namespace att {
typedef short bf16x8 __attribute__((ext_vector_type(8)));
typedef short s16x4 __attribute__((ext_vector_type(4)));
typedef float f32x16 __attribute__((ext_vector_type(16)));
typedef unsigned u32x4 __attribute__((ext_vector_type(4)));
#define ASBAR() __builtin_amdgcn_sched_barrier(0)
constexpr float THR2 = 6.f;
constexpr int SHM_V = 8192, SHM_K = 16384;
constexpr int LDS_VOFF = 0, LDS_KOFF = 3 * SHM_V, LDS_WSOFF = 3 * SHM_V + 3 * SHM_K, LDS_TOTAL = LDS_WSOFF + 8 * 256;
__device__ __forceinline__ int crow(int r, int hi) { return (r & 3) + 8 * (r >> 2) + 4 * hi; }
__device__ __forceinline__ unsigned cvtpk(float lo, float hi) { unsigned r; asm volatile("v_cvt_pk_bf16_f32 %0, %1, %2" : "=v"(r) : "v"(lo), "v"(hi)); return r; }
template <int DQ> __device__ __forceinline__ int kswz(int row, int ch) { return DQ == 64 ? row * 128 + ((ch ^ ((row >> 1) & 7)) << 4) : row * 256 + ((ch ^ (row & 15)) << 4); }
__device__ __forceinline__ int v_st(int k, int c) { const int kk = (k & ~0xC) | ((k & 4) << 1) | ((k & 8) >> 1); return ((kk >> 3) * 2 + (c >> 5)) * 512 + ((kk & 7) * 32 + (c & 31)) * 2; }
__device__ __forceinline__ int v_rd_base(int lane) { return ((lane & 3) << 3) | (((lane >> 2) & 3) << 6) | (((lane >> 4) & 1) << 5) | (((lane >> 5) & 1) << 8); }
constexpr int v_rd_off(int d0, int ks, int half) { return d0 * 512 + ks * 2048 + half * 1024; }
template <int OFF> __device__ __forceinline__ s16x4 tr_read(int vb) { s16x4 r; asm volatile("ds_read_b64_tr_b16 %0, %1 offset:%2" : "=&v"(r) : "v"(vb), "i"(OFF) : "memory"); return r; }

__device__ __forceinline__ void partialSM(f32x16& p0, f32x16& p1, float& m_reg, float& mn, float& alpha) {
    float pmax = p0[0];
#pragma unroll
    for (int r = 1; r < 16; ++r) pmax = fmaxf(pmax, p0[r]);
#pragma unroll
    for (int r = 0; r < 16; ++r) pmax = fmaxf(pmax, p1[r]);
    { auto rr = __builtin_amdgcn_permlane32_swap(__float_as_uint(pmax), __float_as_uint(pmax), false, false); pmax = fmaxf(__uint_as_float(rr[0]), __uint_as_float(rr[1])); }
    if (__builtin_expect(__all(pmax - m_reg <= THR2), 1)) { mn = m_reg; alpha = 1.f; }
    else { mn = fmaxf(m_reg, pmax); alpha = __builtin_amdgcn_exp2f(m_reg - mn); m_reg = mn; }
#pragma unroll
    for (int r = 0; r < 16; ++r) { p0[r] -= mn; p1[r] -= mn; }
#pragma unroll
    for (int r = 0; r < 16; ++r) p0[r] = __builtin_amdgcn_exp2f(p0[r]);
}
__device__ __forceinline__ void finishSM(f32x16& p0, f32x16& p1, float alpha, float& l_reg, bf16x8& pa0, bf16x8& pa1, bf16x8& pa2, bf16x8& pa3) {
#pragma unroll
    for (int r = 0; r < 16; ++r) p1[r] = __builtin_amdgcn_exp2f(p1[r]);
    float ps = 0;
#pragma unroll
    for (int r = 0; r < 16; ++r) ps += p0[r];
#pragma unroll
    for (int r = 0; r < 16; ++r) ps += p1[r];
    { auto rr = __builtin_amdgcn_permlane32_swap(__float_as_uint(ps), __float_as_uint(ps), false, false); ps = __uint_as_float(rr[0]) + __uint_as_float(rr[1]); }
    l_reg = l_reg * alpha + ps;
#define ATT_PK4(P, BASE, OUT) do { unsigned a0 = cvtpk(P[BASE + 0], P[BASE + 1]), a1 = cvtpk(P[BASE + 2], P[BASE + 3]);   \
    unsigned b0 = cvtpk(P[BASE + 4], P[BASE + 5]), b1 = cvtpk(P[BASE + 6], P[BASE + 7]);                              \
    auto r0 = __builtin_amdgcn_permlane32_swap(a0, b0, false, false); auto r1 = __builtin_amdgcn_permlane32_swap(a1, b1, false, false); \
    u32x4 w = {r0[0], r1[0], r0[1], r1[1]}; OUT = *reinterpret_cast<bf16x8*>(&w); } while (0)
    ATT_PK4(p0, 0, pa0); ATT_PK4(p0, 8, pa1); ATT_PK4(p1, 0, pa2); ATT_PK4(p1, 8, pa3);
#undef ATT_PK4
}
template <int DQ> __device__ __forceinline__ void qkt(f32x16& p0, f32x16& p1, const char* Ks, const bf16x8* qr, int r32, int hi) {
    p0 = f32x16{}; p1 = f32x16{};
#pragma unroll
    for (int d0 = 0; d0 < DQ / 16; ++d0) { const int ch = d0 * 2 + hi;
        const bf16x8 b0 = *reinterpret_cast<const bf16x8*>(Ks + kswz<DQ>(r32, ch));
        const bf16x8 b1 = *reinterpret_cast<const bf16x8*>(Ks + kswz<DQ>(32 + r32, ch));
        p0 = __builtin_amdgcn_mfma_f32_32x32x16_bf16(b0, qr[d0], p0, 0, 0, 0);
        p1 = __builtin_amdgcn_mfma_f32_32x32x16_bf16(b1, qr[d0], p1, 0, 0, 0); }
}
template <int D0> __device__ __forceinline__ void pv_one(f32x16& od, int vb, bf16x8 pa0, bf16x8 pa1, bf16x8 pa2, bf16x8 pa3) {
    const s16x4 l0 = tr_read<v_rd_off(D0, 0, 0)>(vb), h0 = tr_read<v_rd_off(D0, 0, 1)>(vb), l1 = tr_read<v_rd_off(D0, 1, 0)>(vb), h1 = tr_read<v_rd_off(D0, 1, 1)>(vb);
    const s16x4 l2 = tr_read<v_rd_off(D0, 2, 0)>(vb), h2 = tr_read<v_rd_off(D0, 2, 1)>(vb), l3 = tr_read<v_rd_off(D0, 3, 0)>(vb), h3 = tr_read<v_rd_off(D0, 3, 1)>(vb);
    asm volatile("s_waitcnt lgkmcnt(0)" ::: "memory"); ASBAR();
#define ATT_PK(L, H) (bf16x8){L[0], L[1], L[2], L[3], H[0], H[1], H[2], H[3]}
    od = __builtin_amdgcn_mfma_f32_32x32x16_bf16(pa0, ATT_PK(l0, h0), od, 0, 0, 0);
    od = __builtin_amdgcn_mfma_f32_32x32x16_bf16(pa1, ATT_PK(l1, h1), od, 0, 0, 0);
    od = __builtin_amdgcn_mfma_f32_32x32x16_bf16(pa2, ATT_PK(l2, h2), od, 0, 0, 0);
    od = __builtin_amdgcn_mfma_f32_32x32x16_bf16(pa3, ATT_PK(l3, h3), od, 0, 0, 0);
#undef ATT_PK
}
__device__ __forceinline__ void pv_all(f32x16* o, int vb, bf16x8 pa0, bf16x8 pa1, bf16x8 pa2, bf16x8 pa3) { pv_one<0>(o[0], vb, pa0, pa1, pa2, pa3); pv_one<1>(o[1], vb, pa0, pa1, pa2, pa3); }


template <int DQ> __device__ __forceinline__ void qkt2(f32x16& p0, f32x16& p1, const char* Ks, const bf16x8* qr, const f32x16& negm, int r32, int hi) {
#pragma unroll
    for (int d0 = 0; d0 < DQ / 16; ++d0) { const int ch = d0 * 2 + hi;
        const bf16x8 b0 = *reinterpret_cast<const bf16x8*>(Ks + kswz<DQ>(r32, ch));
        const bf16x8 b1 = *reinterpret_cast<const bf16x8*>(Ks + kswz<DQ>(32 + r32, ch));
        if (d0 == 0) { p0 = __builtin_amdgcn_mfma_f32_32x32x16_bf16(b0, qr[0], negm, 0, 0, 0); p1 = __builtin_amdgcn_mfma_f32_32x32x16_bf16(b1, qr[0], negm, 0, 0, 0); }
        else { p0 = __builtin_amdgcn_mfma_f32_32x32x16_bf16(b0, qr[d0], p0, 0, 0, 0); p1 = __builtin_amdgcn_mfma_f32_32x32x16_bf16(b1, qr[d0], p1, 0, 0, 0); } }
}
template <bool FIRST> __device__ __forceinline__ void partialSM2(f32x16& p0, f32x16& p1, float& m_ref, f32x16& negm, float& alpha) {
    float pmax = p0[0];
#pragma unroll
    for (int r = 1; r < 16; ++r) pmax = fmaxf(pmax, p0[r]);
#pragma unroll
    for (int r = 0; r < 16; ++r) pmax = fmaxf(pmax, p1[r]);
    { auto rr = __builtin_amdgcn_permlane32_swap(__float_as_uint(pmax), __float_as_uint(pmax), false, false); pmax = fmaxf(__uint_as_float(rr[0]), __uint_as_float(rr[1])); }
    alpha = 1.f;
    if (FIRST || !__builtin_expect(__all(pmax <= THR2), 1)) { const float dl = FIRST ? pmax : fmaxf(pmax, 0.f); m_ref += dl; if (!FIRST) alpha = __builtin_amdgcn_exp2f(-dl);
#pragma unroll
        for (int r = 0; r < 16; ++r) { p0[r] -= dl; p1[r] -= dl; }
#pragma unroll
        for (int r = 0; r < 16; ++r) negm[r] = -m_ref; }
#pragma unroll
    for (int r = 0; r < 16; ++r) p0[r] = __builtin_amdgcn_exp2f(p0[r]);
}
__device__ __forceinline__ void finishSM2(f32x16& p0, f32x16& p1, bf16x8& pa0, bf16x8& pa1, bf16x8& pa2, bf16x8& pa3) {
#pragma unroll
    for (int r = 0; r < 16; ++r) p1[r] = __builtin_amdgcn_exp2f(p1[r]);
#define ATT_PK4(P, BASE, OUT) do { unsigned a0 = cvtpk(P[BASE + 0], P[BASE + 1]), a1 = cvtpk(P[BASE + 2], P[BASE + 3]);   \
    unsigned b0 = cvtpk(P[BASE + 4], P[BASE + 5]), b1 = cvtpk(P[BASE + 6], P[BASE + 7]);                              \
    auto r0 = __builtin_amdgcn_permlane32_swap(a0, b0, false, false); auto r1 = __builtin_amdgcn_permlane32_swap(a1, b1, false, false); \
    u32x4 w = {r0[0], r1[0], r0[1], r1[1]}; OUT = *reinterpret_cast<bf16x8*>(&w); } while (0)
    ATT_PK4(p0, 0, pa0); ATT_PK4(p0, 8, pa1); ATT_PK4(p1, 0, pa2); ATT_PK4(p1, 8, pa3);
#undef ATT_PK4
}
__device__ __forceinline__ void pv_all2(f32x16* o, f32x16& osum, int vb, bf16x8 pa0, bf16x8 pa1, bf16x8 pa2, bf16x8 pa3) {
    pv_one<0>(o[0], vb, pa0, pa1, pa2, pa3); pv_one<1>(o[1], vb, pa0, pa1, pa2, pa3);
    const bf16x8 ones = {16256, 16256, 16256, 16256, 16256, 16256, 16256, 16256};
    osum = __builtin_amdgcn_mfma_f32_32x32x16_bf16(pa0, ones, osum, 0, 0, 0); osum = __builtin_amdgcn_mfma_f32_32x32x16_bf16(pa1, ones, osum, 0, 0, 0);
    osum = __builtin_amdgcn_mfma_f32_32x32x16_bf16(pa2, ones, osum, 0, 0, 0); osum = __builtin_amdgcn_mfma_f32_32x32x16_bf16(pa3, ones, osum, 0, 0, 0);
}
struct Unit {
    const bf16_t* Q; int ldq;
    const bf16_t* K; int ldk;
    const bf16_t* V; int ldv;
    const bf16_t* gate; bf16_t* out;
    int n1, n2, row2;
    int tq0; float sink_l2;
};
template <int DQ, int MODE> __device__ __forceinline__ void attn_unit(const Unit& U, char* lds) {
    const int tid = tid512_fresh(), wid = tid >> 6, lane = tid & 63, r32 = lane & 31, hi = lane >> 5;
    char* V_lds = lds + LDS_VOFF; char* K_lds = lds + LDS_KOFF;
    float* wsp = (float*)(lds + LDS_WSOFF) + wid * 64; float* li_l = wsp; float* al_l = wsp + 32;
    float m_reg = 0.f; f32x16 o[2] = {}, osum = {}, negm = {}; bf16x8 qr[DQ / 16];
    { const bf16_t* Qw = U.Q + (size_t)(wid * 32 + r32) * U.ldq + hi * 8;
#pragma unroll
      for (int d0 = 0; d0 < DQ / 16; ++d0) qr[d0] = *reinterpret_cast<const bf16x8*>(Qw + d0 * 16); }
    constexpr int KCH = DQ / 8;
    const int kr0 = tid / KCH, kc0 = tid % KCH, kr1 = (512 + tid) / KCH, kc1 = (512 + tid) % KCH; const bool k2 = (DQ == 96) && tid < 256;
    const int vr = tid >> 3, vc = (tid & 7) * 8;
    const int kst0 = kswz<DQ>(kr0, kc0), kst1 = kswz<DQ>(k2 ? kr1 : 0, k2 ? kc1 : 0), vst = v_st(vr, vc);
    const int vb0 = (int)(uintptr_t)V_lds + v_rd_base(lane);
    struct { bf16x8 ks0, ks1, vs0; } sr_[2];
    const int NT = U.n1 + U.n2;
#define ATT_TROW(j) ((j) < U.n1 ? 64 * (j) : U.row2 + 64 * ((j) - U.n1))
#define ATT_CROW(j) (MODE == 1 ? min(max(ATT_TROW(j), 0), SPB - 64) : ATT_TROW(j))
#define ATT_SLOAD(i, j) do { const int row_ = ATT_CROW(j); sr_[i].ks0 = *reinterpret_cast<const bf16x8*>(U.K + (size_t)(row_ + kr0) * U.ldk + kc0 * 8); \
    if (k2) sr_[i].ks1 = *reinterpret_cast<const bf16x8*>(U.K + (size_t)(row_ + kr1) * U.ldk + kc1 * 8); \
    sr_[i].vs0 = *reinterpret_cast<const bf16x8*>(U.V + (size_t)(row_ + vr) * U.ldv + vc); } while (0)
#define ATT_SWRITE(b, i) do { *(bf16x8*)(K_lds + (b) * SHM_K + kst0) = sr_[i].ks0; if (k2) *(bf16x8*)(K_lds + (b) * SHM_K + kst1) = sr_[i].ks1; *(bf16x8*)(V_lds + (b) * SHM_V + vst) = sr_[i].vs0; } while (0)
#define ATT_SWAIT() asm volatile("s_waitcnt vmcnt(2)" ::: "memory")
#define ATT_RESC(a) do { if (__any((a) < 1.f)) { if (hi == 0) al_l[r32] = (a); asm volatile("s_waitcnt lgkmcnt(0)" ::: "memory"); \
    _Pragma("unroll") for (int r = 0; r < 16; ++r) { const float a_ = al_l[crow(r, hi)]; o[0][r] *= a_; o[1][r] *= a_; osum[r] *= a_; } } } while (0)
    const int tq = U.tq0 + wid * 32 + r32;
#define ATT_MASK(P0, P1, j) do { if (MODE == 1 && (j) >= U.n1) { const int tk0_ = ATT_TROW(j) - CTX + 4 * hi; const int lo_ = max(tq - 128, 0), hi_ = min(tq + 128, SEQ - 1); \
    _Pragma("unroll") for (int r = 0; r < 16; ++r) { const int tk_ = tk0_ + (r & 3) + 8 * (r >> 2); if (tk_ < lo_ || tk_ > hi_) P0[r] = -1e30f; if (tk_ + 32 < lo_ || tk_ + 32 > hi_) P1[r] = -1e30f; } } } while (0)
    f32x16 pA0, pA1, pB0, pB1; float alA, alB; bf16x8 pa0, pa1, pa2, pa3;
    if (__builtin_amdgcn_readfirstlane(tid) >= 256) __builtin_amdgcn_s_setprio(1);
    ATT_SLOAD(0, 0); asm volatile("s_waitcnt vmcnt(0)" ::: "memory"); ATT_SWRITE(0, 0);
    ATT_SLOAD(1, 1); if (2 < NT) ATT_SLOAD(0, 2);
    __syncthreads();
    qkt2<DQ>(pA0, pA1, K_lds, qr, negm, r32, hi); ATT_MASK(pA0, pA1, 0); partialSM2<true>(pA0, pA1, m_reg, negm, alA);
    ATT_SWAIT(); ATT_SWRITE(1, 1); __syncthreads();
    int bprev = 0, bcur = 1, bnext = 2;
    for (int j = 1; j + 1 < NT; j += 2) {
        ASBAR(); qkt2<DQ>(pB0, pB1, K_lds + bcur * SHM_K, qr, negm, r32, hi);
        finishSM2(pA0, pA1, pa0, pa1, pa2, pa3); ASBAR();
        ATT_SLOAD(1, j + 2 < NT ? j + 2 : NT - 1); ASBAR();
        pv_all2(o, osum, vb0 + bprev * SHM_V, pa0, pa1, pa2, pa3); ATT_MASK(pB0, pB1, j); partialSM2<false>(pB0, pB1, m_reg, negm, alB);
        ATT_SWAIT(); ATT_SWRITE(bnext, 0);
        ATT_RESC(alB); __syncthreads();
        ASBAR(); qkt2<DQ>(pA0, pA1, K_lds + bnext * SHM_K, qr, negm, r32, hi);
        finishSM2(pB0, pB1, pa0, pa1, pa2, pa3); ASBAR();
        if (j + 3 < NT) ATT_SLOAD(0, j + 3); ASBAR();
        pv_all2(o, osum, vb0 + bcur * SHM_V, pa0, pa1, pa2, pa3); ATT_MASK(pA0, pA1, j + 1); partialSM2<false>(pA0, pA1, m_reg, negm, alA);
        ATT_SWAIT(); ATT_SWRITE(bprev, 1);
        ATT_RESC(alA); __syncthreads();
        { const int t_ = bprev; bprev = bnext; bnext = bcur; bcur = t_; }
    }
    ASBAR(); qkt2<DQ>(pB0, pB1, K_lds + bcur * SHM_K, qr, negm, r32, hi);
    finishSM2(pA0, pA1, pa0, pa1, pa2, pa3); ASBAR();
    pv_all2(o, osum, vb0 + bprev * SHM_V, pa0, pa1, pa2, pa3); ATT_MASK(pB0, pB1, NT - 1); partialSM2<false>(pB0, pB1, m_reg, negm, alB);
    ATT_RESC(alB);
    const size_t qrow = (size_t)(wid * 32 + r32); u32x4 gq[4];
#pragma unroll
    for (int k = 0; k < 4; ++k) gq[k] = *(const u32x4*)(U.gate + qrow * NKEEP + hi * 32 + k * 8);
    finishSM2(pB0, pB1, pa0, pa1, pa2, pa3); ASBAR();
    pv_all2(o, osum, vb0 + bcur * SHM_V, pa0, pa1, pa2, pa3);
    if (MODE == 1) {
        if (hi == 0) li_l[r32] = m_reg; asm volatile("s_waitcnt lgkmcnt(0)" ::: "memory");
#pragma unroll
        for (int r = 0; r < 16; ++r) osum[r] += __builtin_amdgcn_exp2f(U.sink_l2 - li_l[crow(r, hi)]); }
    float rli[16];
#pragma unroll
    for (int r = 0; r < 16; ++r) rli[r] = __builtin_amdgcn_rcpf(osum[r]);
    { char* tl = lds + 81920 + wid * 4608;
#pragma unroll
      for (int r = 0; r < 16; ++r) { const unsigned w_ = pk2bf(o[0][r] * rli[r], o[1][r] * rli[r]); bf16_t* tp = (bf16_t*)(tl + crow(r, hi) * 144) + r32; tp[0] = (bf16_t)(w_ & 0xffffu); tp[32] = (bf16_t)(w_ >> 16); }
      SB();
      u32x4 ov[4];
#pragma unroll
      for (int k = 0; k < 4; ++k) ov[k] = *(const u32x4*)(tl + r32 * 144 + hi * 64 + k * 16);
#pragma unroll
      for (int k = 0; k < 4; ++k) { u32x4 w;
#pragma unroll
          for (int e = 0; e < 4; ++e) { const unsigned vv = ov[k][e], gg = gq[k][e];
              w[e] = cvtpk(__uint_as_float(vv << 16) * silu_f(__uint_as_float(gg << 16)), __uint_as_float(vv & 0xffff0000u) * silu_f(__uint_as_float(gg & 0xffff0000u))); }
          *(u32x4*)(U.out + qrow * DM + hi * 32 + k * 8) = w; } }
    __builtin_amdgcn_s_setprio(0);
    __syncthreads();
#undef ATT_TROW
#undef ATT_CROW
#undef ATT_SLOAD
#undef ATT_SWRITE
#undef ATT_SWAIT
#undef ATT_RESC
#undef ATT_MASK
}
}

namespace attn_b {
using bf16=__hip_bfloat16;
using bf16x8=__attribute__((ext_vector_type(8)))short;
using s16x4=__attribute__((ext_vector_type(4)))short;
using f32x16=__attribute__((ext_vector_type(16)))float;
using u32x4=__attribute__((ext_vector_type(4)))unsigned;
constexpr int D=64;
constexpr int NW=8,QBLK=32,QB=QBLK*NW,KVBLK=64;
constexpr int ATTN_UNIT_ROWS=QB;
__device__ __forceinline__ int crow(int r,int hi){return (r&3)+8*(r>>2)+4*hi;}
#define SBAR() __builtin_amdgcn_sched_barrier(0)
__device__ __forceinline__ void cmask(f32x16&p0,f32x16&p1,int jb,int qrel,int hi){
  const float NEG=-INFINITY; int kb=64*jb+4*hi;
  #pragma unroll
  for(int r=0;r<16;++r){int kv=kb+(r&3)+8*(r>>2); if(kv>qrel)p0[r]=NEG; if(kv+32>qrel)p1[r]=NEG;}
}

constexpr int NSLOT=3, SLOTB=8192;
constexpr int LDS_K=0, LDS_V=NSLOT*SLOTB, LDS_WS=2*NSLOT*SLOTB, LDS_OST=LDS_WS+NW*64*4, LDS_BYTES=LDS_OST+NW*4096;
constexpr float C2=0.125f*1.4426950408889634f;
__device__ __forceinline__ void glds16(const void*gsrc,unsigned lds_dst){unsigned keep;
  asm volatile("s_mov_b32 %0, m0\n\ts_mov_b32 m0, %2\n\ts_nop 0\n\tglobal_load_lds_dwordx4 %1, off\n\ts_mov_b32 m0, %0":"=&s"(keep):"v"(gsrc),"s"(lds_dst):"memory");}
__device__ __forceinline__ float max3f(float a,float b,float c){float r;asm("v_max3_f32 %0, %1, %2, %3":"=v"(r):"v"(a),"v"(b),"v"(c));return r;}
__device__ __forceinline__ float max2f(float a,float b){float r;asm("v_max_f32_e32 %0, %1, %2":"=v"(r):"v"(a),"v"(b));return r;}
__device__ __forceinline__ float fadd_s(float a,float b){float r;asm("v_add_f32_e32 %0, %1, %2":"=v"(r):"v"(a),"v"(b));return r;}
__device__ __forceinline__ float fsub_s(float a,float b){float r;asm("v_sub_f32_e32 %0, %1, %2":"=v"(r):"v"(a),"v"(b));return r;}
typedef float f32x2_t __attribute__((ext_vector_type(2))); typedef __bf16 bf16x2_t __attribute__((ext_vector_type(2)));
__device__ __forceinline__ unsigned cvtpk_s(float lo,float hi){f32x2_t v={lo,hi};bf16x2_t b=__builtin_convertvector(v,bf16x2_t);return __builtin_bit_cast(unsigned,b);}
#define WAIT_BAR(N) asm volatile("s_waitcnt vmcnt(" #N ") lgkmcnt(0)\n\ts_barrier":::"memory")

__device__ __forceinline__ void qkt(f32x16&p0,f32x16&p1,const char*Kslot,const bf16x8*qr,const f32x16&negm,int r32,int hi){
  const char*kb=Kslot+hi*1024+r32*16;
  #pragma unroll
  for(int d0=0;d0<4;++d0){
    const bf16x8 b0=*reinterpret_cast<const bf16x8*>(kb+d0*2048);
    const bf16x8 b1=*reinterpret_cast<const bf16x8*>(kb+d0*2048+512);
    if(d0==0){p0=__builtin_amdgcn_mfma_f32_32x32x16_bf16(b0,qr[0],negm,0,0,0);p1=__builtin_amdgcn_mfma_f32_32x32x16_bf16(b1,qr[0],negm,0,0,0);}
    else{p0=__builtin_amdgcn_mfma_f32_32x32x16_bf16(b0,qr[d0],p0,0,0,0);p1=__builtin_amdgcn_mfma_f32_32x32x16_bf16(b1,qr[d0],p1,0,0,0);}}
}
typedef __attribute__((address_space(3))) const char* lds_cptr;
typedef short v4i16_t __attribute__((ext_vector_type(4)));
__device__ __forceinline__ void kload8(bf16x8*kf,lds_cptr kp){
  kf[0]=*(const __attribute__((address_space(3))) bf16x8*)(kp);      kf[1]=*(const __attribute__((address_space(3))) bf16x8*)(kp+512);
  kf[2]=*(const __attribute__((address_space(3))) bf16x8*)(kp+2048); kf[3]=*(const __attribute__((address_space(3))) bf16x8*)(kp+2560);
  kf[4]=*(const __attribute__((address_space(3))) bf16x8*)(kp+4096); kf[5]=*(const __attribute__((address_space(3))) bf16x8*)(kp+4608);
  kf[6]=*(const __attribute__((address_space(3))) bf16x8*)(kp+6144); kf[7]=*(const __attribute__((address_space(3))) bf16x8*)(kp+6656);
}
__device__ __forceinline__ void kload2(bf16x8*kf,lds_cptr kp,int j){ kf[2*j]=*(const __attribute__((address_space(3))) bf16x8*)(kp+j*2048); kf[2*j+1]=*(const __attribute__((address_space(3))) bf16x8*)(kp+j*2048+512); }
__device__ __forceinline__ s16x4 vtr(lds_cptr p){ return __builtin_bit_cast(s16x4,__builtin_amdgcn_ds_read_tr16_b64_v4i16((__attribute__((address_space(3))) v4i16_t*)p)); }
__device__ __forceinline__ float rowmax(const f32x16&p0,const f32x16&p1){
  float a=max3f(p0[0],p0[1],p1[0]),b=max3f(p0[2],p0[3],p1[1]);a=max3f(a,p1[2],p1[3]);
  #pragma unroll
  for(int r=4;r<16;r+=4){a=max3f(a,p0[r],p0[r+1]);b=max3f(b,p0[r+2],p0[r+3]);a=max3f(a,p1[r],p1[r+1]);b=max3f(b,p1[r+2],p1[r+3]);}
  const float m=max2f(a,b);
  auto rr=__builtin_amdgcn_permlane32_swap(__float_as_uint(m),__float_as_uint(m),false,false);
  return max2f(__uint_as_float(rr[0]),__uint_as_float(rr[1]));
}
__device__ __forceinline__ void pv(f32x16*o,int vb,bf16x8 pa0,bf16x8 pa1,bf16x8 pa2,bf16x8 pa3){
  #pragma unroll
  for(int d0=0;d0<2;++d0){s16x4 lo[4],hi[4];
    #pragma unroll
    for(int ks=0;ks<4;++ks){
      asm volatile("ds_read_b64_tr_b16 %0,%1 offset:%c2":"=&v"(lo[ks]):"v"(vb),"i"(d0*4096+ks*1024):"memory");
      asm volatile("ds_read_b64_tr_b16 %0,%1 offset:%c2":"=&v"(hi[ks]):"v"(vb),"i"(d0*4096+ks*1024+512):"memory");}
    asm volatile("s_waitcnt lgkmcnt(0)":::"memory");SBAR();
    #define PK(k) (bf16x8){lo[k][0],lo[k][1],lo[k][2],lo[k][3],hi[k][0],hi[k][1],hi[k][2],hi[k][3]}
    o[d0]=__builtin_amdgcn_mfma_f32_32x32x16_bf16(pa0,PK(0),o[d0],0,0,0);
    o[d0]=__builtin_amdgcn_mfma_f32_32x32x16_bf16(pa1,PK(1),o[d0],0,0,0);
    o[d0]=__builtin_amdgcn_mfma_f32_32x32x16_bf16(pa2,PK(2),o[d0],0,0,0);
    o[d0]=__builtin_amdgcn_mfma_f32_32x32x16_bf16(pa3,PK(3),o[d0],0,0,0);
    #undef PK
  }
}

#ifndef ATTN_STORE16
#define ATTN_STORE16(p,v) (*(u32x4*)(p)=(v))
#endif
template<int THRL,int LDI,int LDO> __device__ __forceinline__ void attn_unit(const bf16*Qb,const bf16*__restrict__ Kb,const bf16*__restrict__ Vb,const bf16*Gb,bf16*Ob,const int NT,char*shm){
  const int tid=tid512_fresh(),lane=tid&63,r32=lane&31,hi=lane>>5; const int wid=__builtin_amdgcn_readfirstlane(tid>>6);
  const bf16*Qw=Qb+(long)(wid*QBLK)*LDI;
  const bf16*Kh=Kb,*Vh=Vb;
  const unsigned lds0=(unsigned)(uintptr_t)shm;
  float*wsf=(float*)(shm+LDS_WS)+wid*64;
  const bf16*ksrc=Kh+(long)lane*LDI+wid*8;
  const bf16*vsrc=Vh+(long)(16*(wid&3)+(lane>>2))*LDI+(wid>>2)*32+(lane&3)*8;
  const unsigned kdst=lds0+LDS_K+wid*1024, vdst=lds0+LDS_V+wid*1024;
  #define DMA_K(t,slot) glds16(ksrc+(long)(t)*KVBLK*LDI,(unsigned)__builtin_amdgcn_readfirstlane(kdst+(slot)))
  #define DMA_V(t,slot) glds16(vsrc+(long)(t)*KVBLK*LDI,(unsigned)__builtin_amdgcn_readfirstlane(vdst+(slot)))
  const int vb0=(int)(lds0+LDS_V)+((lane>>4)&1)*32+(lane&3)*8+(4*hi+((lane&15)>>2))*64;
  const char*Kbase=shm+LDS_K; bf16x8 kf[8];
  const lds_cptr shm3=(lds_cptr)shm; const lds_cptr kp0=shm3+LDS_K+hi*1024+r32*16; const lds_cptr vp0=shm3+LDS_V+((lane>>4)&1)*32+(lane&3)*8+(4*hi+((lane&15)>>2))*64;
  DMA_K(0,0);DMA_V(0,0);DMA_K(1,SLOTB);
  bf16x8 qr[4];
  #pragma unroll
  for(int d0=0;d0<4;++d0)qr[d0]=*reinterpret_cast<const bf16x8*>(&Qw[(long)r32*LDI+d0*16+hi*8]);
  float mhat=0.f,l_reg=0.f;f32x16 o[2];o[0]=f32x16{};o[1]=f32x16{};f32x16 negm=f32x16{};asm volatile("":"+v"(negm));
  #define CMASK(P0,P1,t) do{}while(0)
  bool resc=false;
  #define START(P0,P1) do{ const float rm=rowmax(P0,P1); resc=false; \
    { const float dl=rm; mhat=fadd_s(mhat,dl); \
      _Pragma("unroll") for(int r=0;r<16;++r){P0[r]=fsub_s(P0[r],dl);P1[r]=fsub_s(P1[r],dl);} \
      _Pragma("unroll") for(int r=0;r<16;++r)negm[r]=-mhat; asm volatile("":"+v"(negm)); } \
    _Pragma("unroll") for(int r=0;r<16;++r)P0[r]=__builtin_amdgcn_exp2f(P0[r]); }while(0)
  #define RESC() do{ if(resc){ asm volatile("s_waitcnt lgkmcnt(0)":::"memory"); \
      _Pragma("unroll") for(int d_=0;d_<2;++d_) _Pragma("unroll") for(int r=0;r<16;++r)o[d_][r]*=wsf[crow(r,hi)]; } }while(0)
  f32x16 pA0,pA1,pB0,pB1;
  int sl_prev=0,sl_cur=0,sl_next=SLOTB;
  #define ROT() do{sl_prev=sl_cur;sl_cur=sl_next;sl_next=(sl_next==(NSLOT-1)*SLOTB)?0:sl_next+SLOTB;}while(0)
  DMA_K(2,2*SLOTB);
  WAIT_BAR(3);
  qkt(pA0,pA1,Kbase,qr,negm,r32,hi);asm volatile("s_nop 15\n\ts_nop 7":"+v"(pA0),"+v"(pA1));CMASK(pA0,pA1,0);
  START(pA0,pA1);
  _Pragma("unroll") for(int r=0;r<16;++r)pA1[r]=__builtin_amdgcn_exp2f(pA1[r]);
  WAIT_BAR(0);
  DMA_K(3,0);DMA_V(1,SLOTB);
  ROT();
  kload8(kf,kp0+sl_cur);
  WAIT_BAR(2);
  s16x4 vlo[8],vhi[8]; u32x4 pw0,pw1,pw2,pw3;
  #define PKW(P,B) cvtpk_s(P[B],P[B+1])
  #define PAF(k) __builtin_bit_cast(bf16x8,pw##k)
  #define VFR(i) (bf16x8){vlo[i][0],vlo[i][1],vlo[i][2],vlo[i][3],vhi[i][0],vhi[i][1],vhi[i][2],vhi[i][3]}
  #define PIN(x) asm volatile("":"+v"(x))
  #define MX3(a,b,c) __builtin_fmaxf(__builtin_fmaxf((a),(b)),(c))
  #define GAPA(MF,A0,A1,A2,A3,W0,W1,PW) do{ MF; sacc+=A0; sacc+=A1; sacc+=A2; sacc+=A3; PIN(sacc); W0; W1; PIN(PW); SBAR(); }while(0)
  #define EX(v) __builtin_amdgcn_exp2f(v)
  #define GAPB(MF,X,B) do{ MF; X[B]=EX(X[B]); X[B+1]=EX(X[B+1]); X[B+2]=EX(X[B+2]); X[B+3]=EX(X[B+3]); PIN(X); SBAR(); }while(0)
  #define VRD(i) do{ vlo[i]=vtr(vp_+(((i)>>2)*4096+((i)&3)*1024)); vhi[i]=vtr(vp_+(((i)>>2)*4096+((i)&3)*1024+512)); }while(0)
  #define KRD(G,j) do{ if(G){ kload2(kf,kp0+sl_next,j); SBAR(); } }while(0)
  #define STEP(C0,C1,P0,P1,t,GK,GV,GL) do{ SBAR(); \
    const lds_cptr vp_=vp0+sl_prev; \
    VRD(0); SBAR(); float sacc=(P0[0]+P0[1]); \
    GAPA(C0=__builtin_amdgcn_mfma_f32_32x32x16_bf16(kf[0],qr[0],negm,0,0,0), P0[2],P0[3],P0[4],P0[5],     pw0[0]=PKW(P0,0), pw0[1]=PKW(P0,2), pw0); \
    VRD(4); SBAR(); GAPA(C1=__builtin_amdgcn_mfma_f32_32x32x16_bf16(kf[1],qr[0],negm,0,0,0), P0[6],P0[7],P0[8],P0[9],     pw0[2]=PKW(P0,4), pw0[3]=PKW(P0,6), pw0); \
    VRD(1); SBAR(); GAPA(C0=__builtin_amdgcn_mfma_f32_32x32x16_bf16(kf[2],qr[1],C0,0,0,0),   P0[10],P0[11],P0[12],P0[13], pw1[0]=PKW(P0,8), pw1[1]=PKW(P0,10), pw1); \
    VRD(5); SBAR(); GAPA(C1=__builtin_amdgcn_mfma_f32_32x32x16_bf16(kf[3],qr[1],C1,0,0,0),   P0[14],P0[15],P1[0],P1[1],   pw1[2]=PKW(P0,12),pw1[3]=PKW(P0,14), pw1); \
    VRD(2); SBAR(); GAPA(C0=__builtin_amdgcn_mfma_f32_32x32x16_bf16(kf[4],qr[2],C0,0,0,0),   P1[2],P1[3],P1[4],P1[5],     pw2[0]=PKW(P1,0), pw2[1]=PKW(P1,2), pw2); \
    VRD(6); SBAR(); GAPA(C1=__builtin_amdgcn_mfma_f32_32x32x16_bf16(kf[5],qr[2],C1,0,0,0),   P1[6],P1[7],P1[8],P1[9],     pw2[2]=PKW(P1,4), pw2[3]=PKW(P1,6), pw2); \
    VRD(3); SBAR(); GAPA(C0=__builtin_amdgcn_mfma_f32_32x32x16_bf16(kf[6],qr[3],C0,0,0,0),   P1[10],P1[11],P1[12],P1[13], pw3[0]=PKW(P1,8), pw3[1]=PKW(P1,10), pw3); \
    VRD(7); SBAR(); GAPA(C1=__builtin_amdgcn_mfma_f32_32x32x16_bf16(kf[7],qr[3],C1,0,0,0),   P1[14],P1[15],0.f,0.f,       pw3[2]=PKW(P1,12),pw3[3]=PKW(P1,14), pw3); \
    l_reg+=sacc; \
    if(GK){DMA_K((t)+3,sl_cur);} if(GV){DMA_V((t)+1,sl_next);} \
    CMASK(C0,C1,t); \
    { float a=MX3(C0[0],C0[1],C1[0]),b=MX3(C0[2],C0[3],C1[1]); a=MX3(a,C1[2],C1[3]); \
      _Pragma("unroll") for(int r=4;r<16;r+=4){a=MX3(a,C0[r],C0[r+1]);b=MX3(b,C0[r+2],C0[r+3]);a=MX3(a,C1[r],C1[r+1]);b=MX3(b,C1[r+2],C1[r+3]);} \
      float rm=__builtin_fmaxf(a,b); { auto rr=__builtin_amdgcn_permlane32_swap(__float_as_uint(rm),__float_as_uint(rm),false,false); rm=__builtin_fmaxf(__uint_as_float(rr[0]),__uint_as_float(rr[1])); } \
      resc=false; \
      if(__builtin_expect(__any(rm>(float)THRL),0)){ const float dl=__builtin_fmaxf(rm,0.f); mhat+=dl; \
        _Pragma("unroll") for(int r=0;r<16;++r){C0[r]-=dl;C1[r]-=dl;} \
        _Pragma("unroll") for(int r=0;r<16;++r)negm[r]=-mhat; asm volatile("":"+v"(negm)); \
        const float f=__builtin_amdgcn_exp2f(-dl); l_reg*=f; if(hi==0)wsf[r32]=f; resc=true; } } \
    SBAR(); \
    GAPB(o[0]=__builtin_amdgcn_mfma_f32_32x32x16_bf16(PAF(0),VFR(0),o[0],0,0,0), C0,0); \
    GAPB(o[1]=__builtin_amdgcn_mfma_f32_32x32x16_bf16(PAF(0),VFR(4),o[1],0,0,0), C0,4); \
    KRD(GL,0); GAPB(o[0]=__builtin_amdgcn_mfma_f32_32x32x16_bf16(PAF(1),VFR(1),o[0],0,0,0), C0,8); \
    KRD(GL,1); GAPB(o[1]=__builtin_amdgcn_mfma_f32_32x32x16_bf16(PAF(1),VFR(5),o[1],0,0,0), C0,12); \
    KRD(GL,2); GAPB(o[0]=__builtin_amdgcn_mfma_f32_32x32x16_bf16(PAF(2),VFR(2),o[0],0,0,0), C1,0); \
    KRD(GL,3); GAPB(o[1]=__builtin_amdgcn_mfma_f32_32x32x16_bf16(PAF(2),VFR(6),o[1],0,0,0), C1,4); \
    GAPB(o[0]=__builtin_amdgcn_mfma_f32_32x32x16_bf16(PAF(3),VFR(3),o[0],0,0,0), C1,8); \
    GAPB(o[1]=__builtin_amdgcn_mfma_f32_32x32x16_bf16(PAF(3),VFR(7),o[1],0,0,0), C1,12); \
    }while(0)
  int t=1;
  #undef CMASK
  #define CMASK(P0,P1,t) do{}while(0)
  for(;t+5<NT;t+=2){
    STEP(pB0,pB1,pA0,pA1,t,true,true,true);     WAIT_BAR(2); RESC(); ROT();
    STEP(pA0,pA1,pB0,pB1,t+1,true,true,true);   WAIT_BAR(2); RESC(); ROT();
  }
  #undef CMASK
  #define CMASK(P0,P1,t) do{}while(0)
  #define ENDW(tt) do{ if((tt)+3<NT){WAIT_BAR(2);} else if((tt)+2<NT){WAIT_BAR(1);} else {WAIT_BAR(0);} }while(0)
  for(;t+1<NT;t+=2){
    STEP(pB0,pB1,pA0,pA1,t,(t+3<NT),(t+1<NT),(t+1<NT));       ENDW(t);   RESC(); ROT();
    STEP(pA0,pA1,pB0,pB1,t+1,(t+4<NT),(t+2<NT),(t+2<NT));     ENDW(t+1); RESC(); ROT();
  }
  STEP(pB0,pB1,pA0,pA1,NT-1,false,false,false); RESC();
  { float sacc=pB0[0]+pB0[1]; _Pragma("unroll") for(int r=2;r<16;++r)sacc+=pB0[r]; _Pragma("unroll") for(int r=0;r<16;++r)sacc+=pB1[r]; l_reg+=sacc;
    pw0=(u32x4){PKW(pB0,0),PKW(pB0,2),PKW(pB0,4),PKW(pB0,6)};pw1=(u32x4){PKW(pB0,8),PKW(pB0,10),PKW(pB0,12),PKW(pB0,14)};pw2=(u32x4){PKW(pB1,0),PKW(pB1,2),PKW(pB1,4),PKW(pB1,6)};pw3=(u32x4){PKW(pB1,8),PKW(pB1,10),PKW(pB1,12),PKW(pB1,14)};
    SBAR(); pv(o,vb0+sl_cur,PAF(0),PAF(1),PAF(2),PAF(3)); }
  #undef PKW
  #undef PAF
  #undef VFR
  #undef PIN
  #undef MX3
  #undef GAPA
  #undef GAPB
  #undef EX
  #undef VRD
  #undef KRD
  #undef STEP
  #undef ENDW
  {auto rr=__builtin_amdgcn_permlane32_swap(__float_as_uint(l_reg),__float_as_uint(l_reg),false,false);l_reg=__uint_as_float(rr[0])+__uint_as_float(rr[1]);}
  if(hi==0)wsf[32+r32]=l_reg;asm volatile("s_waitcnt lgkmcnt(0)":::"memory");
  float rli[16];
  #pragma unroll
  for(int r=0;r<16;++r)rli[r]=__builtin_amdgcn_rcpf(wsf[32+crow(r,hi)]);
  bf16*Ow=Ob+(long)(wid*QBLK)*LDO; const bf16*Gw=Gb+(long)(wid*QBLK)*LDI;
  { bf16*stg=(bf16*)(shm+LDS_OST)+wid*2048;
    #pragma unroll
    for(int r=0;r<16;++r){const int orow=crow(r,hi);
      #pragma unroll
      for(int d0=0;d0<2;++d0)stg[orow*64+d0*32+r32]=__float2bfloat16(o[d0][r]*rli[r]);}
    asm volatile("s_waitcnt lgkmcnt(0)":::"memory");
    #pragma unroll
    for(int i=0;i<4;++i){const int row=i*8+(lane>>3),ch=lane&7; const u32x4 v=*(const u32x4*)(stg+row*64+ch*8); const u32x4 g=*(const u32x4*)(Gw+(long)row*LDI+ch*8); u32x4 w;
      #pragma unroll
      for(int e=0;e<4;++e){ const float v0=__uint_as_float(v[e]<<16),v1=__uint_as_float(v[e]&0xffff0000u),g0=__uint_as_float(g[e]<<16),g1=__uint_as_float(g[e]&0xffff0000u);
        w[e]=cvtpk_s(v0*g0*__builtin_amdgcn_rcpf(1.f+__expf(-g0)),v1*g1*__builtin_amdgcn_rcpf(1.f+__expf(-g1))); }
      ATTN_STORE16(Ow+(long)row*LDO+ch*8,w);} }
  asm volatile("s_waitcnt lgkmcnt(0)\n\ts_barrier":::"memory");
  #undef DMA_K
  #undef DMA_V
  #undef CMASK
  #undef START
  #undef RESC
  #undef ROT
}
constexpr int ATTN_LDS_BYTES=LDS_BYTES;
#undef SBAR
#undef WAIT_BAR
}

namespace attn_a {
using bf16=__hip_bfloat16;
using bf16x8=__attribute__((ext_vector_type(8)))short;
using s16x4=__attribute__((ext_vector_type(4)))short;
using f32x16=__attribute__((ext_vector_type(16)))float;
using u32x4=__attribute__((ext_vector_type(4)))unsigned;
constexpr int D=64;
constexpr int NW=8,QBLK=32,QB=QBLK*NW,KVBLK=64;
constexpr int ATTN_UNIT_ROWS=QB;
__device__ __forceinline__ int crow(int r,int hi){return (r&3)+8*(r>>2)+4*hi;}
#define SBAR() __builtin_amdgcn_sched_barrier(0)
__device__ __forceinline__ void cmask(f32x16&p0,f32x16&p1,int jb,int qrel,int hi){
  const float NEG=-INFINITY; int kb=64*jb+4*hi;
  #pragma unroll
  for(int r=0;r<16;++r){int kv=kb+(r&3)+8*(r>>2); if(kv>qrel)p0[r]=NEG; if(kv+32>qrel)p1[r]=NEG;}
}

constexpr int NSLOT=3, SLOTB=8192, KSLOT=12288;
constexpr int LDS_K=0, LDS_V=NSLOT*KSLOT, LDS_WS=NSLOT*KSLOT+NSLOT*SLOTB, LDS_OST=LDS_WS+NW*64*4, LDS_BYTES=LDS_OST+NW*4096;
constexpr float C2=0.125f*1.4426950408889634f;
__device__ __forceinline__ void glds16(const void*gsrc,unsigned lds_dst){unsigned keep;
  asm volatile("s_mov_b32 %0, m0\n\ts_mov_b32 m0, %2\n\ts_nop 0\n\tglobal_load_lds_dwordx4 %1, off\n\ts_mov_b32 m0, %0":"=&s"(keep):"v"(gsrc),"s"(lds_dst):"memory");}
__device__ __forceinline__ float max3f(float a,float b,float c){float r;asm("v_max3_f32 %0, %1, %2, %3":"=v"(r):"v"(a),"v"(b),"v"(c));return r;}
__device__ __forceinline__ float max2f(float a,float b){float r;asm("v_max_f32_e32 %0, %1, %2":"=v"(r):"v"(a),"v"(b));return r;}
__device__ __forceinline__ float fadd_s(float a,float b){float r;asm("v_add_f32_e32 %0, %1, %2":"=v"(r):"v"(a),"v"(b));return r;}
__device__ __forceinline__ float fsub_s(float a,float b){float r;asm("v_sub_f32_e32 %0, %1, %2":"=v"(r):"v"(a),"v"(b));return r;}
typedef float f32x2_t __attribute__((ext_vector_type(2))); typedef __bf16 bf16x2_t __attribute__((ext_vector_type(2)));
__device__ __forceinline__ unsigned cvtpk_s(float lo,float hi){f32x2_t v={lo,hi};bf16x2_t b=__builtin_convertvector(v,bf16x2_t);return __builtin_bit_cast(unsigned,b);}
#define KS(s) ((s)+((s)>>1))
#define WAIT_BAR(N) asm volatile("s_waitcnt vmcnt(" #N ") lgkmcnt(0)\n\ts_barrier":::"memory")

__device__ __forceinline__ void qkt(f32x16&p0,f32x16&p1,const char*Kslot,const bf16x8*qr,const f32x16&negm,int r32,int hi){
  const char*kb=Kslot+hi*1024+r32*16;
  #pragma unroll
  for(int d0=0;d0<6;++d0){
    const bf16x8 b0=*reinterpret_cast<const bf16x8*>(kb+d0*2048);
    const bf16x8 b1=*reinterpret_cast<const bf16x8*>(kb+d0*2048+512);
    if(d0==0){p0=__builtin_amdgcn_mfma_f32_32x32x16_bf16(b0,qr[0],negm,0,0,0);p1=__builtin_amdgcn_mfma_f32_32x32x16_bf16(b1,qr[0],negm,0,0,0);}
    else{p0=__builtin_amdgcn_mfma_f32_32x32x16_bf16(b0,qr[d0],p0,0,0,0);p1=__builtin_amdgcn_mfma_f32_32x32x16_bf16(b1,qr[d0],p1,0,0,0);}}
}
typedef __attribute__((address_space(3))) const char* lds_cptr;
typedef short v4i16_t __attribute__((ext_vector_type(4)));
__device__ __forceinline__ void kload8(bf16x8*kf,lds_cptr kp){
  kf[0]=*(const __attribute__((address_space(3))) bf16x8*)(kp);      kf[1]=*(const __attribute__((address_space(3))) bf16x8*)(kp+512);
  kf[2]=*(const __attribute__((address_space(3))) bf16x8*)(kp+2048); kf[3]=*(const __attribute__((address_space(3))) bf16x8*)(kp+2560);
  kf[4]=*(const __attribute__((address_space(3))) bf16x8*)(kp+4096); kf[5]=*(const __attribute__((address_space(3))) bf16x8*)(kp+4608);
  kf[6]=*(const __attribute__((address_space(3))) bf16x8*)(kp+6144); kf[7]=*(const __attribute__((address_space(3))) bf16x8*)(kp+6656);
  kf[8]=*(const __attribute__((address_space(3))) bf16x8*)(kp+8192); kf[9]=*(const __attribute__((address_space(3))) bf16x8*)(kp+8704);
  kf[10]=*(const __attribute__((address_space(3))) bf16x8*)(kp+10240); kf[11]=*(const __attribute__((address_space(3))) bf16x8*)(kp+10752);
}
__device__ __forceinline__ void kload2(bf16x8*kf,lds_cptr kp,int j){ kf[2*j]=*(const __attribute__((address_space(3))) bf16x8*)(kp+j*2048); kf[2*j+1]=*(const __attribute__((address_space(3))) bf16x8*)(kp+j*2048+512); }
__device__ __forceinline__ s16x4 vtr(lds_cptr p){ return __builtin_bit_cast(s16x4,__builtin_amdgcn_ds_read_tr16_b64_v4i16((__attribute__((address_space(3))) v4i16_t*)p)); }
__device__ __forceinline__ float rowmax(const f32x16&p0,const f32x16&p1){
  float a=max3f(p0[0],p0[1],p1[0]),b=max3f(p0[2],p0[3],p1[1]);a=max3f(a,p1[2],p1[3]);
  #pragma unroll
  for(int r=4;r<16;r+=4){a=max3f(a,p0[r],p0[r+1]);b=max3f(b,p0[r+2],p0[r+3]);a=max3f(a,p1[r],p1[r+1]);b=max3f(b,p1[r+2],p1[r+3]);}
  const float m=max2f(a,b);
  auto rr=__builtin_amdgcn_permlane32_swap(__float_as_uint(m),__float_as_uint(m),false,false);
  return max2f(__uint_as_float(rr[0]),__uint_as_float(rr[1]));
}
__device__ __forceinline__ void pv(f32x16*o,int vb,bf16x8 pa0,bf16x8 pa1,bf16x8 pa2,bf16x8 pa3){
  #pragma unroll
  for(int d0=0;d0<2;++d0){s16x4 lo[4],hi[4];
    #pragma unroll
    for(int ks=0;ks<4;++ks){
      asm volatile("ds_read_b64_tr_b16 %0,%1 offset:%c2":"=&v"(lo[ks]):"v"(vb),"i"(d0*4096+ks*1024):"memory");
      asm volatile("ds_read_b64_tr_b16 %0,%1 offset:%c2":"=&v"(hi[ks]):"v"(vb),"i"(d0*4096+ks*1024+512):"memory");}
    asm volatile("s_waitcnt lgkmcnt(0)":::"memory");SBAR();
    #define PK(k) (bf16x8){lo[k][0],lo[k][1],lo[k][2],lo[k][3],hi[k][0],hi[k][1],hi[k][2],hi[k][3]}
    o[d0]=__builtin_amdgcn_mfma_f32_32x32x16_bf16(pa0,PK(0),o[d0],0,0,0);
    o[d0]=__builtin_amdgcn_mfma_f32_32x32x16_bf16(pa1,PK(1),o[d0],0,0,0);
    o[d0]=__builtin_amdgcn_mfma_f32_32x32x16_bf16(pa2,PK(2),o[d0],0,0,0);
    o[d0]=__builtin_amdgcn_mfma_f32_32x32x16_bf16(pa3,PK(3),o[d0],0,0,0);
    #undef PK
  }
}

#ifndef ATTN_STORE16
#define ATTN_STORE16(p,v) (*(u32x4*)(p)=(v))
#endif
template<int THRL,int LDQ,int LDK,int LDV,int LDG,int LDO> __device__ __forceinline__ void attn_unit(const bf16*Qb,const bf16*__restrict__ Kb,const bf16*__restrict__ Vb,const bf16*Gb,bf16*Ob,const int NT,char*shm){
  const int tid=tid512_fresh(),lane=tid&63,r32=lane&31,hi=lane>>5; const int wid=__builtin_amdgcn_readfirstlane(tid>>6);
  const bf16*Qw=Qb+(long)(wid*QBLK)*LDQ;
  const bf16*Kh=Kb,*Vh=Vb;
  const unsigned lds0=(unsigned)(uintptr_t)shm;
  float*wsf=(float*)(shm+LDS_WS)+wid*64;
  const bf16*ksrc=Kh+(long)lane*LDK+wid*8; const bf16*ksrc2=Kh+(long)lane*LDK+(8+(wid&3))*8;
  const bf16*vsrc=Vh+(long)(16*(wid&3)+(lane>>2))*LDV+(wid>>2)*32+(lane&3)*8;
  const unsigned kdst=lds0+LDS_K+wid*1024, kdst2=lds0+LDS_K+(8+(wid&3))*1024, vdst=lds0+LDS_V+wid*1024;
  #define DMA_K(t,slot) do{ glds16(ksrc+(long)(t)*KVBLK*LDK,(unsigned)__builtin_amdgcn_readfirstlane(kdst+KS(slot))); glds16(ksrc2+(long)(t)*KVBLK*LDK,(unsigned)__builtin_amdgcn_readfirstlane(kdst2+KS(slot))); }while(0)
  #define DMA_V(t,slot) glds16(vsrc+(long)(t)*KVBLK*LDV,(unsigned)__builtin_amdgcn_readfirstlane(vdst+(slot)))
  const int vb0=(int)(lds0+LDS_V)+((lane>>4)&1)*32+(lane&3)*8+(4*hi+((lane&15)>>2))*64;
  const char*Kbase=shm+LDS_K; bf16x8 kf[12];
  const lds_cptr shm3=(lds_cptr)shm; const lds_cptr kp0=shm3+LDS_K+hi*1024+r32*16; const lds_cptr vp0=shm3+LDS_V+((lane>>4)&1)*32+(lane&3)*8+(4*hi+((lane&15)>>2))*64;
  DMA_K(0,0);DMA_V(0,0);DMA_K(1,SLOTB);
  bf16x8 qr[6];
  #pragma unroll
  for(int d0=0;d0<6;++d0)qr[d0]=*reinterpret_cast<const bf16x8*>(&Qw[(long)r32*LDQ+d0*16+hi*8]);
  float mhat=0.f,l_reg=0.f;f32x16 o[2];o[0]=f32x16{};o[1]=f32x16{};f32x16 negm=f32x16{};asm volatile("":"+v"(negm));
  #define CMASK(P0,P1,t) do{}while(0)
  bool resc=false;
  #define START(P0,P1) do{ const float rm=rowmax(P0,P1); resc=false; \
    { const float dl=rm; mhat=fadd_s(mhat,dl); \
      _Pragma("unroll") for(int r=0;r<16;++r){P0[r]=fsub_s(P0[r],dl);P1[r]=fsub_s(P1[r],dl);} \
      _Pragma("unroll") for(int r=0;r<16;++r)negm[r]=-mhat; asm volatile("":"+v"(negm)); } \
    _Pragma("unroll") for(int r=0;r<16;++r)P0[r]=__builtin_amdgcn_exp2f(P0[r]); }while(0)
  #define RESC() do{ if(resc){ asm volatile("s_waitcnt lgkmcnt(0)":::"memory"); \
      _Pragma("unroll") for(int d_=0;d_<2;++d_) _Pragma("unroll") for(int r=0;r<16;++r)o[d_][r]*=wsf[crow(r,hi)]; } }while(0)
  f32x16 pA0,pA1,pB0,pB1;
  int sl_prev=0,sl_cur=0,sl_next=SLOTB;
  #define ROT() do{sl_prev=sl_cur;sl_cur=sl_next;sl_next=(sl_next==(NSLOT-1)*SLOTB)?0:sl_next+SLOTB;}while(0)
  DMA_K(2,2*SLOTB);
  WAIT_BAR(5);
  qkt(pA0,pA1,Kbase,qr,negm,r32,hi);asm volatile("s_nop 15\n\ts_nop 7":"+v"(pA0),"+v"(pA1));CMASK(pA0,pA1,0);
  START(pA0,pA1);
  _Pragma("unroll") for(int r=0;r<16;++r)pA1[r]=__builtin_amdgcn_exp2f(pA1[r]);
  WAIT_BAR(0);
  DMA_K(3,0);DMA_V(1,SLOTB);
  ROT();
  kload8(kf,kp0+KS(sl_cur));
  WAIT_BAR(3);
  s16x4 vlo[8],vhi[8]; u32x4 pw0,pw1,pw2,pw3;
  #define PKW(P,B) cvtpk_s(P[B],P[B+1])
  #define PAF(k) __builtin_bit_cast(bf16x8,pw##k)
  #define VFR(i) (bf16x8){vlo[i][0],vlo[i][1],vlo[i][2],vlo[i][3],vhi[i][0],vhi[i][1],vhi[i][2],vhi[i][3]}
  #define PIN(x) asm volatile("":"+v"(x))
  #define MX3(a,b,c) __builtin_fmaxf(__builtin_fmaxf((a),(b)),(c))
  #define GAPA(MF,A0,A1,A2,A3,W0,W1,PW) do{ MF; sacc+=A0; sacc+=A1; sacc+=A2; sacc+=A3; PIN(sacc); W0; W1; PIN(PW); SBAR(); }while(0)
  #define EX(v) __builtin_amdgcn_exp2f(v)
  #define GAPB(MF,X,B) do{ MF; X[B]=EX(X[B]); X[B+1]=EX(X[B+1]); X[B+2]=EX(X[B+2]); X[B+3]=EX(X[B+3]); PIN(X); SBAR(); }while(0)
  #define VRD(i) do{ vlo[i]=vtr(vp_+(((i)>>2)*4096+((i)&3)*1024)); vhi[i]=vtr(vp_+(((i)>>2)*4096+((i)&3)*1024+512)); }while(0)
  #define KRD(G,j) do{ if(G){ kload2(kf,kp0+KS(sl_next),j); SBAR(); } }while(0)
  #define STEP(C0,C1,P0,P1,t,GK,GV,GL) do{ SBAR(); \
    const lds_cptr vp_=vp0+sl_prev; \
    VRD(0); SBAR(); float sacc=(P0[0]+P0[1]); \
    GAPA(C0=__builtin_amdgcn_mfma_f32_32x32x16_bf16(kf[0],qr[0],negm,0,0,0), P0[2],P0[3],P0[4],P0[5],     pw0[0]=PKW(P0,0), pw0[1]=PKW(P0,2), pw0); \
    VRD(4); SBAR(); GAPA(C1=__builtin_amdgcn_mfma_f32_32x32x16_bf16(kf[1],qr[0],negm,0,0,0), P0[6],P0[7],P0[8],P0[9],     pw0[2]=PKW(P0,4), pw0[3]=PKW(P0,6), pw0); \
    VRD(1); SBAR(); GAPA(C0=__builtin_amdgcn_mfma_f32_32x32x16_bf16(kf[2],qr[1],C0,0,0,0),   P0[10],P0[11],P0[12],P0[13], pw1[0]=PKW(P0,8), pw1[1]=PKW(P0,10), pw1); \
    VRD(5); SBAR(); GAPA(C1=__builtin_amdgcn_mfma_f32_32x32x16_bf16(kf[3],qr[1],C1,0,0,0),   P0[14],P0[15],P1[0],P1[1],   pw1[2]=PKW(P0,12),pw1[3]=PKW(P0,14), pw1); \
    VRD(2); SBAR(); GAPA(C0=__builtin_amdgcn_mfma_f32_32x32x16_bf16(kf[4],qr[2],C0,0,0,0),   P1[2],P1[3],P1[4],P1[5],     pw2[0]=PKW(P1,0), pw2[1]=PKW(P1,2), pw2); \
    VRD(6); SBAR(); GAPA(C1=__builtin_amdgcn_mfma_f32_32x32x16_bf16(kf[5],qr[2],C1,0,0,0),   P1[6],P1[7],P1[8],P1[9],     pw2[2]=PKW(P1,4), pw2[3]=PKW(P1,6), pw2); \
    VRD(3); SBAR(); GAPA(C0=__builtin_amdgcn_mfma_f32_32x32x16_bf16(kf[6],qr[3],C0,0,0,0),   P1[10],P1[11],P1[12],P1[13], pw3[0]=PKW(P1,8), pw3[1]=PKW(P1,10), pw3); \
    VRD(7); SBAR(); GAPA(C1=__builtin_amdgcn_mfma_f32_32x32x16_bf16(kf[7],qr[3],C1,0,0,0),   P1[14],P1[15],0.f,0.f,       pw3[2]=PKW(P1,12),pw3[3]=PKW(P1,14), pw3); \
    C0=__builtin_amdgcn_mfma_f32_32x32x16_bf16(kf[8],qr[4],C0,0,0,0); C1=__builtin_amdgcn_mfma_f32_32x32x16_bf16(kf[9],qr[4],C1,0,0,0); SBAR(); \
    C0=__builtin_amdgcn_mfma_f32_32x32x16_bf16(kf[10],qr[5],C0,0,0,0); C1=__builtin_amdgcn_mfma_f32_32x32x16_bf16(kf[11],qr[5],C1,0,0,0); SBAR(); \
    l_reg+=sacc; \
    if(GK){DMA_K((t)+3,sl_cur);} if(GV){DMA_V((t)+1,sl_next);} \
    CMASK(C0,C1,t); \
    { float a=MX3(C0[0],C0[1],C1[0]),b=MX3(C0[2],C0[3],C1[1]); a=MX3(a,C1[2],C1[3]); \
      _Pragma("unroll") for(int r=4;r<16;r+=4){a=MX3(a,C0[r],C0[r+1]);b=MX3(b,C0[r+2],C0[r+3]);a=MX3(a,C1[r],C1[r+1]);b=MX3(b,C1[r+2],C1[r+3]);} \
      float rm=__builtin_fmaxf(a,b); { auto rr=__builtin_amdgcn_permlane32_swap(__float_as_uint(rm),__float_as_uint(rm),false,false); rm=__builtin_fmaxf(__uint_as_float(rr[0]),__uint_as_float(rr[1])); } \
      resc=false; \
      if(__builtin_expect(__any(rm>(float)THRL),0)){ const float dl=__builtin_fmaxf(rm,0.f); mhat+=dl; \
        _Pragma("unroll") for(int r=0;r<16;++r){C0[r]-=dl;C1[r]-=dl;} \
        _Pragma("unroll") for(int r=0;r<16;++r)negm[r]=-mhat; asm volatile("":"+v"(negm)); \
        const float f=__builtin_amdgcn_exp2f(-dl); l_reg*=f; if(hi==0)wsf[r32]=f; resc=true; } } \
    SBAR(); \
    GAPB(o[0]=__builtin_amdgcn_mfma_f32_32x32x16_bf16(PAF(0),VFR(0),o[0],0,0,0), C0,0); \
    GAPB(o[1]=__builtin_amdgcn_mfma_f32_32x32x16_bf16(PAF(0),VFR(4),o[1],0,0,0), C0,4); \
    KRD(GL,0); GAPB(o[0]=__builtin_amdgcn_mfma_f32_32x32x16_bf16(PAF(1),VFR(1),o[0],0,0,0), C0,8); \
    KRD(GL,1); GAPB(o[1]=__builtin_amdgcn_mfma_f32_32x32x16_bf16(PAF(1),VFR(5),o[1],0,0,0), C0,12); \
    KRD(GL,2); GAPB(o[0]=__builtin_amdgcn_mfma_f32_32x32x16_bf16(PAF(2),VFR(2),o[0],0,0,0), C1,0); \
    KRD(GL,3); GAPB(o[1]=__builtin_amdgcn_mfma_f32_32x32x16_bf16(PAF(2),VFR(6),o[1],0,0,0), C1,4); \
    KRD(GL,4); GAPB(o[0]=__builtin_amdgcn_mfma_f32_32x32x16_bf16(PAF(3),VFR(3),o[0],0,0,0), C1,8); \
    KRD(GL,5); GAPB(o[1]=__builtin_amdgcn_mfma_f32_32x32x16_bf16(PAF(3),VFR(7),o[1],0,0,0), C1,12); \
    }while(0)
  int t=1;
  #undef CMASK
  #define CMASK(P0,P1,t) do{}while(0)
  for(;t+5<NT;t+=2){
    STEP(pB0,pB1,pA0,pA1,t,true,true,true);     WAIT_BAR(3); RESC(); ROT();
    STEP(pA0,pA1,pB0,pB1,t+1,true,true,true);   WAIT_BAR(3); RESC(); ROT();
  }
  #undef CMASK
  #define CMASK(P0,P1,t) do{}while(0)
  #define ENDW(tt) do{ if((tt)+3<NT){WAIT_BAR(3);} else if((tt)+2<NT){WAIT_BAR(1);} else {WAIT_BAR(0);} }while(0)
  for(;t+1<NT;t+=2){
    STEP(pB0,pB1,pA0,pA1,t,(t+3<NT),(t+1<NT),(t+1<NT));       ENDW(t);   RESC(); ROT();
    STEP(pA0,pA1,pB0,pB1,t+1,(t+4<NT),(t+2<NT),(t+2<NT));     ENDW(t+1); RESC(); ROT();
  }
  STEP(pB0,pB1,pA0,pA1,NT-1,false,false,false); RESC();
  { float sacc=pB0[0]+pB0[1]; _Pragma("unroll") for(int r=2;r<16;++r)sacc+=pB0[r]; _Pragma("unroll") for(int r=0;r<16;++r)sacc+=pB1[r]; l_reg+=sacc;
    pw0=(u32x4){PKW(pB0,0),PKW(pB0,2),PKW(pB0,4),PKW(pB0,6)};pw1=(u32x4){PKW(pB0,8),PKW(pB0,10),PKW(pB0,12),PKW(pB0,14)};pw2=(u32x4){PKW(pB1,0),PKW(pB1,2),PKW(pB1,4),PKW(pB1,6)};pw3=(u32x4){PKW(pB1,8),PKW(pB1,10),PKW(pB1,12),PKW(pB1,14)};
    SBAR(); pv(o,vb0+sl_cur,PAF(0),PAF(1),PAF(2),PAF(3)); }
  #undef PKW
  #undef PAF
  #undef VFR
  #undef PIN
  #undef MX3
  #undef GAPA
  #undef GAPB
  #undef EX
  #undef VRD
  #undef KRD
  #undef STEP
  #undef ENDW
  {auto rr=__builtin_amdgcn_permlane32_swap(__float_as_uint(l_reg),__float_as_uint(l_reg),false,false);l_reg=__uint_as_float(rr[0])+__uint_as_float(rr[1]);}
  if(hi==0)wsf[32+r32]=l_reg;asm volatile("s_waitcnt lgkmcnt(0)":::"memory");
  float rli[16];
  #pragma unroll
  for(int r=0;r<16;++r)rli[r]=__builtin_amdgcn_rcpf(wsf[32+crow(r,hi)]);
  bf16*Ow=Ob+(long)(wid*QBLK)*LDO; const bf16*Gw=Gb+(long)(wid*QBLK)*LDG;
  { bf16*stg=(bf16*)(shm+LDS_OST)+wid*2048;
    #pragma unroll
    for(int r=0;r<16;++r){const int orow=crow(r,hi);
      #pragma unroll
      for(int d0=0;d0<2;++d0)stg[orow*64+d0*32+r32]=__float2bfloat16(o[d0][r]*rli[r]);}
    asm volatile("s_waitcnt lgkmcnt(0)":::"memory");
    #pragma unroll
    for(int i=0;i<4;++i){const int row=i*8+(lane>>3),ch=lane&7; const u32x4 v=*(const u32x4*)(stg+row*64+ch*8); const u32x4 g=*(const u32x4*)(Gw+(long)row*LDG+ch*8); u32x4 w;
      #pragma unroll
      for(int e=0;e<4;++e){ const float v0=__uint_as_float(v[e]<<16),v1=__uint_as_float(v[e]&0xffff0000u),g0=__uint_as_float(g[e]<<16),g1=__uint_as_float(g[e]&0xffff0000u);
        w[e]=cvtpk_s(v0*g0*__builtin_amdgcn_rcpf(1.f+__expf(-g0)),v1*g1*__builtin_amdgcn_rcpf(1.f+__expf(-g1))); }
      ATTN_STORE16(Ow+(long)row*LDO+ch*8,w);} }
  asm volatile("s_waitcnt lgkmcnt(0)\n\ts_barrier":::"memory");
  #undef DMA_K
  #undef DMA_V
  #undef CMASK
  #undef START
  #undef RESC
  #undef ROT
}
constexpr int ATTN_LDS_BYTES=LDS_BYTES;
#undef SBAR
#undef WAIT_BAR
#undef KS
}
__device__ __forceinline__ void attn_phase(const P& p, int layer, char* lds, int bx, int G, bool need_ctx, int stage) {
    const int vcu = (G % 8 == 0) ? (bx % 8) * (G / 8) + bx / 8 : bx;
    const bf16_t* QA = (const bf16_t*)(p.ws + WS_QA); const bf16_t* KA = (const bf16_t*)(p.ws + WS_KA); const bf16_t* VA = (const bf16_t*)(p.ws + WS_VA);
    const bf16_t* KEEP = (const bf16_t*)(p.ws + WS_KEEP); bf16_t* MIX = (bf16_t*)(p.ws + WS_H);
    for (int pass = 0; pass < 2; ++pass) {
        if (pass == 1 && (!need_ctx || stage != 2)) break;
        const int nu = pass == 0 ? 256 : 48;
        for (int u = pass == 0 ? vcu : bx - (G >= 112 ? 64 : 0); u >= 0 && u < nu; u += G) {
            int b, h, qb, grp = -1; if (pass == 0) { b = u >> 6; h = (u >> 4) & 3; qb = u & 15; } else { grp = u >> 4; b = (u >> 2) & 3; h = u & 3; qb = 0; }
            const size_t rowb = (size_t)b * SPB, rowq = rowb + (pass == 0 ? CTX + qb * 256 : 0); const int nk = pass == 0 ? SPB / 64 : CTX / 64;
            if ((pass == 0 && stage == 0) || grp == 0) { att::Unit U; U.Q = QA + rowq * 384 + h * 96; U.ldq = 384; U.K = KA + rowb * 384 + h * 96; U.ldk = 384; U.V = VA + rowb * 256 + h * 64; U.ldv = 256;
              U.gate = KEEP + rowq * NKEEP + K_GA + h * 64; U.out = MIX + rowq * DM + h * 64; U.n1 = nk; U.n2 = 0; U.row2 = 0; U.tq0 = 0; U.sink_l2 = 0.f;
              if (HAND_A) attn_a::attn_unit<8, 384, 384, 256, NKEEP, DM>((const attn_a::bf16*)U.Q, (const attn_a::bf16*)U.K, (const attn_a::bf16*)U.V, (const attn_a::bf16*)U.gate, (attn_a::bf16*)U.out, nk, lds);
              else att::attn_unit<96, 0>(U, lds); }
            if ((pass == 0 && stage == 1) || grp == 1) { att::Unit U; U.Q = KEEP + rowq * NKEEP + K_BQ + h * 64; U.ldq = NKEEP; U.K = KEEP + rowb * NKEEP + K_BK + (h >> 1) * 64; U.ldk = NKEEP; U.V = KEEP + rowb * NKEEP + K_BV + (h >> 1) * 64; U.ldv = NKEEP;
              U.gate = KEEP + rowq * NKEEP + K_BG + h * 64; U.out = MIX + rowq * DM + 256 + h * 64; U.n1 = nk; U.n2 = 0; U.row2 = 0; U.tq0 = 0; U.sink_l2 = 0.f;
              if (HAND_B) attn_b::attn_unit<8, NKEEP, DM>((const attn_b::bf16*)U.Q, (const attn_b::bf16*)U.K, (const attn_b::bf16*)U.V, (const attn_b::bf16*)U.gate, (attn_b::bf16*)U.out, nk, lds);
              else att::attn_unit<64, 0>(U, lds); }
            if ((pass == 0 && stage == 2) || grp == 2) { att::Unit U; U.Q = KEEP + rowq * NKEEP + K_CQ + h * 64; U.ldq = NKEEP; U.K = KEEP + rowb * NKEEP + K_CK + (h >> 1) * 64; U.ldk = NKEEP; U.V = KEEP + rowb * NKEEP + K_CV + (h >> 1) * 64; U.ldv = NKEEP;
              U.gate = KEEP + rowq * NKEEP + K_CG + h * 64; U.out = MIX + rowq * DM + 512 + h * 64; U.n1 = CTX / 64; U.n2 = pass == 0 ? 8 : 0; U.row2 = CTX + qb * 256 - 128; U.tq0 = qb * 256;
              U.sink_l2 = p.swa_sink[layer * 4 + h] * LOG2E;
              att::attn_unit<64, 1>(U, lds); }
        }
    }
}


namespace prep {
typedef short bf16x8 __attribute__((ext_vector_type(8)));
typedef float f32x16 __attribute__((ext_vector_type(16)));
constexpr int AQ_PITCH = 528, AKV_PITCH = 272;
constexpr int L_AQ = 0, L_AKV = 64 * AQ_PITCH, L_KR = L_AKV + 64 * AKV_PITCH, L_END = L_KR + 64 * 32 * 4;
__device__ __forceinline__ void unit(const P& p, int layer, int u, char* lds) {
    const int tid = tid512_fresh(), wid = tid >> 6, lane = tid & 63, r32 = lane & 31, hi = lane >> 5; const int row0 = u * 64;
    const bf16_t* tmp = (const bf16_t*)(p.ws + WS_TMP);
    { const float* qn = p.mla_q_norm + layer * 256 + lane * 4; const float* kvn = p.mla_kv_norm + layer * 128 + lane * 2;
      const float qn0 = qn[0], qn1 = qn[1], qn2 = qn[2], qn3 = qn[3], kn0 = kvn[0], kn1 = kvn[1];
      uint2 cqv[8]; unsigned ckv[8]; bf16_t krv[8];
#pragma unroll
      for (int i = 0; i < 8; ++i) { const bf16_t* row = tmp + (size_t)(row0 + wid * 8 + i) * NTMP; cqv[i] = *(const uint2*)(row + T_CQ + lane * 4); ckv[i] = *(const unsigned*)(row + T_CKV + lane * 2); krv[i] = row[T_KR + (lane & 31)]; }
      SB();
      float sq[8], sk[8];
#pragma unroll
      for (int i = 0; i < 8; ++i) { const float a0 = __uint_as_float(cqv[i].x << 16), a1 = __uint_as_float(cqv[i].x & 0xffff0000u), a2 = __uint_as_float(cqv[i].y << 16), a3 = __uint_as_float(cqv[i].y & 0xffff0000u);
          const float b0 = __uint_as_float(ckv[i] << 16), b1 = __uint_as_float(ckv[i] & 0xffff0000u); sq[i] = a0 * a0 + a1 * a1 + a2 * a2 + a3 * a3; sk[i] = b0 * b0 + b1 * b1; }
#pragma unroll
      for (int o = 1; o < 64; o <<= 1) {
#pragma unroll
          for (int i = 0; i < 8; ++i) { sq[i] += __shfl_xor(sq[i], o); sk[i] += __shfl_xor(sk[i], o); } }
#pragma unroll
      for (int i = 0; i < 8; ++i) { const int rr = wid * 8 + i; const float rq = rsqrtf(sq[i] * (1.f / 256.f) + EPS), rk = rsqrtf(sk[i] * (1.f / 128.f) + EPS);
          const float a0 = __uint_as_float(cqv[i].x << 16), a1 = __uint_as_float(cqv[i].x & 0xffff0000u), a2 = __uint_as_float(cqv[i].y << 16), a3 = __uint_as_float(cqv[i].y & 0xffff0000u);
          const float b0 = __uint_as_float(ckv[i] << 16), b1 = __uint_as_float(ckv[i] & 0xffff0000u);
          uint2 o; o.x = pk2bf(a0 * rq * qn0, a1 * rq * qn1); o.y = pk2bf(a2 * rq * qn2, a3 * rq * qn3);
          *(uint2*)(lds + L_AQ + rr * AQ_PITCH + lane * 8) = o;
          *(unsigned*)(lds + L_AKV + rr * AKV_PITCH + lane * 4) = pk2bf(b0 * rk * kn0, b1 * rk * kn1);
          if (lane < 32) ((float*)(lds + L_KR))[rr * 32 + lane] = bf2f(krv[i]); } }
    __syncthreads();
    { const int rt = wid & 1, h = wid >> 1;
      const bf16x8* WQF = (const bf16x8*)(p.ws + WS_WQ) + (size_t)layer * 12288 + lane; const bf16x8* WKVF = (const bf16x8*)(p.ws + WS_WKV) + (size_t)layer * 8192 + lane;
      f32x16 aq[3] = {};
      const char* ap = lds + L_AQ + (rt * 32 + r32) * AQ_PITCH + hi * 16;
#pragma unroll
      for (int kb = 0; kb < 2; ++kb) { bf16x8 wf[8][3], af[8];
#pragma unroll
          for (int k8 = 0; k8 < 8; ++k8) { af[k8] = *(const bf16x8*)(ap + (kb * 8 + k8) * 32);
#pragma unroll
              for (int j = 0; j < 3; ++j) wf[k8][j] = WQF[((3 * h + j) * 16 + kb * 8 + k8) * 64]; }
          SB();
#pragma unroll
          for (int k8 = 0; k8 < 8; ++k8)
#pragma unroll
              for (int j = 0; j < 3; ++j) aq[j] = __builtin_amdgcn_mfma_f32_32x32x16_bf16(wf[k8][j], af[k8], aq[j], 0, 0, 0);
          SB(); }
      f32x16 akv[4] = {};
      const char* ap2 = lds + L_AKV + (rt * 32 + r32) * AKV_PITCH + hi * 16;
#pragma unroll
      for (int kb = 0; kb < 2; ++kb) { bf16x8 wf[4][4], af[4];
#pragma unroll
          for (int k4 = 0; k4 < 4; ++k4) { af[k4] = *(const bf16x8*)(ap2 + (kb * 4 + k4) * 32);
#pragma unroll
              for (int j = 0; j < 4; ++j) wf[k4][j] = WKVF[((4 * h + j) * 8 + kb * 4 + k4) * 64]; }
          SB();
#pragma unroll
          for (int k4 = 0; k4 < 4; ++k4)
#pragma unroll
              for (int j = 0; j < 4; ++j) akv[j] = __builtin_amdgcn_mfma_f32_32x32x16_bf16(wf[k4][j], af[k4], akv[j], 0, 0, 0);
          SB(); }
      bf16_t* QA = (bf16_t*)(p.ws + WS_QA); bf16_t* KA = (bf16_t*)(p.ws + WS_KA); bf16_t* VA = (bf16_t*)(p.ws + WS_VA);
      const float qscale = LOG2E * 0.10206207261596577f;
      const int R = row0 + rt * 32 + r32, s = R % SPB;
      if (s >= CTX) { const float* rt32 = (const float*)(p.ws + WS_ROPE32) + (size_t)(s - CTX) * 32;
#pragma unroll
          for (int rq = 0; rq < 2; ++rq) { const float4 c01 = *(const float4*)(rt32 + (8 * rq + 4 * hi) * 2), c23 = *(const float4*)(rt32 + (8 * rq + 4 * hi) * 2 + 4);
              const float cs[4] = {c01.x, c01.z, c23.x, c23.z}, sn[4] = {c01.y, c01.w, c23.y, c23.w};
#pragma unroll
              for (int e = 0; e < 4; ++e) { const float x1 = aq[2][rq * 4 + e], x2 = aq[2][rq * 4 + 8 + e]; aq[2][rq * 4 + e] = x1 * cs[e] - x2 * sn[e]; aq[2][rq * 4 + 8 + e] = x1 * sn[e] + x2 * cs[e]; } } }
#define PREP_ST16(T, SC, DST) do { _Pragma("unroll") for (int m_ = 0; m_ < 2; ++m_) { \
          const unsigned a0_ = pk2bf(T[8 * m_ + 0] * (SC), T[8 * m_ + 1] * (SC)), a1_ = pk2bf(T[8 * m_ + 2] * (SC), T[8 * m_ + 3] * (SC)), b0_ = pk2bf(T[8 * m_ + 4] * (SC), T[8 * m_ + 5] * (SC)), b1_ = pk2bf(T[8 * m_ + 6] * (SC), T[8 * m_ + 7] * (SC)); \
          auto r0_ = __builtin_amdgcn_permlane32_swap(a0_, b0_, false, false); auto r1_ = __builtin_amdgcn_permlane32_swap(a1_, b1_, false, false); \
          *(uint4*)((DST) + 16 * m_ + 8 * hi) = make_uint4(r0_[0], r1_[0], r0_[1], r1_[1]); } } while (0)
#pragma unroll
      for (int j = 0; j < 3; ++j) PREP_ST16(aq[j], qscale, QA + (size_t)R * 384 + 96 * h + 32 * j);
#pragma unroll
      for (int j = 0; j < 2; ++j) PREP_ST16(akv[j], 1.f, KA + (size_t)R * 384 + 96 * h + 32 * j);
#pragma unroll
      for (int j = 2; j < 4; ++j) PREP_ST16(akv[j], 1.f, VA + (size_t)R * 256 + 64 * h + 32 * (j - 2));
#undef PREP_ST16
      { const int rr = tid >> 3, gq = tid & 3, hp = (tid >> 2) & 1; const int Rk = row0 + rr, sk_ = Rk % SPB; const float* kr = (const float*)(lds + L_KR) + rr * 32 + gq * 4;
        const float4 xa = *(const float4*)kr, xb = *(const float4*)(kr + 16);
        float x1[4] = {xa.x, xa.y, xa.z, xa.w}, x2[4] = {xb.x, xb.y, xb.z, xb.w};
        if (sk_ >= CTX) { const float* rp = (const float*)(p.ws + WS_ROPE32) + ((size_t)(sk_ - CTX) * 16 + gq * 4) * 2; const float4 c01 = *(const float4*)rp, c23 = *(const float4*)(rp + 4);
            const float cs[4] = {c01.x, c01.z, c23.x, c23.z}, sn[4] = {c01.y, c01.w, c23.y, c23.w};
#pragma unroll
            for (int e = 0; e < 4; ++e) { const float y1 = x1[e] * cs[e] - x2[e] * sn[e], y2 = x1[e] * sn[e] + x2[e] * cs[e]; x1[e] = y1; x2[e] = y2; } }
        uint2 o1, o2; o1.x = pk2bf(x1[0], x1[1]); o1.y = pk2bf(x1[2], x1[3]); o2.x = pk2bf(x2[0], x2[1]); o2.y = pk2bf(x2[2], x2[3]);
        bf16_t* kp = KA + (size_t)Rk * 384 + 64 + gq * 4 + hp * 192;
        *(uint2*)kp = o1; *(uint2*)(kp + 16) = o2; *(uint2*)(kp + 96) = o1; *(uint2*)(kp + 112) = o2; }
    }
    __syncthreads();
}
__device__ __forceinline__ void bc_rows(const P& p, int layer, int ck0, int ck1, int ckstep) {
    if (ck0 >= ck1) return;
    const int tid = tid512_fresh(), lane = tid & 63, slot = lane >> 4, j = lane & 15; const int wv = tid >> 6; const float qscale = 0.125f * LOG2E;
    int offs[3]; float sc[3], w1a[3], w1b[3], w2a[3], w2b[3]; bool nrm[3];
#pragma unroll
    for (int it = 0; it < 3; ++it) { const int hv = it * 4 + slot; const bool isq = hv < 4 || (hv >= 6 && hv < 10); nrm[it] = hv < 6;
        offs[it] = hv < 4 ? K_BQ + hv * 64 : hv < 6 ? K_BK + (hv - 4) * 64 : hv < 10 ? K_CQ + (hv - 6) * 64 : K_CK + (hv - 10) * 64; sc[it] = isq ? qscale : 1.f;
        const float* nw = hv < 4 ? p.gqa_q_norm + layer * 64 : p.gqa_k_norm + layer * 64;
        w1a[it] = nrm[it] ? nw[2 * j] : 1.f; w1b[it] = nrm[it] ? nw[2 * j + 1] : 1.f; w2a[it] = nrm[it] ? nw[32 + 2 * j] : 1.f; w2b[it] = nrm[it] ? nw[33 + 2 * j] : 1.f; }
    const float dtb = p.dt_bias[layer * 8 + (lane & 7)]; const bf16_t* tmp = (const bf16_t*)(p.ws + WS_TMP);
#pragma unroll 1
    for (int ck = ck0; ck < ck1; ck += 2 * ckstep) {
        unsigned x1[4][3], x2[4][3]; float4 cs[4]; float dtv[4]; const bool two = ck + ckstep < ck1;
#pragma unroll
        for (int q = 0; q < 4; ++q) { const int R = ((q >> 1) && two ? ck + ckstep : ck) * 16 + wv + (q & 1) * 8; const int s = R % SPB; const bf16_t* row = (const bf16_t*)(p.ws + WS_KEEP) + (size_t)R * NKEEP;
            cs[q] = make_float4(1.f, 0.f, 1.f, 0.f); if (s >= CTX) cs[q] = *(const float4*)((const float*)(p.ws + WS_ROPE64) + ((size_t)(s - CTX) * 32 + 2 * j) * 2);
            dtv[q] = bf2f(tmp[(size_t)R * NTMP + T_DT + (lane & 7)]);
#pragma unroll
            for (int it = 0; it < 3; ++it) { x1[q][it] = *(const unsigned*)(row + offs[it] + 2 * j); x2[q][it] = *(const unsigned*)(row + offs[it] + 32 + 2 * j); } }
        SB();
#pragma unroll
        for (int q = 0; q < 4; ++q) { if ((q >> 1) && !two) break; const int R = ((q >> 1) ? ck + ckstep : ck) * 16 + wv + (q & 1) * 8; bf16_t* row = (bf16_t*)(p.ws + WS_KEEP) + (size_t)R * NKEEP;
#pragma unroll
            for (int it = 0; it < 3; ++it) {
                float a0 = __uint_as_float(x1[q][it] << 16), a1 = __uint_as_float(x1[q][it] & 0xffff0000u), b0 = __uint_as_float(x2[q][it] << 16), b1 = __uint_as_float(x2[q][it] & 0xffff0000u);
                float ss = a0 * a0 + a1 * a1 + b0 * b0 + b1 * b1;
#pragma unroll
                for (int o = 1; o < 16; o <<= 1) ss += __shfl_xor(ss, o);
                const float rs = nrm[it] ? rsqrtf(ss * (1.f / 64.f) + EPS) : 1.f;
                a0 *= rs * w1a[it]; a1 *= rs * w1b[it]; b0 *= rs * w2a[it]; b1 *= rs * w2b[it];
                const float y10 = (a0 * cs[q].x - b0 * cs[q].y) * sc[it], y11 = (a1 * cs[q].z - b1 * cs[q].w) * sc[it], y20 = (a0 * cs[q].y + b0 * cs[q].x) * sc[it], y21 = (a1 * cs[q].w + b1 * cs[q].z) * sc[it];
                *(unsigned*)(row + offs[it] + 2 * j) = pk2bf(y10, y11); *(unsigned*)(row + offs[it] + 32 + 2 * j) = pk2bf(y20, y21); }
            if (lane < 8) { const float v = dtv[q] + dtb; const float e = __expf(-fabsf(v));
                const float l1p = e < 0.03f ? e * (1.f - e * (0.5f - e * 0.33333334f)) : __logf(1.f + e);
                ((float*)(p.ws + WS_DT))[(size_t)R * 8 + lane] = fmaxf(v, 0.f) + l1p; } } }
}
__device__ __forceinline__ void conv_items(const P& p, int layer, int it0, int itstep) {
    const int tid = tid512_fresh(); const bf16_t* tmp = (const bf16_t*)(p.ws + WS_TMP); bf16_t* U = (bf16_t*)(p.ws + WS_U);
#pragma unroll 1
    for (int it = it0; it < (MROWS / 16) * 96 / 512; it += itstep) { const int item = it * 512 + tid; const int seg = item / 96, cg = item % 96; const int R0 = seg * 16; const int s0 = R0 % SPB; const bool lat = s0 >= CTX; const int pos0 = lat ? s0 - CTX : s0, len = lat ? SEQ : CTX;
        const float* cw = p.conv_w + (size_t)layer * 5 * 768 + cg * 8; const float* cb = p.conv_b + layer * 768 + cg * 8;
        float w[5][8], bias[8];
#pragma unroll
        for (int e = 0; e < 8; ++e) bias[e] = cb[e];
#pragma unroll
        for (int j = 0; j < 5; ++j)
#pragma unroll
            for (int e = 0; e < 8; ++e) w[j][e] = cw[j * 768 + e];
        uint4 xin[20];
#pragma unroll
        for (int j = 0; j < 20; ++j) { const int pp = pos0 + j - 2; xin[j] = (pp >= 0 && pp < len) ? *(const uint4*)(tmp + (size_t)(R0 + j - 2) * NTMP + T_XBC + cg * 8) : make_uint4(0u, 0u, 0u, 0u); }
        SB();
#pragma unroll
        for (int rr = 0; rr < 16; ++rr) { float a[8];
#pragma unroll
            for (int e = 0; e < 8; ++e) a[e] = bias[e];
#pragma unroll
            for (int j = 0; j < 5; ++j) { const uint4 xv = xin[rr + j]; const unsigned xw[4] = {xv.x, xv.y, xv.z, xv.w};
#pragma unroll
                for (int e = 0; e < 4; ++e) { a[2 * e] += w[j][2 * e] * __uint_as_float(xw[e] << 16); a[2 * e + 1] += w[j][2 * e + 1] * __uint_as_float(xw[e] & 0xffff0000u); } }
            uint4 o; o.x = pk2bf(silu_f(a[0]), silu_f(a[1])); o.y = pk2bf(silu_f(a[2]), silu_f(a[3]));
            o.z = pk2bf(silu_f(a[4]), silu_f(a[5])); o.w = pk2bf(silu_f(a[6]), silu_f(a[7]));
            *(uint4*)(U + (size_t)(R0 + rr) * 768 + cg * 8) = o; } }
}
}


namespace ssdc {
typedef short bf16x8 __attribute__((ext_vector_type(8)));
typedef float f32x16 __attribute__((ext_vector_type(16)));
typedef unsigned u32x4 __attribute__((ext_vector_type(4)));
__device__ __forceinline__ void unit(const P& p, int layer, int u, char* lds) {
    const int tid = tid512_fresh(), wid = tid >> 6, lane = tid & 63, r32 = lane & 31, hi = lane >> 5; const int rt = wid & 1, h = wid >> 1, g = h >> 1;
    const int row0 = u * 64 + rt * 32; const int b = row0 / SPB, ch = (row0 % SPB) >> 7;
    const bf16_t* U = (const bf16_t*)(p.ws + WS_U); const bf16_t* ST = (const bf16_t*)(p.ws + WS_STATES); const float* ACUM = (const float*)(p.ws + WS_ACUM);
    bf16x8 cf[8];
    { const bf16_t* Cp = U + (size_t)(row0 + r32) * 768 + 512 + g * 128 + hi * 8;
#pragma unroll
      for (int ks = 0; ks < 8; ++ks) cf[ks] = *(const bf16x8*)(Cp + ks * 16); }
    f32x16 y0 = {}, y1 = {};
    constexpr int PP = 272;
    char* pl = lds + 4096;
#pragma unroll 1
    for (int d = 0; d < 2; ++d) {
        { u32x4 sv[8]; const u32x4* gp = (const u32x4*)(ST + ((size_t)(b * 34 + ch) * 2 + d) * 4 * 8192) + tid;
#pragma unroll
          for (int i = 0; i < 8; ++i) sv[i] = gp[512 * i];
          SB();
#pragma unroll
          for (int i = 0; i < 8; ++i) { const int c = tid + 512 * i; const int hh = c >> 10, pp = ((c >> 9) & 1) * 32 + (c & 31), n8 = (c >> 5) & 15;
              *(u32x4*)(pl + (hh * 64 + pp) * PP + n8 * 16) = sv[i]; } }
        __syncthreads();
        f32x16 t0 = {}, t1 = {};
        const char* bp = pl + (h * 64 + r32) * PP + hi * 16;
#pragma unroll
        for (int ks = 0; ks < 8; ++ks) {
            const bf16x8 b0 = *(const bf16x8*)(bp + ks * 32), b1 = *(const bf16x8*)(bp + 32 * PP + ks * 32);
            t0 = __builtin_amdgcn_mfma_f32_32x32x16_bf16(b0, cf[ks], t0, 0, 0, 0);
            t1 = __builtin_amdgcn_mfma_f32_32x32x16_bf16(b1, cf[ks], t1, 0, 0, 0); }
        const float dec = __expf(ACUM[(size_t)(row0 + r32) * 8 + d * 4 + h]);
#pragma unroll
        for (int r = 0; r < 16; ++r) { y0[r] += dec * t0[r]; y1[r] += dec * t1[r]; }
        __syncthreads(); }
    const bf16_t* Y = (const bf16_t*)(p.ws + WS_Y); const bf16_t* keep = (const bf16_t*)(p.ws + WS_KEEP); const float skip = p.ssd_d[layer * 4 + h];
    float* ssum = (float*)lds;
    const size_t R = (size_t)(row0 + r32); float ss = 0.f;
    uint2 yv8[8], xv8[8], zv8[8];
#pragma unroll
    for (int q8 = 0; q8 < 8; ++q8) { const int c0 = h * 64 + (q8 >> 2) * 32 + 8 * (q8 & 3) + 4 * hi; yv8[q8] = *(const uint2*)(Y + R * 256 + c0); xv8[q8] = *(const uint2*)(U + R * 768 + c0); zv8[q8] = *(const uint2*)(keep + R * NKEEP + K_Z + c0); }
    SB();
#pragma unroll
    for (int pt = 0; pt < 2; ++pt)
#pragma unroll
        for (int rq = 0; rq < 4; ++rq) {
            const uint2 yv = yv8[pt * 4 + rq], xv = xv8[pt * 4 + rq], zv = zv8[pt * 4 + rq];
            const float ye[4] = {__uint_as_float(yv.x << 16), __uint_as_float(yv.x & 0xffff0000u), __uint_as_float(yv.y << 16), __uint_as_float(yv.y & 0xffff0000u)};
            const float xe[4] = {__uint_as_float(xv.x << 16), __uint_as_float(xv.x & 0xffff0000u), __uint_as_float(xv.y << 16), __uint_as_float(xv.y & 0xffff0000u)};
            const float ze[4] = {__uint_as_float(zv.x << 16), __uint_as_float(zv.x & 0xffff0000u), __uint_as_float(zv.y << 16), __uint_as_float(zv.y & 0xffff0000u)};
#pragma unroll
            for (int e = 0; e < 4; ++e) { const float acc = pt == 0 ? y0[rq * 4 + e] : y1[rq * 4 + e]; const float v = (acc + ye[e] + skip * xe[e]) * silu_f(ze[e]); ss += v * v;
                if (pt == 0) y0[rq * 4 + e] = v; else y1[rq * 4 + e] = v; } }
    ss += __shfl_xor(ss, 32);
    if (hi == 0) ssum[(rt * 4 + h) * 32 + r32] = ss;
    __syncthreads();
    const float tot = ssum[(rt * 4 + 0) * 32 + r32] + ssum[(rt * 4 + 1) * 32 + r32] + ssum[(rt * 4 + 2) * 32 + r32] + ssum[(rt * 4 + 3) * 32 + r32];
    const float rs = rsqrtf(tot * (1.f / 256.f) + EPS); bf16_t* mix = (bf16_t*)(p.ws + WS_H);
#pragma unroll
    for (int pt = 0; pt < 2; ++pt)
#pragma unroll
        for (int m = 0; m < 2; ++m) {
            const int c0 = h * 64 + pt * 32 + 16 * m + 4 * hi; const float4 nwa = *(const float4*)(p.ssd_norm_w + layer * 256 + c0), nwb = *(const float4*)(p.ssd_norm_w + layer * 256 + c0 + 8);
            const float va0 = pt == 0 ? y0[8 * m + 0] : y1[8 * m + 0], va1 = pt == 0 ? y0[8 * m + 1] : y1[8 * m + 1], va2 = pt == 0 ? y0[8 * m + 2] : y1[8 * m + 2], va3 = pt == 0 ? y0[8 * m + 3] : y1[8 * m + 3];
            const float vb0 = pt == 0 ? y0[8 * m + 4] : y1[8 * m + 4], vb1 = pt == 0 ? y0[8 * m + 5] : y1[8 * m + 5], vb2 = pt == 0 ? y0[8 * m + 6] : y1[8 * m + 6], vb3 = pt == 0 ? y0[8 * m + 7] : y1[8 * m + 7];
            const unsigned a0_ = att::cvtpk(va0 * rs * nwa.x, va1 * rs * nwa.y), a1_ = att::cvtpk(va2 * rs * nwa.z, va3 * rs * nwa.w), b0_ = att::cvtpk(vb0 * rs * nwb.x, vb1 * rs * nwb.y), b1_ = att::cvtpk(vb2 * rs * nwb.z, vb3 * rs * nwb.w);
            auto r0_ = __builtin_amdgcn_permlane32_swap(a0_, b0_, false, false); auto r1_ = __builtin_amdgcn_permlane32_swap(a1_, b1_, false, false);
            *(uint4*)(mix + R * DM + 768 + h * 64 + pt * 32 + 16 * m + 8 * hi) = make_uint4(r0_[0], r1_[0], r0_[1], r1_[1]); }
    __syncthreads();
}
}


namespace ssda {
using att::bf16x8; using att::s16x4; using att::f32x16; using att::u32x4;
constexpr int L_KB = 0, L_VX = 32768, L_VB = 65536, L_VEC = 98304, L_END = L_VEC + 12 * 512;
__device__ __forceinline__ int v_st4(int k, int c) { const int kk = (k & ~0xC) | ((k & 4) << 1) | ((k & 8) >> 1); return ((kk >> 3) * 4 + (c >> 5)) * 512 + ((kk & 7) * 32 + (c & 31)) * 2; }
constexpr int v4_off(int d0, int ks, int half) { return d0 * 512 + ks * 4096 + half * 2048; }
#define SSDA_PK(L, H) (bf16x8){L[0], L[1], L[2], L[3], H[0], H[1], H[2], H[3]}
template <int PT, int KS> __device__ __forceinline__ bf16x8 xfrag(int vb) { const s16x4 l = att::tr_read<att::v_rd_off(PT, KS, 0)>(vb), h = att::tr_read<att::v_rd_off(PT, KS, 1)>(vb); asm volatile("s_waitcnt lgkmcnt(0)" ::: "memory"); __builtin_amdgcn_sched_barrier(0); return SSDA_PK(l, h); }
template <int NT, int KS> __device__ __forceinline__ bf16x8 bfrag(int vb) { const s16x4 l = att::tr_read<v4_off(NT, KS, 0)>(vb), h = att::tr_read<v4_off(NT, KS, 1)>(vb); asm volatile("s_waitcnt lgkmcnt(0)" ::: "memory"); __builtin_amdgcn_sched_barrier(0); return SSDA_PK(l, h); }
__device__ __forceinline__ bf16x8 scale8(bf16x8 x, const float* w) {
    const float4 w0 = *(const float4*)w, w1 = *(const float4*)(w + 4); u32x4 xi = *reinterpret_cast<u32x4*>(&x), o;
    o[0] = att::cvtpk(__uint_as_float(xi[0] << 16) * w0.x, __uint_as_float(xi[0] & 0xffff0000u) * w0.y); o[1] = att::cvtpk(__uint_as_float(xi[1] << 16) * w0.z, __uint_as_float(xi[1] & 0xffff0000u) * w0.w);
    o[2] = att::cvtpk(__uint_as_float(xi[2] << 16) * w1.x, __uint_as_float(xi[2] & 0xffff0000u) * w1.y); o[3] = att::cvtpk(__uint_as_float(xi[3] << 16) * w1.z, __uint_as_float(xi[3] & 0xffff0000u) * w1.w);
    return *reinterpret_cast<bf16x8*>(&o);
}
template <int D0> __device__ __forceinline__ void pvT_one(f32x16& od, int vb, bf16x8 pa0, bf16x8 pa1, bf16x8 pa2, bf16x8 pa3) {
    const s16x4 l0 = att::tr_read<att::v_rd_off(D0, 0, 0)>(vb), h0 = att::tr_read<att::v_rd_off(D0, 0, 1)>(vb), l1 = att::tr_read<att::v_rd_off(D0, 1, 0)>(vb), h1 = att::tr_read<att::v_rd_off(D0, 1, 1)>(vb);
    const s16x4 l2 = att::tr_read<att::v_rd_off(D0, 2, 0)>(vb), h2 = att::tr_read<att::v_rd_off(D0, 2, 1)>(vb), l3 = att::tr_read<att::v_rd_off(D0, 3, 0)>(vb), h3 = att::tr_read<att::v_rd_off(D0, 3, 1)>(vb);
    asm volatile("s_waitcnt lgkmcnt(0)" ::: "memory"); __builtin_amdgcn_sched_barrier(0);
    od = __builtin_amdgcn_mfma_f32_32x32x16_bf16(SSDA_PK(l0, h0), pa0, od, 0, 0, 0);
    od = __builtin_amdgcn_mfma_f32_32x32x16_bf16(SSDA_PK(l1, h1), pa1, od, 0, 0, 0);
    od = __builtin_amdgcn_mfma_f32_32x32x16_bf16(SSDA_PK(l2, h2), pa2, od, 0, 0, 0);
    od = __builtin_amdgcn_mfma_f32_32x32x16_bf16(SSDA_PK(l3, h3), pa3, od, 0, 0, 0);
}
template <int PT, int KT> __device__ __forceinline__ void state_tile(f32x16* acc, int vx, int vbb, const float* wsv, int hi) {
#define SSDA_STEP(KS) do { \
    const s16x4 xl = att::tr_read<att::v_rd_off(PT, KS, 0)>(vx), xh = att::tr_read<att::v_rd_off(PT, KS, 1)>(vx); \
    const s16x4 l0 = att::tr_read<v4_off(0, KS, 0)>(vbb), h0 = att::tr_read<v4_off(0, KS, 1)>(vbb), l1 = att::tr_read<v4_off(1, KS, 0)>(vbb), h1 = att::tr_read<v4_off(1, KS, 1)>(vbb); \
    const s16x4 l2 = att::tr_read<v4_off(2, KS, 0)>(vbb), h2 = att::tr_read<v4_off(2, KS, 1)>(vbb), l3 = att::tr_read<v4_off(3, KS, 0)>(vbb), h3 = att::tr_read<v4_off(3, KS, 1)>(vbb); \
    asm volatile("s_waitcnt lgkmcnt(0)" ::: "memory"); __builtin_amdgcn_sched_barrier(0); \
    const bf16x8 a = scale8(SSDA_PK(xl, xh), wsv + KT * 64 + KS * 16 + hi * 8); \
    acc[0] = __builtin_amdgcn_mfma_f32_32x32x16_bf16(SSDA_PK(l0, h0), a, acc[0], 0, 0, 0); acc[1] = __builtin_amdgcn_mfma_f32_32x32x16_bf16(SSDA_PK(l1, h1), a, acc[1], 0, 0, 0); \
    acc[2] = __builtin_amdgcn_mfma_f32_32x32x16_bf16(SSDA_PK(l2, h2), a, acc[2], 0, 0, 0); acc[3] = __builtin_amdgcn_mfma_f32_32x32x16_bf16(SSDA_PK(l3, h3), a, acc[3], 0, 0, 0); \
    __builtin_amdgcn_sched_barrier(0); } while (0)
    SSDA_STEP(0); SSDA_STEP(1); SSDA_STEP(2); SSDA_STEP(3);
#undef SSDA_STEP
}
__device__ __forceinline__ void unit(const P& p, int layer, int u, int hm, char* lds) {
    const int tid = tid512_fresh(), wid = tid >> 6, lane = tid & 63, r32 = lane & 31, hi = lane >> 5; const int g = u & 1, bc = u >> 1, ch = bc % 34, b = bc / 34;
    const size_t R0 = (size_t)b * SPB + ch * 128; const bf16_t* U = (const bf16_t*)(p.ws + WS_U); const float* DT = (const float*)(p.ws + WS_DT);
    float* vec = (float*)(lds + L_VEC);
    bf16x8 qr[8];
    { const int hh_ = wid >> 2, qt_ = wid & 3; const bf16_t* Cp = U + (R0 + qt_ * 32 + r32) * 768 + 512 + g * 128 + hi * 8;
#pragma unroll
      for (int d0 = 0; d0 < 8; ++d0) qr[d0] = *(const bf16x8*)(Cp + d0 * 16); (void)hh_; }
    float dtl0 = 0.f, dtl1 = 0.f;
    if (wid < 4) { const int d = wid & 1, h = 2 * g + (wid >> 1); const int k0 = d == 0 ? 2 * lane : 127 - 2 * lane, k1 = d == 0 ? 2 * lane + 1 : 126 - 2 * lane; dtl0 = DT[(R0 + k0) * 8 + d * 4 + h]; dtl1 = DT[(R0 + k1) * 8 + d * 4 + h]; }
    { bf16x8 vb[4], vx[4];
#pragma unroll
      for (int i = 0; i < 4; ++i) { const int c = tid + 512 * i; vb[i] = *(const bf16x8*)(U + (R0 + (c >> 4)) * 768 + 256 + g * 128 + (c & 15) * 8); vx[i] = *(const bf16x8*)(U + (R0 + ((c >> 3) & 127)) * 768 + (2 * g + (c >> 10)) * 64 + (c & 7) * 8); }
      SB();
#pragma unroll
      for (int i = 0; i < 4; ++i) { const int c = tid + 512 * i, row = c >> 4, chk = c & 15;
          *(bf16x8*)(lds + L_KB + att::kswz<128>(row, chk)) = vb[i]; *(bf16x8*)(lds + L_VB + (row >> 6) * 16384 + v_st4(row & 63, chk * 8)) = vb[i]; }
#pragma unroll
      for (int i = 0; i < 4; ++i) { const int c = tid + 512 * i, hh = c >> 10, row = (c >> 3) & 127, chk = c & 7;
          *(bf16x8*)(lds + L_VX + (hh * 2 + (row >> 6)) * 8192 + att::v_st(row & 63, chk * 8)) = vx[i]; } }
    if (wid < 4) { const int hh = wid >> 1, d = wid & 1, h = 2 * g + hh; const float a = -__expf(p.a_log[layer * 8 + d * 4 + h]);
        const int k0 = d == 0 ? 2 * lane : 127 - 2 * lane, k1 = d == 0 ? 2 * lane + 1 : 126 - 2 * lane;
        const float dt0 = dtl0, dt1 = dtl1; const float c1 = dt0 * a, c2 = c1 + dt1 * a;
        float sc = c2;
#pragma unroll
        for (int o = 1; o < 64; o <<= 1) { const float t = __shfl_up(sc, o); if (lane >= o) sc += t; }
        const float ex = sc - c2, ac_0 = ex + c1, ac_1 = ex + c2; const float atot = __shfl(sc, 63);
        float* v = vec + (hh * 2 + d) * 384;
        v[k0] = ac_0; v[k1] = ac_1; v[128 + k0] = dt0; v[128 + k1] = dt1; v[256 + k0] = __expf(atot - ac_0) * dt0; v[256 + k1] = __expf(atot - ac_1) * dt1;
        if (hm < 0 || hm == hh) { float* ACUM = (float*)(p.ws + WS_ACUM); ACUM[(R0 + k0) * 8 + d * 4 + h] = ac_0; ACUM[(R0 + k1) * 8 + d * 4 + h] = ac_1;
            if (lane == 0) ((float*)(p.ws + WS_ATOT))[(b * 34 + ch) * 8 + d * 4 + h] = atot; } }
    __syncthreads();
    if (hm < 0 || wid < 4) { const int hh = hm < 0 ? wid >> 2 : hm, qt = wid & 3, h = 2 * g + hh; const int q = qt * 32 + r32;
      const float* v0 = vec + (hh * 2 + 0) * 384; const float* v1 = vec + (hh * 2 + 1) * 384; const float ac0q = v0[q], ac1q = v1[q];
      f32x16 o[2] = {};
#pragma unroll
      for (int kt = 0; kt < 2; ++kt) { f32x16 p0, p1; att::qkt<128>(p0, p1, lds + L_KB + kt * 64 * 256, qr, r32, hi);
#pragma unroll
          for (int rq = 0; rq < 4; ++rq) {
#pragma unroll
              for (int hf = 0; hf < 2; ++hf) { const int kb = kt * 64 + hf * 32 + 8 * rq + 4 * hi;
                  const float4 a0 = *(const float4*)(v0 + kb), d0v = *(const float4*)(v0 + 128 + kb), a1 = *(const float4*)(v1 + kb), d1v = *(const float4*)(v1 + 128 + kb);
                  const float a0e[4] = {a0.x, a0.y, a0.z, a0.w}, d0e[4] = {d0v.x, d0v.y, d0v.z, d0v.w}, a1e[4] = {a1.x, a1.y, a1.z, a1.w}, d1e[4] = {d1v.x, d1v.y, d1v.z, d1v.w};
#pragma unroll
                  for (int e = 0; e < 4; ++e) { const int k = kb + e; float w = 0.f; if (k <= q) w += __expf(ac0q - a0e[e]) * d0e[e]; if (k >= q) w += __expf(ac1q - a1e[e]) * d1e[e];
                      if (hf == 0) p0[rq * 4 + e] *= w; else p1[rq * 4 + e] *= w; } } }
          bf16x8 pa0, pa1, pa2, pa3;
#define SSDA_PK4(PP, BASE, OUT) do { unsigned a0_ = att::cvtpk(PP[BASE + 0], PP[BASE + 1]), a1_ = att::cvtpk(PP[BASE + 2], PP[BASE + 3]); unsigned b0_ = att::cvtpk(PP[BASE + 4], PP[BASE + 5]), b1_ = att::cvtpk(PP[BASE + 6], PP[BASE + 7]); \
    auto r0_ = __builtin_amdgcn_permlane32_swap(a0_, b0_, false, false); auto r1_ = __builtin_amdgcn_permlane32_swap(a1_, b1_, false, false); u32x4 w_ = {r0_[0], r1_[0], r0_[1], r1_[1]}; OUT = *reinterpret_cast<bf16x8*>(&w_); } while (0)
          SSDA_PK4(p0, 0, pa0); SSDA_PK4(p0, 8, pa1); SSDA_PK4(p1, 0, pa2); SSDA_PK4(p1, 8, pa3);
#undef SSDA_PK4
          { const int vbx = (int)(uintptr_t)(lds + L_VX + (hh * 2 + kt) * 8192) + att::v_rd_base(lane); pvT_one<0>(o[0], vbx, pa0, pa1, pa2, pa3); pvT_one<1>(o[1], vbx, pa0, pa1, pa2, pa3); } }
      bf16_t* Yr = (bf16_t*)(p.ws + WS_Y) + (R0 + qt * 32 + r32) * 256 + h * 64 + 8 * hi;
#pragma unroll
      for (int pt = 0; pt < 2; ++pt)
#pragma unroll
          for (int m = 0; m < 2; ++m) { const unsigned a0_ = pk2bf(o[pt][8 * m + 0], o[pt][8 * m + 1]), a1_ = pk2bf(o[pt][8 * m + 2], o[pt][8 * m + 3]), b0_ = pk2bf(o[pt][8 * m + 4], o[pt][8 * m + 5]), b1_ = pk2bf(o[pt][8 * m + 6], o[pt][8 * m + 7]);
              auto r0_ = __builtin_amdgcn_permlane32_swap(a0_, b0_, false, false); auto r1_ = __builtin_amdgcn_permlane32_swap(a1_, b1_, false, false);
              *(uint4*)(Yr + pt * 32 + 16 * m) = make_uint4(r0_[0], r1_[0], r0_[1], r1_[1]); } }
    if (hm < 0 || wid >= 4) { const int hh = hm < 0 ? wid >> 2 : hm, d = (wid >> 1) & 1, pt = wid & 1, h = 2 * g + hh; const float* wsv = vec + (hh * 2 + d) * 384 + 256;
      const int vx0 = (int)(uintptr_t)(lds + L_VX + (hh * 2 + 0) * 8192) + att::v_rd_base(lane), vx1 = vx0 + 8192;
      const int vb0 = (int)(uintptr_t)(lds + L_VB) + att::v_rd_base(lane), vb1 = vb0 + 16384;
      f32x16 acc[4] = {};
      if (pt == 0) { state_tile<0, 0>(acc, vx0, vb0, wsv, hi); state_tile<0, 1>(acc, vx1, vb1, wsv, hi); } else { state_tile<1, 0>(acc, vx0, vb0, wsv, hi); state_tile<1, 1>(acc, vx1, vb1, wsv, hi); }
      uint4* sp = (uint4*)((bf16_t*)(p.ws + WS_STATES) + (((size_t)(b * 34 + ch) * 2 + d) * 4 + h) * 8192) + pt * 512 + lane;
#pragma unroll
      for (int nt = 0; nt < 4; ++nt)
#pragma unroll
          for (int j = 0; j < 2; ++j) { const unsigned a0_ = pk2bf(acc[nt][j * 8 + 0], acc[nt][j * 8 + 1]), a1_ = pk2bf(acc[nt][j * 8 + 2], acc[nt][j * 8 + 3]), b0_ = pk2bf(acc[nt][j * 8 + 4], acc[nt][j * 8 + 5]), b1_ = pk2bf(acc[nt][j * 8 + 6], acc[nt][j * 8 + 7]);
              auto r0_ = __builtin_amdgcn_permlane32_swap(a0_, b0_, false, false); auto r1_ = __builtin_amdgcn_permlane32_swap(a1_, b1_, false, false);
              sp[(nt * 2 + j) * 64] = make_uint4(r0_[0], r1_[0], r0_[1], r1_[1]); } }
    __syncthreads();
}
#undef SSDA_PK
}

#define LAS __attribute__((address_space(3)))
#define XB_TMO      128
#define XB_XCNT(j)  (256  + 64 * (j))
#define XB_XSUB(j)  (1280 + 64 * (j))
#define XB_XGEN(j)  (2304 + 64 * (j))
#define XB_TOP      3328
#define XB_TOPGEN   3392
#define XCD_BAR_WORDS 3456
#define XB_SPIN_CAP (1u << 18)

__device__ __forceinline__ unsigned xb_ld(unsigned* p)              { return __hip_atomic_load(p, __ATOMIC_RELAXED, __HIP_MEMORY_SCOPE_AGENT); }
__device__ __forceinline__ unsigned xb_add(unsigned* p, unsigned v) { return __hip_atomic_fetch_add(p, v, __ATOMIC_RELAXED, __HIP_MEMORY_SCOPE_AGENT); }
__device__ __forceinline__ unsigned xb_xcc_id() { return (unsigned)__builtin_amdgcn_s_getreg((3 << 11) | 20) & 0xFu; }
#define XB_SPIN(cond, bar) do { unsigned _sp = 0; while (cond) { __builtin_amdgcn_s_sleep(1); \
    if ((++_sp & 255u) == 0u) { if (xb_ld(&(bar)[XB_TMO])) break; if (_sp > XB_SPIN_CAP) { atomicAdd(&(bar)[XB_TMO], 1u); break; } } } } while (0)

struct XcdBarrier {
    unsigned* bar; unsigned x;
    volatile LAS unsigned* st;
};

__device__ __forceinline__ XcdBarrier xcd_barrier_post(unsigned* bar, volatile LAS unsigned* st) {
    XcdBarrier b; b.bar = bar; b.x = xb_xcc_id(); b.st = st;
    if (threadIdx.x == 0) (void)xb_add(&bar[XB_XCNT(b.x)], 1u);
    return b;
}
__device__ __forceinline__ void xcd_barrier_complete(unsigned* bar, unsigned x, unsigned& nloc, unsigned& nx) {
    const unsigned G = gridDim.x * gridDim.y * gridDim.z;
    unsigned sum, cnt, mine, sp = 0u;
    for (;;) {
        sum = 0u; cnt = 0u; mine = 0u;
#pragma unroll
        for (unsigned j = 0; j < 16; ++j) { const unsigned c = xb_ld(&bar[XB_XCNT(j)]); sum += c; cnt += (c > 0u) ? 1u : 0u; mine = (j == x) ? c : mine; }
        if (sum == G) break;
        __builtin_amdgcn_s_sleep(1);
        if ((++sp & 255u) == 0u) { if (xb_ld(&bar[XB_TMO])) break; if (sp > XB_SPIN_CAP) { atomicAdd(&bar[XB_TMO], 1u); break; } }
    }
    nloc = mine > 0u ? mine : 1u; nx = cnt > 0u ? cnt : 1u;
}

__device__ __forceinline__ void xcd_barrier(const XcdBarrier& b) {
    asm volatile("s_waitcnt vmcnt(0)" ::: "memory");
    __syncthreads();
    if (threadIdx.x == 0) {
        unsigned* bar = b.bar;
        __builtin_amdgcn_s_waitcnt(0);
        unsigned nloc = b.st[0], nx = b.st[1];
        if (nloc == 0u) { xcd_barrier_complete(bar, b.x, nloc, nx); b.st[0] = nloc; b.st[1] = nx; }
        const unsigned old = xb_add(&bar[XB_XSUB(b.x)], 1u);
        const unsigned gen = old / nloc;
        if (old + 1u == (gen + 1u) * nloc) {
            __builtin_amdgcn_fence(__ATOMIC_RELEASE, "agent");
            asm volatile("s_waitcnt vmcnt(0)" ::: "memory");
            const unsigned og = xb_add(&bar[XB_TOP], 1u);
            const unsigned tg = og / nx;
            if (og + 1u == (tg + 1u) * nx) xb_add(&bar[XB_TOPGEN], 1u);
            else XB_SPIN(xb_ld(&bar[XB_TOPGEN]) == tg, bar);
            __builtin_amdgcn_fence(__ATOMIC_ACQUIRE, "agent");
            xb_add(&bar[XB_XGEN(b.x)], 1u);
            asm volatile("s_waitcnt vmcnt(0)" ::: "memory");
        } else {
            XB_SPIN(xb_ld(&bar[XB_XGEN(b.x)]) == gen, bar);
            __builtin_amdgcn_fence(__ATOMIC_ACQUIRE, "agent");
            asm volatile("s_waitcnt vmcnt(0)" ::: "memory");
        }
    }
    __syncthreads();
}


__device__ __forceinline__ void split_arrive(const XcdBarrier& b, unsigned* bar2, int slot = 2) {
    asm volatile("s_waitcnt vmcnt(0)" ::: "memory"); __syncthreads();
    if (threadIdx.x == 0) { __builtin_amdgcn_s_waitcnt(0); unsigned bx_ = b.x; asm volatile("" : "+s"(bx_));
        const unsigned nloc = b.st[0], nx = b.st[1]; const unsigned old = xb_add(&bar2[XB_XSUB(bx_)], 1u); const unsigned gen = old / nloc; b.st[slot] = gen;
        if (old + 1u == (gen + 1u) * nloc) { __builtin_amdgcn_fence(__ATOMIC_RELEASE, "agent"); asm volatile("s_waitcnt vmcnt(0)" ::: "memory");
            const unsigned og = xb_add(&bar2[XB_TOP], 1u); const unsigned tg = og / nx; if (og + 1u == (tg + 1u) * nx) xb_add(&bar2[XB_TOPGEN], 1u); } }
}
__device__ __forceinline__ void split_wait(const XcdBarrier& b, unsigned* bar2, int slot = 2) {
    if (threadIdx.x == 0) { const unsigned gen = b.st[slot]; XB_SPIN(xb_ld(&bar2[XB_TOPGEN]) <= gen, b.bar);
        __builtin_amdgcn_fence(__ATOMIC_ACQUIRE, "agent"); asm volatile("s_waitcnt vmcnt(0)" ::: "memory"); }
    __syncthreads();
}

#define REP_PREP 1
#define REP_ATTN 1
#define REP_SSDA 1
#define REP_SSDC 1
#define REP_GEMM_IN 1
#define BCW_X 8
#define BCW_Y 22
#define BCW_Z1 59
#define BCW_Z2 86
#define REP_NORM 1
#define EXTRA_SYNCS 0
constexpr int NTHREADS = 512, LDS_BYTES = 147456, HALF_LDS = 65536, LDS_CTL_OFF = 131072 + 256;
__global__ void __launch_bounds__(NTHREADS, 2) mega(P p) {
    extern __shared__ __attribute__((aligned(16))) char lds[];
    cg::grid_group grid = cg::this_grid();
    const int G = gridDim.x, bx = blockIdx.x;
    volatile LAS unsigned* bst = (volatile LAS unsigned*)((LAS unsigned char*)lds + LDS_CTL_OFF);
    if (threadIdx.x < 16) bst[threadIdx.x] = 0u;
    __syncthreads();
    XcdBarrier xbar = xcd_barrier_post((unsigned*)(p.ws + WS_CTL), bst);
#define GSYNC() do { XcdBarrier xb_ = xbar; size_t o_ = WS_CTL; asm volatile("" : "+s"(o_), "+s"(xb_.x)); xb_.bar = (unsigned*)(p.ws + o_); xcd_barrier(xb_); } while (0)
#define PHASE(n, call) do { const int half = tid512_fresh() >> 8; char* smem = lds + half * HALF_LDS; (void)smem; for (int vb = bx * 2 + half; vb < (n); vb += 2 * G) { call; __syncthreads(); } } while (0)
    weights_layer(p, lds, 0, bx, G);
    __syncthreads();
    mla_weight_frags(p, bx, G);
    for (int u = bx; u < 96; u += G) mod_unit(p, u, lds);
    PHASE(SEQ * 48 / 256, rope_body(p, vb));
    if (p.never) grid.sync();
    GSYNC();
    { const int t5 = tid512_fresh(); for (int r = bx * 8 + (t5 >> 6); r < MROWS; r += 2 * G * 8) norm_row2(p, 0, r, r + G * 8 < MROWS ? r + G * 8 : -1, t5 & 63); }
    GSYNC();
    for (int l = 0; l < DEPTH; ++l) {
        { pg8::Gemm g{(const bf16_t*)(p.ws + WS_H), (const bf16_t*)(p.ws + WS_WIN) + (size_t)l * 3328 * DM, MROWS, 3328, DM};
          EpiIn E{(bf16_t*)(p.ws + WS_TMP), (bf16_t*)(p.ws + WS_KEEP)};
          if (G == 256 && l > 0) { size_t o5_ = 65536; asm volatile("" : "+s"(o5_)); split_wait(xbar, (unsigned*)(p.ws + o5_), 5); }
#pragma unroll 1
          for (int pass = 0; pass < 3; ++pass) { InOrder S{G, bx, pass};
              if (pass == 1 && G == 256 && l > 0) { size_t o4_ = 49152; asm volatile("" : "+s"(o4_)); split_wait(xbar, (unsigned*)(p.ws + o4_), 4); }
              pg8::gemm_phase<EpiIn, InOrder, true, true>((PG8_LAS unsigned char*)lds, g, S, E);
              if (pass == 1) { size_t o6_ = 98304; asm volatile("" : "+s"(o6_)); split_arrive(xbar, (unsigned*)(p.ws + o6_), 6); } }
          { size_t o6_ = 98304; asm volatile("" : "+s"(o6_)); split_wait(xbar, (unsigned*)(p.ws + o6_), 6); } }
        { int u2 = 1 << 20, cv0 = 1 << 20, cvs = 1 << 20, ck0 = 0, ck1 = 0, cks = 1;
          if (G == 256) {
              constexpr int B1 = (132 * BCW_X) >> 3, B2 = B1 + ((16 * BCW_Y) >> 3), B3 = B2 + ((72 * BCW_Z1) >> 3);
              if (bx < 132) { const int i = bx; cv0 = bx; ck0 = (i * BCW_X) >> 3; ck1 = ((i + 1) * BCW_X) >> 3; }
              else if (bx < 148) { const int i = bx - 132; u2 = 256 + i; ck0 = B1 + ((i * BCW_Y) >> 3); ck1 = B1 + (((i + 1) * BCW_Y) >> 3); }
              else if (bx < 220) { const int i = bx - 148; cv0 = 132 + i; ck0 = B2 + ((i * BCW_Z1) >> 3); ck1 = B2 + (((i + 1) * BCW_Z1) >> 3); }
              else { const int i = bx - 220; ck0 = B3 + ((i * BCW_Z2) >> 3); ck1 = bx == 255 ? MROWS / 16 : B3 + (((i + 1) * BCW_Z2) >> 3); }
              if (ck1 > MROWS / 16) ck1 = MROWS / 16; if (ck0 > ck1) ck0 = ck1;
          } else { u2 = bx + G; cv0 = bx; cvs = G; ck0 = bx; ck1 = MROWS / 16; cks = G; }
          for (int u = bx; u < MROWS / 64; u = (G == 256 ? (u < 256 ? u2 : 1 << 20) : u + G)) prep::unit(p, l, u, lds);
          { size_t o7_ = 114688; asm volatile("" : "+s"(o7_)); split_arrive(xbar, (unsigned*)(p.ws + o7_), 7); }
          prep::conv_items(p, l, cv0, cvs); prep::bc_rows(p, l, ck0, ck1, cks);
          { size_t o8_ = 131072; asm volatile("" : "+s"(o8_)); split_arrive(xbar, (unsigned*)(p.ws + o8_), 8); } }
        { size_t o2_ = 16384; asm volatile("" : "+s"(o2_)); unsigned* bar2 = (unsigned*)(p.ws + o2_);
          { size_t o7_ = 114688; asm volatile("" : "+s"(o7_)); split_wait(xbar, (unsigned*)(p.ws + o7_), 7); }
          attn_phase(p, l, lds, bx, G, l < DEPTH - 1, 0);
          { size_t o8_ = 131072; asm volatile("" : "+s"(o8_)); split_wait(xbar, (unsigned*)(p.ws + o8_), 8); }
          for (int u = bx, hm = -1; u < NB * 34 * 2; ) { ssda::unit(p, l, u, hm, lds);
              if (G == 256) { if (u < 256 && bx >= 16 && bx < 48) { u = 256 + ((bx - 16) >> 1); hm = (bx - 16) & 1; } else u = 1 << 20; } else u += G; }
          split_arrive(xbar, bar2);
          attn_phase(p, l, lds, bx, G, l < DEPTH - 1, 1);
          split_wait(xbar, bar2);
          for (int idx = bx * NTHREADS + tid512_fresh(); idx < NB * 2 * 4 * 4096; idx += G * NTHREADS) ssd_chunk_scan_body(p, idx);
          split_arrive(xbar, bar2);
          attn_phase(p, l, lds, bx, G, l < DEPTH - 1, 2);
          split_wait(xbar, bar2);
          for (int u = bx; u < MROWS / 64; u = (G == 256 ? ((u < 256 && bx >= 48 && bx < 64) ? 256 + bx - 48 : 1 << 20) : u + G)) ssdc::unit(p, l, u, lds);
          if (l + 1 < DEPTH) { int wgi = bx, nwg = G; if (G == 256) { wgi = (bx >= 112 && bx < 160) ? bx - 112 : bx < 16 ? 48 + bx : bx >= 160 ? 64 + bx - 160 : bx >= 64 ? 160 + bx - 64 : 1 << 20; nwg = 208; }
              weights_layer(p, lds, l + 1, wgi, nwg);
              __syncthreads();
              for (int u = (G == 256 ? bx - 160 : bx); u >= 0 && u < 96; u += G) mod_unit(p, 96 * (l + 1) + u, lds); } }
        GSYNC();
        { pg8::Gemm g{(const bf16_t*)(p.ws + WS_H), (const bf16_t*)(p.ws + WS_WOUT) + (size_t)l * DM * DM, MROWS, DM, DM};
          EpiOut E{l == 0 ? p.x : (const float*)p.out, l == 0 ? p.ctx : (const float*)(p.ws + WS_XC), p.out, (float*)(p.ws + WS_XC), (const float*)(p.ws + WS_MOD) + (size_t)l * 5 * 3072};
          if (l == DEPTH - 1) { LatentOrder SL{G, bx}; pg8::gemm_phase<EpiOut, LatentOrder, true, true>((PG8_LAS unsigned char*)lds, g, SL, E); GSYNC(); }
          else if (G != 256) { pg8::StaticOrder S; S.init(MROWS, DM, G, bx); pg8::gemm_phase<EpiOut, pg8::StaticOrder, true, true>((PG8_LAS unsigned char*)lds, g, S, E); GSYNC();
              for (int r = bx * 8 + (tid512_fresh() >> 6); r < MROWS; r += G * 8) norm_row(p, l + 1, r, tid512_fresh() & 63);
              GSYNC(); }
          else {
              size_t o3_ = 32768, o4_ = 49152, o5_ = 65536, oc_ = 81920 + (size_t)l * 256; asm volatile("" : "+s"(o3_), "+s"(o4_), "+s"(o5_), "+s"(oc_));
              unsigned* bar3 = (unsigned*)(p.ws + o3_); unsigned* bar4 = (unsigned*)(p.ws + o4_); unsigned* bar5 = (unsigned*)(p.ws + o5_); unsigned* cnt16 = (unsigned*)(p.ws + oc_);
              { LatentOrder SL{G, bx}; pg8::gemm_phase<EpiOut, LatentOrder, true, true>((PG8_LAS unsigned char*)lds, g, SL, E); }
              split_arrive(xbar, bar3, 3);
              if (bx < 16) split_arrive(xbar, bar5, 5);
              if (bx < 16) {
                  { CtxOrder SC{G, bx}; pg8::gemm_phase<EpiOut, CtxOrder, true, true>((PG8_LAS unsigned char*)lds, g, SC, E); }
                  asm volatile("s_waitcnt vmcnt(0)" ::: "memory"); __syncthreads();
                  if (threadIdx.x == 0) { __builtin_amdgcn_fence(__ATOMIC_RELEASE, "agent"); asm volatile("s_waitcnt vmcnt(0)" ::: "memory"); (void)xb_add(cnt16, 1u);
                      unsigned sp_ = 0; while (xb_ld(cnt16) < 16u && ++sp_ < (1u << 22)) __builtin_amdgcn_s_sleep(2);
                      __builtin_amdgcn_fence(__ATOMIC_ACQUIRE, "agent"); asm volatile("s_waitcnt vmcnt(0)" ::: "memory"); }
                  __syncthreads();
                  { const int t5 = tid512_fresh(); for (int rc = bx * 8 + (t5 >> 6); rc < NB * CTX; rc += 2 * 128) { const int r2 = rc + 128;
                      norm_row2(p, l + 1, (rc >> 8) * SPB + (rc & 255), r2 < NB * CTX ? (r2 >> 8) * SPB + (r2 & 255) : -1, t5 & 63); } } }
              split_arrive(xbar, bar4, 4);
              if (bx >= 16) { split_wait(xbar, bar3, 3);
                  const int t5 = tid512_fresh(); for (int rl = (bx - 16) * 8 + (t5 >> 6); rl < NB * SEQ; rl += 2 * 240 * 8) { const int r2 = rl + 240 * 8;
                  norm_row2(p, l + 1, (rl >> 12) * SPB + CTX + (rl & 4095), r2 < NB * SEQ ? (r2 >> 12) * SPB + CTX + (r2 & 4095) : -1, t5 & 63); }
                  split_arrive(xbar, bar5, 5); } } }
    }
    PHASE(NB * SEQ / 4, final_norm_body(p, vb));
#undef PHASE
}

extern "C" void kernel_launch(void* const* d_in, const int* in_sizes, int n_in, void* d_out, int out_size, void* d_ws, size_t ws_size, hipStream_t stream) {
    if (n_in != 23 || ws_size < WS_END) { fprintf(stderr, "kernel_launch: unexpected n_in %d / ws_size %zu\n", n_in, ws_size); return; }
    static int grid_blocks = 0;
    if (!grid_blocks) {
        int dev = 0, cus = 0, per_cu = 0;
        (void)hipGetDevice(&dev); (void)hipDeviceGetAttribute(&cus, hipDeviceAttributeMultiprocessorCount, dev);
        if (hipFuncSetAttribute((const void*)mega, hipFuncAttributeMaxDynamicSharedMemorySize, LDS_BYTES) != hipSuccess) fprintf(stderr, "kernel_launch: hipFuncSetAttribute failed\n");
        if (hipOccupancyMaxActiveBlocksPerMultiprocessor(&per_cu, mega, NTHREADS, LDS_BYTES) != hipSuccess || per_cu < 1) { fprintf(stderr, "kernel_launch: occupancy query says %d\n", per_cu); per_cu = 1; }
        grid_blocks = cus * per_cu;
    }
    P p{};
    const float** f = (const float**)&p;
    for (int i = 0; i < 23; ++i) f[i] = (const float*)d_in[i];
    p.out = (float*)d_out; p.ws = (unsigned char*)d_ws;
    (void)hipMemsetAsync(d_ws, 0, 131072 + 16384, stream);
    void* args[] = {&p};
    hipError_t e = hipLaunchCooperativeKernel((void*)mega, dim3(grid_blocks), dim3(NTHREADS), args, LDS_BYTES, stream);
    if (e != hipSuccess) fprintf(stderr, "cooperative launch failed: %s (grid %d)\n", hipGetErrorString(e), grid_blocks);
}
```
